# Optimizing an MI355X kernel written in HIP

```python
import jax, jax.numpy as jnp
from jax import lax
import numpy as np

D_MODEL = 1024
BATCH = 8
SEQ = 2048
DEPTH = 1

N_MEM = 256
HEAD_DIM = 64
MIX_WIDTH = D_MODEL
NSA_HEADS = (MIX_WIDTH // 2) // HEAD_DIM
NSA_KV_GROUPS = 2
NSA_HPG = NSA_HEADS // NSA_KV_GROUPS
NSA_WIDTH = NSA_HEADS * HEAD_DIM
NSA_KV_WIDTH = NSA_KV_GROUPS * HEAD_DIM
CMP_BLOCK = 32
CMP_STRIDE = 16
CMP_HIDDEN = 2 * HEAD_DIM
SEL_BLOCK = 64
SEL_TOPK = 8
WINDOW = 512
Q_BLOCK = 128
RET_HEADS = (MIX_WIDTH - NSA_WIDTH) // HEAD_DIM
RET_WIDTH = RET_HEADS * HEAD_DIM
RET_CHUNK = 128
ROPE_BASE = 10000.0
PROJ_WIDTH = NSA_WIDTH + 6 * NSA_KV_WIDTH + 3 * NSA_HEADS + 4 * RET_WIDTH
PROJ_SPLIT_POINTS = (NSA_WIDTH, NSA_WIDTH + 6 * NSA_KV_WIDTH,
                     NSA_WIDTH + 6 * NSA_KV_WIDTH + 3 * NSA_HEADS)
MEM_HEADS = 4
MEM_WIDTH = MEM_HEADS * HEAD_DIM
N_GROUPS = 4
EXPERTS_PER_GROUP = 8
N_EXPERTS = N_GROUPS * EXPERTS_PER_GROUP
TOP_K_IN_GROUP = 2
EXPERT_FF = D_MODEL // 4
MOE_BLOCK = 128

EPS = 1e-6
NEG_INF = -1e30
FORCE_SCORE = 1e9

kernel_name = 'hymba_nsa_retention_hmoe_layer'


def rms_norm(x, g):
    xf = x.astype(jnp.float32)
    y = xf * lax.rsqrt(jnp.mean(xf * xf, axis=-1, keepdims=True) + EPS)
    return (y * g.astype(jnp.float32)).astype(x.dtype)


def masked_softmax(s, mask):
    s = jnp.where(mask, s.astype(jnp.float32), NEG_INF)
    m = jnp.max(s, axis=-1, keepdims=True)
    p = jnp.exp(s - m) * mask
    return p / jnp.maximum(jnp.sum(p, axis=-1, keepdims=True), 1e-30)


def compress_blocks(kv, pos, w1, w2):
    B, S, G, Dh = kv.shape
    n_c = (S - CMP_BLOCK) // CMP_STRIDE + 1
    idx = np.arange(n_c)[:, None] * CMP_STRIDE + np.arange(CMP_BLOCK)[None, :]
    blk = kv[:, idx] + pos[None, None, :, None, :]
    blk = jnp.moveaxis(blk, 3, 2).reshape(B, n_c, G, CMP_BLOCK * Dh)
    return jax.nn.silu(blk @ w1) @ w2


def sel_from_cmp_matrix(n_c, n_sel):
    c0 = np.arange(n_c) * CMP_STRIDE
    s0 = np.arange(n_sel) * SEL_BLOCK
    ov = np.minimum(c0[None, :] + CMP_BLOCK, s0[:, None] + SEL_BLOCK) - np.maximum(c0[None, :], s0[:, None])
    return (np.clip(ov, 0, None) / CMP_BLOCK).astype(np.float32)


def nsa_mixer(q, kc, vc, ks, vs, kw, vw, gates, q_norm, kc_norm, ks_norm, kw_norm,
              pos_k, pos_v, ck_w1, ck_w2, cv_w1, cv_w2):
    B, S = q.shape[:2]
    G, R, Dh = NSA_KV_GROUPS, NSA_HPG, HEAD_DIM
    q = rms_norm(q.reshape(B, S, G, R, Dh), q_norm) * (Dh ** -0.5)
    t_pos = jnp.arange(S)
    kcmp = rms_norm(compress_blocks(kc, pos_k, ck_w1, ck_w2), kc_norm)
    vcmp = compress_blocks(vc, pos_v, cv_w1, cv_w2)
    n_c = kcmp.shape[1]
    c_end = jnp.arange(n_c) * CMP_STRIDE + CMP_BLOCK - 1
    cmask = c_end[None, :] <= t_pos[:, None]
    s_c = jnp.einsum('bsgrd,bcgd->bsgrc', q, kcmp)
    p_c = masked_softmax(s_c, cmask[None, :, None, None, :])
    o_cmp = jnp.einsum('bsgrc,bcgd->bsgrd', p_c.astype(vcmp.dtype), vcmp)
    n_sel = S // SEL_BLOCK
    m_sc = jnp.asarray(sel_from_cmp_matrix(n_c, n_sel))
    imp = jnp.einsum('bsgrc,jc->bsgj', p_c, m_sc)
    blk_id = jnp.arange(n_sel)[None, :]
    cur = (t_pos // SEL_BLOCK)[:, None]
    forced = (blk_id == 0) | (blk_id == cur) | (blk_id == cur - 1)
    future = blk_id > cur
    imp = jnp.where(forced[None, :, None, :], FORCE_SCORE,
                    jnp.where(future[None, :, None, :], NEG_INF, imp))
    k_top = min(SEL_TOPK, n_sel)
    _, sel_idx = lax.top_k(imp, k_top)
    ks = rms_norm(ks, ks_norm)
    kw = rms_norm(kw, kw_norm)
    k_blocks = ks.reshape(B, n_sel, SEL_BLOCK, G, Dh).transpose(0, 3, 1, 2, 4)
    v_blocks = vs.reshape(B, n_sel, SEL_BLOCK, G, Dh).transpose(0, 3, 1, 2, 4)
    kw_pad = jnp.pad(kw, ((0, 0), (WINDOW, 0), (0, 0), (0, 0)))
    vw_pad = jnp.pad(vw, ((0, 0), (WINDOW, 0), (0, 0), (0, 0)))
    nq = S // Q_BLOCK
    q_blocks = q.reshape(B, nq, Q_BLOCK, G, R, Dh).transpose(1, 0, 2, 3, 4, 5)
    idx_blocks = sel_idx.reshape(B, nq, Q_BLOCK, G, k_top).transpose(1, 0, 3, 2, 4)
    gather = jax.vmap(jax.vmap(lambda kb, ib: kb[ib]))

    def block_attn(args):
        i, qb, ib = args
        t = i * Q_BLOCK + jnp.arange(Q_BLOCK)
        ksel = gather(k_blocks, ib).reshape(B, G, Q_BLOCK, k_top * SEL_BLOCK, Dh)
        vsel = gather(v_blocks, ib).reshape(B, G, Q_BLOCK, k_top * SEL_BLOCK, Dh)
        kpos = (ib[..., None] * SEL_BLOCK + jnp.arange(SEL_BLOCK)).reshape(B, G, Q_BLOCK, k_top * SEL_BLOCK)
        smask = (kpos <= t[None, None, :, None]).transpose(0, 2, 1, 3)[:, :, :, None, :]
        s_s = jnp.einsum('bqgrd,bgqkd->bqgrk', qb, ksel)
        p_s = masked_softmax(s_s, smask)
        o_s = jnp.einsum('bqgrk,bgqkd->bqgrd', p_s.astype(vsel.dtype), vsel)
        kwin = lax.dynamic_slice_in_dim(kw_pad, i * Q_BLOCK, Q_BLOCK + WINDOW, axis=1)
        vwin = lax.dynamic_slice_in_dim(vw_pad, i * Q_BLOCK, Q_BLOCK + WINDOW, axis=1)
        wpos = i * Q_BLOCK - WINDOW + jnp.arange(Q_BLOCK + WINDOW)
        diff = t[:, None] - wpos[None, :]
        wmask = (wpos[None, :] >= 0) & (diff >= 0) & (diff < WINDOW)
        s_w = jnp.einsum('bqgrd,bkgd->bqgrk', qb, kwin)
        p_w = masked_softmax(s_w, wmask[None, :, None, None, :])
        o_w = jnp.einsum('bqgrk,bkgd->bqgrd', p_w.astype(vwin.dtype), vwin)
        return o_s, o_w

    o_sel, o_win = lax.map(block_attn, (jnp.arange(nq), q_blocks, idx_blocks))
    o_sel = o_sel.transpose(1, 0, 2, 3, 4, 5).reshape(B, S, G, R, Dh)
    o_win = o_win.transpose(1, 0, 2, 3, 4, 5).reshape(B, S, G, R, Dh)
    g = jax.nn.sigmoid(gates.astype(jnp.float32)).reshape(B, S, G, R, 3).astype(o_cmp.dtype)
    out = g[..., 0:1] * o_cmp + g[..., 1:2] * o_sel + g[..., 2:3] * o_win
    return out.reshape(B, S, NSA_HEADS, Dh)


def rotary(x, pos):
    half = x.shape[-1] // 2
    inv_freq = ROPE_BASE ** (-jnp.arange(half, dtype=jnp.float32) / half)
    ang = pos.astype(jnp.float32)[:, None] * inv_freq[None, :]
    cos, sin = jnp.cos(ang)[None, :, None, :], jnp.sin(ang)[None, :, None, :]
    x1, x2 = x[..., :half], x[..., half:]
    return jnp.concatenate([x1 * cos - x2 * sin, x1 * sin + x2 * cos], axis=-1)


def retention_mixer(q, k, v, g, out_norm):
    B, S = q.shape[:2]
    H, Dh, C = RET_HEADS, HEAD_DIM, RET_CHUNK
    f32 = jnp.float32
    pos = jnp.arange(S)
    q = rotary(q.reshape(B, S, H, Dh).astype(f32), pos)
    k = rotary(k.reshape(B, S, H, Dh).astype(f32), pos) * (Dh ** -0.5)
    v = v.reshape(B, S, H, Dh).astype(f32)
    log_gamma = jnp.log1p(-jnp.power(2.0, -5.0 - jnp.arange(H, dtype=f32)))
    n_ch = S // C
    i = jnp.arange(C, dtype=f32)
    rel = i[:, None] - i[None, :]
    decay = jnp.where(rel >= 0, jnp.exp(jnp.maximum(rel, 0.0)[None] * log_gamma[:, None, None]), 0.0)
    qc = q.reshape(B, n_ch, C, H, Dh)
    kc = k.reshape(B, n_ch, C, H, Dh)
    vc = v.reshape(B, n_ch, C, H, Dh)
    inner = jnp.einsum('bnihd,bnjhd->bnhij', qc, kc) * decay[None, None]
    o_inner = jnp.einsum('bnhij,bnjhd->bnihd', inner, vc)
    xi = jnp.exp((i + 1.0)[:, None] * log_gamma[None, :])
    zeta = jnp.exp((C - 1.0 - i)[:, None] * log_gamma[None, :])
    gamma_c = jnp.exp(C * log_gamma)

    def step(state, xs):
        qn, kn, vn = xs
        cross = jnp.einsum('bihd,bhde->bihe', qn, state) * xi[None, :, :, None]
        state = gamma_c[None, :, None, None] * state + jnp.einsum('bjhd,bjhe->bhde', kn * zeta[None, :, :, None], vn)
        return state, cross

    state0 = jnp.zeros((B, H, Dh, Dh), f32)
    _, o_cross = lax.scan(step, state0, (qc.transpose(1, 0, 2, 3, 4), kc.transpose(1, 0, 2, 3, 4), vc.transpose(1, 0, 2, 3, 4)))
    y = (o_inner + o_cross.transpose(1, 0, 2, 3, 4)).reshape(B, S, H, Dh)
    mu = jnp.mean(y, axis=-1, keepdims=True)
    var = jnp.mean(jnp.square(y - mu), axis=-1, keepdims=True)
    y = (y - mu) * lax.rsqrt(var + EPS) * out_norm.astype(f32).reshape(H, Dh)
    return (jax.nn.silu(g.astype(f32)).reshape(B, S, H, Dh) * y).astype(g.dtype)


def memory_cross_attention(x, mem, norm_x, norm_mem, wq, wkv, q_norm, k_norm, wo):
    B, S, _ = x.shape
    M = mem.shape[1]
    h = rms_norm(x, norm_x)
    hm = rms_norm(mem, norm_mem)
    q = rms_norm((h @ wq).reshape(B, S, MEM_HEADS, HEAD_DIM), q_norm) * (HEAD_DIM ** -0.5)
    k, v = jnp.split(hm @ wkv, 2, axis=-1)
    k = rms_norm(k.reshape(B, M, MEM_HEADS, HEAD_DIM), k_norm)
    v = v.reshape(B, M, MEM_HEADS, HEAD_DIM)
    p = jax.nn.softmax(jnp.einsum('bshd,bmhd->bhsm', q, k).astype(jnp.float32), axis=-1)
    o = jnp.einsum('bhsm,bmhd->bshd', p.astype(v.dtype), v).reshape(B, S, MEM_WIDTH)
    return o @ wo


def hierarchical_moe(x, norm_g, w_rg, b_rg, w_re, b_re, w_gate, w_up, w_down):
    B, S, Dm = x.shape
    T = B * S
    K = TOP_K_IN_GROUP
    h = rms_norm(x, norm_g).reshape(T, Dm)
    g_logits = (h @ w_rg).astype(jnp.float32) + b_rg.astype(jnp.float32)
    g_prob = jax.nn.softmax(g_logits, axis=-1)
    grp = jnp.argmax(g_logits, axis=-1)
    g_w = jnp.take_along_axis(g_prob, grp[:, None], axis=-1)
    e_all = jnp.einsum('td,gde->tge', h, w_re).astype(jnp.float32) + b_re.astype(jnp.float32)
    e_logits = jnp.take_along_axis(e_all, grp[:, None, None], axis=1)[:, 0]
    top_val, top_local = lax.top_k(e_logits, K)
    e_w = jax.nn.softmax(top_val, axis=-1) * g_w
    expert_id = grp[:, None] * EXPERTS_PER_GROUP + top_local
    A = T * K
    flat_e = expert_id.reshape(A)
    flat_tok = jnp.repeat(jnp.arange(T, dtype=jnp.int32), K)
    flat_w = e_w.reshape(A)
    order = jnp.argsort(flat_e)
    se, stok, sw = flat_e[order], flat_tok[order], flat_w[order]
    counts = jnp.bincount(flat_e, length=N_EXPERTS)
    start = jnp.cumsum(counts) - counts
    padded = (counts + MOE_BLOCK - 1) // MOE_BLOCK * MOE_BLOCK
    pend = jnp.cumsum(padded)
    pstart = pend - padded
    dest = pstart[se] + jnp.arange(A) - start[se]
    P = A + N_EXPERTS * MOE_BLOCK
    n_blocks = P // MOE_BLOCK
    row_tok = jnp.full((P,), T, jnp.int32).at[dest].set(stok)
    row_w = jnp.zeros((P,), h.dtype).at[dest].set(sw.astype(h.dtype))
    blk_e = jnp.minimum(jnp.searchsorted(pend, jnp.arange(n_blocks) * MOE_BLOCK, side='right'), N_EXPERTS - 1)
    h_pad = jnp.concatenate([h, jnp.zeros((1, Dm), h.dtype)], axis=0)
    x_rows = h_pad[row_tok].reshape(n_blocks, MOE_BLOCK, Dm)

    def expert_block(args):
        xb, e = args
        return (jax.nn.silu(xb @ w_gate[e]) * (xb @ w_up[e])) @ w_down[e]

    y_rows = lax.map(expert_block, (x_rows, blk_e)).reshape(P, Dm)
    y = jax.ops.segment_sum(y_rows * row_w[:, None], row_tok, num_segments=T + 1)[:T]
    return y.reshape(B, S, Dm)


def setup_inputs(seed: int = 0) -> dict:
    key = jax.random.key(seed)
    keys = iter(jax.random.split(key, 48))
    f32 = jnp.float32
    L, Dh, D = DEPTH, HEAD_DIM, D_MODEL

    def nrm(shape, scale):
        return jax.random.normal(next(keys), shape, f32) * scale

    def gain(shape):
        return 1.0 + nrm(shape, 0.02)

    return {
        'x': nrm((BATCH, SEQ, D), 1.0),
        'mem': nrm((BATCH, N_MEM, D), 1.0),
        'mix_norm': gain((L, D)),
        'w_in': nrm((L, D, PROJ_WIDTH), D ** -0.5),
        'nsa_q_norm': gain((L, Dh)),
        'nsa_kcmp_norm': gain((L, Dh)),
        'nsa_ksel_norm': gain((L, Dh)),
        'nsa_kwin_norm': gain((L, Dh)),
        'cmp_pos_k': nrm((L, CMP_BLOCK, Dh), 0.1),
        'cmp_pos_v': nrm((L, CMP_BLOCK, Dh), 0.1),
        'cmp_k_w1': nrm((L, CMP_BLOCK * Dh, CMP_HIDDEN), (CMP_BLOCK * Dh) ** -0.5),
        'cmp_k_w2': nrm((L, CMP_HIDDEN, Dh), CMP_HIDDEN ** -0.5),
        'cmp_v_w1': nrm((L, CMP_BLOCK * Dh, CMP_HIDDEN), (CMP_BLOCK * Dh) ** -0.5),
        'cmp_v_w2': nrm((L, CMP_HIDDEN, Dh), CMP_HIDDEN ** -0.5),
        'nsa_out_norm': gain((L, NSA_WIDTH)),
        'ret_out_norm': gain((L, RET_WIDTH)),
        'w_out': nrm((L, MIX_WIDTH, D), MIX_WIDTH ** -0.5),
        'mem_x_norm': gain((L, D)),
        'mem_kv_norm': gain((L, D)),
        'mem_wq': nrm((L, D, MEM_WIDTH), D ** -0.5),
        'mem_wkv': nrm((L, D, 2 * MEM_WIDTH), D ** -0.5),
        'mem_q_norm': gain((L, Dh)),
        'mem_k_norm': gain((L, Dh)),
        'mem_wo': nrm((L, MEM_WIDTH, D), MEM_WIDTH ** -0.5),
        'ffn_norm': gain((L, D)),
        'router_group_w': nrm((L, D, N_GROUPS), D ** -0.5),
        'router_group_b': nrm((L, N_GROUPS), 0.01),
        'router_expert_w': nrm((L, N_GROUPS, D, EXPERTS_PER_GROUP), D ** -0.5),
        'router_expert_b': nrm((L, N_GROUPS, EXPERTS_PER_GROUP), 0.01),
        'exp_w_gate': nrm((L, N_EXPERTS, D, EXPERT_FF), D ** -0.5),
        'exp_w_up': nrm((L, N_EXPERTS, D, EXPERT_FF), D ** -0.5),
        'exp_w_down': nrm((L, N_EXPERTS, EXPERT_FF, D), EXPERT_FF ** -0.5),
    }


def reference(x, mem, mix_norm, w_in, nsa_q_norm, nsa_kcmp_norm, nsa_ksel_norm, nsa_kwin_norm,
              cmp_pos_k, cmp_pos_v, cmp_k_w1, cmp_k_w2, cmp_v_w1, cmp_v_w2,
              nsa_out_norm, ret_out_norm, w_out,
              mem_x_norm, mem_kv_norm, mem_wq, mem_wkv, mem_q_norm, mem_k_norm, mem_wo,
              ffn_norm, router_group_w, router_group_b, router_expert_w, router_expert_b,
              exp_w_gate, exp_w_up, exp_w_down):
    B, S, _ = x.shape
    G, Dh = NSA_KV_GROUPS, HEAD_DIM
    for l in range(DEPTH):
        h = rms_norm(x, mix_norm[l])
        proj = h @ w_in[l]
        q_a, kv_a, gate_a, ret_a = jnp.split(proj, list(PROJ_SPLIT_POINTS), axis=-1)
        kc, vc, ks, vs, kw, vw = jnp.split(kv_a.reshape(B, S, 6, G, Dh), 6, axis=2)
        o_a = nsa_mixer(q_a, kc[:, :, 0], vc[:, :, 0], ks[:, :, 0], vs[:, :, 0], kw[:, :, 0], vw[:, :, 0], gate_a,
                        nsa_q_norm[l], nsa_kcmp_norm[l], nsa_ksel_norm[l], nsa_kwin_norm[l],
                        cmp_pos_k[l], cmp_pos_v[l], cmp_k_w1[l], cmp_k_w2[l], cmp_v_w1[l], cmp_v_w2[l])
        o_a = rms_norm(o_a, nsa_out_norm[l].reshape(NSA_HEADS, Dh)).reshape(B, S, NSA_WIDTH)
        q_r, k_r, v_r, g_r = jnp.split(ret_a, 4, axis=-1)
        o_b = retention_mixer(q_r, k_r, v_r, g_r, ret_out_norm[l]).reshape(B, S, RET_WIDTH)
        x = x + jnp.concatenate([o_a, o_b], axis=-1) @ w_out[l]
        x = x + memory_cross_attention(x, mem, mem_x_norm[l], mem_kv_norm[l], mem_wq[l], mem_wkv[l],
                                       mem_q_norm[l], mem_k_norm[l], mem_wo[l])
        x = x + hierarchical_moe(x, ffn_norm[l], router_group_w[l], router_group_b[l],
                                 router_expert_w[l], router_expert_b[l],
                                 exp_w_gate[l], exp_w_up[l], exp_w_down[l])
    return x
```

```cpp
#include <hip/hip_runtime.h>
#include <cstdint>
#include <cstdio>

#define DI __device__ __forceinline__
#define LAS __attribute__((address_space(3)))
#define GAS __attribute__((address_space(1)))

constexpr int NB = 8, NS = 2048, DM = 1024, NT = NB * NS;
constexpr int NG = 2, NR = 4, DH = 64, NHA = 8, NHR = 8;
constexpr int PROJ = 3352;
constexpr int NCMP = 127, NSEL = 32, TOPK = 8, WIN = 512;
constexpr int NMEM = 256, MH = 4, MW = 256;
constexpr int NGRP = 4, EPG = 8, NEXP = 32, EFF = 256;
constexpr float EPS = 1e-6f;
constexpr int NTHR = 512, NWAVE = 8;

typedef unsigned short bf16_t;

DI unsigned short f2bf(float f) { unsigned u = __float_as_uint(f); u += 0x7fffu + ((u >> 16) & 1u); return (unsigned short)(u >> 16); }
DI float bf2f(unsigned short h) { return __uint_as_float(((unsigned)h) << 16); }
DI float wave_sum(float v) {
#pragma unroll
    for (int o = 1; o < 64; o <<= 1) v += __shfl_xor(v, o);
    return v;
}
DI float wave_max(float v) {
#pragma unroll
    for (int o = 1; o < 64; o <<= 1) v = fmaxf(v, __shfl_xor(v, o));
    return v;
}
DI float siluf(float x) { return x / (1.f + __expf(-x)); }
DI float sigmf(float x) { return 1.f / (1.f + __expf(-x)); }

constexpr size_t MiB = 1u << 20;
constexpr size_t WS_CTL = 0, CTL_ZERO_BYTES = 64 * 1024;
constexpr size_t WS_GATES = 1 * MiB;
constexpr size_t WS_MK = 3 * MiB;
constexpr size_t WS_MV = 4 * MiB;
constexpr size_t WS_KCMP = 5 * MiB;
constexpr size_t WS_VCMP = 5 * MiB + 512 * 1024;
constexpr size_t WS_OA = 80 * MiB;
constexpr size_t WS_Q = 112 * MiB;
constexpr size_t WS_KV = 128 * MiB;
constexpr size_t WS_RET = 172 * MiB;
constexpr size_t WS_END = 256 * MiB;
constexpr size_t KV_STRIDE = (size_t)NB * NG * NS * DH;
constexpr size_t RET_STRIDE = (size_t)NB * NHR * NS * DH;

#define XB_TMO      128
#define XB_XCNT(j)  (256  + 64 * (j))
#define XB_XSUB(j)  (1280 + 64 * (j))
#define XB_XGEN(j)  (2304 + 64 * (j))
#define XB_TOP      3328
#define XB_TOPGEN   3392
#define XCD_BAR_WORDS 3456
#define XB_SPIN_CAP (1u << 22)
DI unsigned xb_ld(unsigned* p)              { return __hip_atomic_load(p, __ATOMIC_RELAXED, __HIP_MEMORY_SCOPE_AGENT); }
DI unsigned xb_add(unsigned* p, unsigned v) { return __hip_atomic_fetch_add(p, v, __ATOMIC_RELAXED, __HIP_MEMORY_SCOPE_AGENT); }
DI unsigned xb_xcc_id() { return (unsigned)__builtin_amdgcn_s_getreg((3 << 11) | 20) & 0xFu; }
#define XB_SPIN(cond, bar) do { unsigned _sp = 0; while (cond) { __builtin_amdgcn_s_sleep(1); \
    if ((++_sp & 255u) == 0u) { if (xb_ld(&(bar)[XB_TMO])) break; if (_sp > XB_SPIN_CAP) { atomicAdd(&(bar)[XB_TMO], 1u); break; } } } } while (0)
struct XcdBarrier { unsigned* bar; unsigned x; volatile LAS unsigned* st; };
DI XcdBarrier xcd_barrier_post(unsigned* bar, volatile LAS unsigned* st) {
    XcdBarrier b; b.bar = bar; b.x = xb_xcc_id(); b.st = st;
    if (threadIdx.x == 0) (void)xb_add(&bar[XB_XCNT(b.x)], 1u);
    return b;
}
DI void xcd_barrier_complete(unsigned* bar, unsigned x, unsigned& nloc, unsigned& nx) {
    const unsigned G = gridDim.x * gridDim.y * gridDim.z;
    unsigned sum, cnt, mine, sp = 0u;
    for (;;) {
        sum = 0u; cnt = 0u; mine = 0u;
#pragma unroll
        for (unsigned j = 0; j < 16; ++j) { const unsigned c = xb_ld(&bar[XB_XCNT(j)]); sum += c; cnt += (c > 0u) ? 1u : 0u; mine = (j == x) ? c : mine; }
        if (sum == G) break;
        __builtin_amdgcn_s_sleep(1);
        if ((++sp & 255u) == 0u) { if (xb_ld(&bar[XB_TMO])) break; if (sp > XB_SPIN_CAP) { atomicAdd(&bar[XB_TMO], 1u); break; } }
    }
    nloc = mine > 0u ? mine : 1u; nx = cnt > 0u ? cnt : 1u;
}
DI void xcd_barrier(const XcdBarrier& b) {
    asm volatile("s_waitcnt vmcnt(0)" ::: "memory");
    __syncthreads();
    if (threadIdx.x == 0) {
        unsigned* bar = b.bar;
        __builtin_amdgcn_s_waitcnt(0);
        unsigned nloc = b.st[0], nx = b.st[1];
        if (nloc == 0u) { xcd_barrier_complete(bar, b.x, nloc, nx); b.st[0] = nloc; b.st[1] = nx; }
        const unsigned old = xb_add(&bar[XB_XSUB(b.x)], 1u);
        const unsigned gen = old / nloc;
        if (old + 1u == (gen + 1u) * nloc) {
            __builtin_amdgcn_fence(__ATOMIC_RELEASE, "agent");
            asm volatile("s_waitcnt vmcnt(0)" ::: "memory");
            const unsigned og = xb_add(&bar[XB_TOP], 1u);
            const unsigned tg = og / nx;
            if (og + 1u == (tg + 1u) * nx) xb_add(&bar[XB_TOPGEN], 1u);
            else XB_SPIN(xb_ld(&bar[XB_TOPGEN]) == tg, bar);
            __builtin_amdgcn_fence(__ATOMIC_ACQUIRE, "agent");
            xb_add(&bar[XB_XGEN(b.x)], 1u);
            asm volatile("s_waitcnt vmcnt(0)" ::: "memory");
        } else {
            XB_SPIN(xb_ld(&bar[XB_XGEN(b.x)]) == gen, bar);
            __builtin_amdgcn_fence(__ATOMIC_ACQUIRE, "agent");
            asm volatile("s_waitcnt vmcnt(0)" ::: "memory");
        }
    }
    __syncthreads();
}

struct Args {
    const float* in[32];
    float* out;
    unsigned char* ws;
};
enum {
    I_X = 0, I_MEM, I_MIXN, I_WIN, I_QN, I_KCN, I_KSN, I_KWN, I_POSK, I_POSV, I_CKW1, I_CKW2, I_CVW1, I_CVW2,
    I_NSAON, I_RETON, I_WOUT, I_MXN, I_MKVN, I_MWQ, I_MWKV, I_MQN, I_MKN, I_MWO, I_FFN, I_RGW, I_RGB, I_REW, I_REB,
    I_EWG, I_EWU, I_EWD
};

constexpr int LDS_BYTES = 147456;
constexpr int LDS_MISC = 147456 - 256;

DI void phase_proj(const Args& a, float* lds) {
    const int tid = threadIdx.x, lane = tid & 63, wv = tid >> 6;
    float* xs = lds;
    float* pr = lds + 4 * 1024;
    const float* x = a.in[I_X]; const float* w_in = a.in[I_WIN]; const float* mixn = a.in[I_MIXN];
    bf16_t* Q = (bf16_t*)(a.ws + WS_Q); bf16_t* KV = (bf16_t*)(a.ws + WS_KV); bf16_t* RET = (bf16_t*)(a.ws + WS_RET);
    float* GATES = (float*)(a.ws + WS_GATES);
    for (int tg = blockIdx.x; tg < NT / 4; tg += gridDim.x) {
        __syncthreads();
        if (wv < 4) {
            const float* xr = x + (size_t)(tg * 4 + wv) * DM;
            float v[16]; float ss = 0.f;
#pragma unroll
            for (int i = 0; i < 16; ++i) { v[i] = xr[lane + 64 * i]; ss += v[i] * v[i]; }
            ss = wave_sum(ss);
            const float rstd = rsqrtf(ss * (1.f / DM) + EPS);
#pragma unroll
            for (int i = 0; i < 16; ++i) xs[wv * 1024 + lane + 64 * i] = v[i] * rstd * mixn[lane + 64 * i];
        }
        __syncthreads();
        float acc[7][4];
#pragma unroll
        for (int i = 0; i < 7; ++i)
#pragma unroll
            for (int k = 0; k < 4; ++k) acc[i][k] = 0.f;
        for (int d = 0; d < DM; d += 2) {
            float w0[7], w1[7];
#pragma unroll
            for (int i = 0; i < 7; ++i) { const int c = tid + 512 * i; w0[i] = (c < PROJ) ? w_in[(size_t)d * PROJ + c] : 0.f; w1[i] = (c < PROJ) ? w_in[(size_t)(d + 1) * PROJ + c] : 0.f; }
            float xa[4], xb[4];
#pragma unroll
            for (int k = 0; k < 4; ++k) { xa[k] = xs[k * 1024 + d]; xb[k] = xs[k * 1024 + d + 1]; }
#pragma unroll
            for (int i = 0; i < 7; ++i)
#pragma unroll
                for (int k = 0; k < 4; ++k) { acc[i][k] += xa[k] * w0[i]; acc[i][k] += xb[k] * w1[i]; }
        }
#pragma unroll
        for (int i = 0; i < 7; ++i) { const int c = tid + 512 * i; if (c < PROJ) {
#pragma unroll
            for (int k = 0; k < 4; ++k) pr[k * PROJ + c] = acc[i][k]; } }
        __syncthreads();
        if (tid < 208) {
            const int k = tid / 52, v = tid % 52; const int t = tg * 4 + k, b = t / NS, s = t % NS;
            const float* p = pr + k * PROJ;
            if (v < 8) {
                const float* src = p + v * 64; float ss = 0.f;
                for (int d = 0; d < 64; ++d) ss += src[d] * src[d];
                const float rstd = rsqrtf(ss * (1.f / 64.f) + EPS) * 0.125f;
                bf16_t* dst = Q + (size_t)t * 512 + v * 64;
                for (int d = 0; d < 64; ++d) dst[d] = f2bf(src[d] * rstd * a.in[I_QN][d]);
            } else if (v < 20) {
                const int i = (v - 8) >> 1, g = (v - 8) & 1;
                const float* src = p + 512 + i * 128 + g * 64;
                bf16_t* dst = KV + (size_t)i * KV_STRIDE + ((size_t)(b * NG + g) * NS + s) * DH;
                if (i == 2 || i == 4) {
                    const float* gn = (i == 2) ? a.in[I_KSN] : a.in[I_KWN]; float ss = 0.f;
                    for (int d = 0; d < 64; ++d) ss += src[d] * src[d];
                    const float rstd = rsqrtf(ss * (1.f / 64.f) + EPS);
                    for (int d = 0; d < 64; ++d) dst[d] = f2bf(src[d] * rstd * gn[d]);
                } else {
                    for (int d = 0; d < 64; ++d) dst[d] = f2bf(src[d]);
                }
            } else {
                const int rr = (v - 20) >> 3, h = (v - 20) & 7;
                const float* src = p + 1304 + rr * 512 + h * 64;
                bf16_t* dst = RET + (size_t)rr * RET_STRIDE + ((size_t)(b * NHR + h) * NS + s) * DH;
                if (rr < 2) {
                    const float sc = (rr == 1) ? 0.125f : 1.f;
                    for (int i2 = 0; i2 < 32; ++i2) {
                        const float inv = exp2f(-(float)i2 * (13.287712379549449f / 32.f));
                        float sn, cs; sincosf((float)s * inv, &sn, &cs);
                        const float x1 = src[i2], x2 = src[i2 + 32];
                        dst[i2] = f2bf((x1 * cs - x2 * sn) * sc); dst[i2 + 32] = f2bf((x1 * sn + x2 * cs) * sc);
                    }
                } else {
                    for (int d = 0; d < 64; ++d) dst[d] = f2bf(src[d]);
                }
            }
        } else if (tid >= 256 && tid < 256 + 96) {
            const int k = (tid - 256) / 24, j = (tid - 256) % 24; const int t = tg * 4 + k;
            GATES[(size_t)t * 24 + j] = pr[k * PROJ + 1280 + j];
        }
    }
}

DI void phase_memkv(const Args& a, float* lds) {
    const int tid = threadIdx.x, lane = tid & 63, wv = tid >> 6;
    float* hm = lds; float* red = lds + 1024; float* kv = lds + 1100;
    const float* mem = a.in[I_MEM]; const float* wkv = a.in[I_MWKV];
    bf16_t* MK = (bf16_t*)(a.ws + WS_MK); bf16_t* MV = (bf16_t*)(a.ws + WS_MV);
    for (int r = blockIdx.x; r < NB * NMEM; r += gridDim.x) {
        __syncthreads();
        const float* xr = mem + (size_t)r * DM;
        const float v0 = xr[tid], v1 = xr[tid + 512];
        float ss = wave_sum(v0 * v0 + v1 * v1);
        if (lane == 0) red[wv] = ss;
        __syncthreads();
        float tot = 0.f;
#pragma unroll
        for (int i = 0; i < 8; ++i) tot += red[i];
        const float rstd = rsqrtf(tot * (1.f / DM) + EPS);
        hm[tid] = v0 * rstd * a.in[I_MKVN][tid]; hm[tid + 512] = v1 * rstd * a.in[I_MKVN][tid + 512];
        __syncthreads();
        float acc = 0.f;
        for (int d = 0; d < DM; ++d) acc += hm[d] * wkv[(size_t)d * 512 + tid];
        kv[tid] = acc;
        __syncthreads();
        const int b = r / NMEM, m = r % NMEM;
        if (tid < 4) {
            const float* src = kv + tid * 64; float s2 = 0.f;
            for (int d = 0; d < 64; ++d) s2 += src[d] * src[d];
            const float rs = rsqrtf(s2 * (1.f / 64.f) + EPS);
            bf16_t* dst = MK + ((size_t)(b * MH + tid) * NMEM + m) * DH;
            for (int d = 0; d < 64; ++d) dst[d] = f2bf(src[d] * rs * a.in[I_MKN][d]);
        } else if (tid >= 64 && tid < 68) {
            const int h = tid - 64; const float* src = kv + 256 + h * 64;
            bf16_t* dst = MV + ((size_t)(b * MH + h) * NMEM + m) * DH;
            for (int d = 0; d < 64; ++d) dst[d] = f2bf(src[d]);
        }
    }
}

DI void phase_compress(const Args& a, float* lds) {
    const int tid = threadIdx.x;
    float* blk = lds;
    float* part = lds + 2048;
    float* hid = lds + 2048 + 512;
    float* outv = hid + 128;
    const bf16_t* KV = (const bf16_t*)(a.ws + WS_KV);
    bf16_t* KCMP = (bf16_t*)(a.ws + WS_KCMP); bf16_t* VCMP = (bf16_t*)(a.ws + WS_VCMP);
    const int nunit = 2 * NB * NG * 128;
    for (int u = blockIdx.x; u < nunit; u += gridDim.x) {
        const int kvsel = u / (NB * NG * 128), rem = u % (NB * NG * 128), bg = rem / 128, c = rem % 128;
        bf16_t* dst = (kvsel == 0 ? KCMP : VCMP) + ((size_t)bg * 128 + c) * DH;
        if (c == 127) { if (tid < 64) dst[tid] = 0; continue; }
        __syncthreads();
        const bf16_t* src = KV + (size_t)kvsel * KV_STRIDE + ((size_t)bg * NS + 16 * c) * DH;
        const float* pos = a.in[kvsel == 0 ? I_POSK : I_POSV];
        const float* w1 = a.in[kvsel == 0 ? I_CKW1 : I_CVW1];
        const float* w2 = a.in[kvsel == 0 ? I_CKW2 : I_CVW2];
#pragma unroll
        for (int i = 0; i < 4; ++i) { const int f = tid + 512 * i; blk[f] = bf2f(src[f]) + pos[f]; }
        __syncthreads();
        { const int j = tid & 127, pt = tid >> 7; float acc = 0.f;
          for (int f = pt * 512; f < pt * 512 + 512; ++f) acc += blk[f] * w1[(size_t)f * 128 + j];
          part[tid] = acc; }
        __syncthreads();
        if (tid < 128) { const float h = part[tid] + part[tid + 128] + part[tid + 256] + part[tid + 384]; hid[tid] = siluf(h); }
        __syncthreads();
        if (tid < 64) { float acc = 0.f; for (int j = 0; j < 128; ++j) acc += hid[j] * w2[j * 64 + tid]; outv[tid] = acc; }
        __syncthreads();
        if (tid < 64) {
            float v = outv[tid];
            if (kvsel == 0) { float ss = 0.f; for (int d = 0; d < 64; ++d) ss += outv[d] * outv[d]; v = v * rsqrtf(ss * (1.f / 64.f) + EPS) * a.in[I_KCN][tid]; }
            dst[tid] = f2bf(v);
        }
    }
}

DI void softmax_rows4(float* sc, int ld, int n, int wv, int lane) {
    if (wv < 4) {
        float* row = sc + wv * ld; float m = -1e30f;
        for (int i = lane; i < n; i += 64) m = fmaxf(m, row[i]);
        m = wave_max(m);
        float s = 0.f;
        for (int i = lane; i < n; i += 64) { const float v = row[i]; const float e = (v > -1e29f) ? __expf(v - m) : 0.f; row[i] = e; s += e; }
        s = wave_sum(s);
        const float inv = 1.f / fmaxf(s, 1e-30f);
        for (int i = lane; i < n; i += 64) row[i] *= inv;
    }
}
DI void phase_nsa(const Args& a, float* lds) {
    const int tid = threadIdx.x, lane = tid & 63, wv = tid >> 6;
    float* q = lds;
    float* sc = lds + 256;
    float* psum = sc + 2048;
    float* imp = psum + 128;
    float* oacc = imp + 32;
    int* sel = (int*)(oacc + 768);
    float* ofin = (float*)(sel + 8);
    const bf16_t* Q = (const bf16_t*)(a.ws + WS_Q); const bf16_t* KV = (const bf16_t*)(a.ws + WS_KV);
    const bf16_t* KCMP = (const bf16_t*)(a.ws + WS_KCMP); const bf16_t* VCMP = (const bf16_t*)(a.ws + WS_VCMP);
    const float* GATES = (const float*)(a.ws + WS_GATES);
    bf16_t* OA = (bf16_t*)(a.ws + WS_OA);
    for (int u = blockIdx.x; u < NT * NG; u += gridDim.x) {
        const int t = u >> 1, g = u & 1, b = t / NS, s = t % NS, bg = b * NG + g;
        __syncthreads();
        if (tid < 256) q[tid] = bf2f(Q[(size_t)t * 512 + g * 256 + tid]);
        __syncthreads();
        const int ncv = (s >= 31) ? min(NCMP, (s - 31) / 16 + 1) : 0;
        { const int r = tid >> 7, c = tid & 127; float v = -1e30f;
          if (c < ncv) { const bf16_t* kr = KCMP + ((size_t)bg * 128 + c) * DH; float d = 0.f; for (int i = 0; i < 64; ++i) d += q[r * 64 + i] * bf2f(kr[i]); v = d; }
          sc[r * 512 + c] = v; }
        __syncthreads();
        softmax_rows4(sc, 512, 128, wv, lane);
        __syncthreads();
        if (tid < 128) psum[tid] = sc[tid] + sc[512 + tid] + sc[1024 + tid] + sc[1536 + tid];
        if (tid >= 256) { const int r = (tid - 256) >> 6, d = tid & 63; float acc = 0.f;
            for (int c = 0; c < ncv; ++c) acc += sc[r * 512 + c] * bf2f(VCMP[((size_t)bg * 128 + c) * DH + d]);
            oacc[r * 64 + d] = acc; }
        __syncthreads();
        const int cur = s / 64;
        if (tid < 32) { const int j = tid; float v = 0.f;
            if (4 * j - 1 >= 0) v += 0.5f * psum[4 * j - 1];
            v += psum[4 * j] + psum[4 * j + 1] + psum[4 * j + 2];
            if (4 * j + 3 < NCMP) v += 0.5f * psum[4 * j + 3];
            if (j == 0 || j == cur || j == cur - 1) v = 1e9f; else if (j > cur) v = -1e30f;
            imp[j] = v; }
        __syncthreads();
        if (tid == 0) {
            unsigned used = 0u;
            for (int k = 0; k < TOPK; ++k) { int best = -1; float bv = 0.f;
                for (int j = 0; j < NSEL; ++j) if (!((used >> j) & 1u)) { if (best < 0 || imp[j] > bv) { best = j; bv = imp[j]; } }
                used |= 1u << best; sel[k] = best; }
        }
        __syncthreads();
        { const int kk = tid >> 6, i = tid & 63; const int kpos = sel[kk] * 64 + i;
          const bf16_t* kr = KV + 2 * KV_STRIDE + ((size_t)bg * NS + kpos) * DH;
          float d0 = 0.f, d1 = 0.f, d2 = 0.f, d3 = 0.f;
          if (kpos <= s) { for (int e = 0; e < 64; ++e) { const float kvv = bf2f(kr[e]); d0 += q[e] * kvv; d1 += q[64 + e] * kvv; d2 += q[128 + e] * kvv; d3 += q[192 + e] * kvv; } }
          else { d0 = d1 = d2 = d3 = -1e30f; }
          sc[tid] = d0; sc[512 + tid] = d1; sc[1024 + tid] = d2; sc[1536 + tid] = d3; }
        __syncthreads();
        softmax_rows4(sc, 512, 512, wv, lane);
        __syncthreads();
        if (tid < 256) { const int r = tid >> 6, d = tid & 63; float acc = 0.f;
            for (int k = 0; k < 512; ++k) { const float p = sc[r * 512 + k]; if (p != 0.f) { const int kpos = sel[k >> 6] * 64 + (k & 63); acc += p * bf2f(KV[3 * KV_STRIDE + ((size_t)bg * NS + kpos) * DH + d]); } }
            oacc[256 + r * 64 + d] = acc; }
        __syncthreads();
        { const int kpos = s - 511 + tid;
          const bf16_t* kr = KV + 4 * KV_STRIDE + ((size_t)bg * NS + kpos) * DH;
          float d0 = 0.f, d1 = 0.f, d2 = 0.f, d3 = 0.f;
          if (kpos >= 0) { for (int e = 0; e < 64; ++e) { const float kvv = bf2f(kr[e]); d0 += q[e] * kvv; d1 += q[64 + e] * kvv; d2 += q[128 + e] * kvv; d3 += q[192 + e] * kvv; } }
          else { d0 = d1 = d2 = d3 = -1e30f; }
          sc[tid] = d0; sc[512 + tid] = d1; sc[1024 + tid] = d2; sc[1536 + tid] = d3; }
        __syncthreads();
        softmax_rows4(sc, 512, 512, wv, lane);
        __syncthreads();
        if (tid < 256) { const int r = tid >> 6, d = tid & 63; float acc = 0.f;
            for (int k = 0; k < 512; ++k) { const float p = sc[r * 512 + k]; if (p != 0.f) { const int kpos = s - 511 + k; acc += p * bf2f(KV[5 * KV_STRIDE + ((size_t)bg * NS + kpos) * DH + d]); } }
            oacc[512 + r * 64 + d] = acc; }
        __syncthreads();
        if (tid < 256) { const int r = tid >> 6, d = tid & 63;
            const float* gt = GATES + (size_t)t * 24 + g * 12 + r * 3;
            ofin[tid] = sigmf(gt[0]) * oacc[tid] + sigmf(gt[1]) * oacc[256 + tid] + sigmf(gt[2]) * oacc[512 + tid]; }
        __syncthreads();
        if (tid < 256) { const int r = tid >> 6, d = tid & 63; float ss = 0.f;
            for (int e = 0; e < 64; ++e) ss += ofin[r * 64 + e] * ofin[r * 64 + e];
            const int h = g * 4 + r;
            OA[(size_t)t * 1024 + h * 64 + d] = f2bf(ofin[tid] * rsqrtf(ss * (1.f / 64.f) + EPS) * a.in[I_NSAON][h * 64 + d]); }
    }
}

DI void phase_ret(const Args& a, float* lds) {
    const int tid = threadIdx.x;
    float* qv = lds;
    float* wts = lds + 64;
    float* part = wts + 2048;
    float* yv = part + 512;
    const bf16_t* RET = (const bf16_t*)(a.ws + WS_RET);
    bf16_t* OA = (bf16_t*)(a.ws + WS_OA);
    for (int u = blockIdx.x; u < NB * NHR * NS; u += gridDim.x) {
        const int s = u % NS, bh = u / NS, h = bh % NHR, b = bh / NHR;
        const float l2g = log2f(1.f - exp2f(-5.f - (float)h));
        __syncthreads();
        if (tid < 64) qv[tid] = bf2f(RET[((size_t)bh * NS + s) * DH + tid]);
        __syncthreads();
        for (int j = tid; j <= s; j += 512) {
            const bf16_t* kr = RET + RET_STRIDE + ((size_t)bh * NS + j) * DH; float d = 0.f;
            for (int e = 0; e < 64; ++e) d += qv[e] * bf2f(kr[e]);
            wts[j] = d * exp2f((float)(s - j) * l2g);
        }
        __syncthreads();
        { const int d = tid & 63, pt = tid >> 6; float acc = 0.f;
          for (int j = pt; j <= s; j += 8) acc += wts[j] * bf2f(RET[2 * RET_STRIDE + ((size_t)bh * NS + j) * DH + d]);
          part[pt * 64 + d] = acc; }
        __syncthreads();
        if (tid < 64) { float y = 0.f; for (int p = 0; p < 8; ++p) y += part[p * 64 + tid]; yv[tid] = y; }
        __syncthreads();
        if (tid < 64) {
            float mu = 0.f; for (int e = 0; e < 64; ++e) mu += yv[e]; mu *= (1.f / 64.f);
            float var = 0.f; for (int e = 0; e < 64; ++e) { const float dd = yv[e] - mu; var += dd * dd; } var *= (1.f / 64.f);
            const float gr = bf2f(RET[3 * RET_STRIDE + ((size_t)bh * NS + s) * DH + tid]);
            const float y = (yv[tid] - mu) * rsqrtf(var + EPS) * a.in[I_RETON][h * 64 + tid] * siluf(gr);
            OA[(size_t)(b * NS + s) * 1024 + 512 + h * 64 + tid] = f2bf(y);
        }
    }
}

DI void phase_tail(const Args& a, float* lds) {
    const int tid = threadIdx.x, lane = tid & 63, wv = tid >> 6;
    constexpr int TK = 4;
    float* oa = lds;
    float* x1 = oa + TK * 1024;
    float* qb = x1 + TK * 1024;
    float* ob = qb + TK * 256;
    float* scm = ob + TK * 256;
    float* tmp = scm + TK * 1024;
    float* hidb = tmp + TK * 512;
    float* lg = hidb + 256;
    float* rs = lg + TK * 36;
    int* eid = (int*)(rs + TK);
    float* ew = (float*)(eid + TK * 2);
    const float* x = a.in[I_X];
    const bf16_t* OA = (const bf16_t*)(a.ws + WS_OA);
    const bf16_t* MK = (const bf16_t*)(a.ws + WS_MK); const bf16_t* MV = (const bf16_t*)(a.ws + WS_MV);
    const float* w_out = a.in[I_WOUT]; const float* wq = a.in[I_MWQ]; const float* wo = a.in[I_MWO];
    for (int tg = blockIdx.x; tg < NT / TK; tg += gridDim.x) {
        const int t0 = tg * TK, b = t0 / NS;
        __syncthreads();
        for (int i = tid; i < TK * 1024; i += 512) oa[i] = bf2f(OA[(size_t)t0 * 1024 + i]);
        __syncthreads();
        { float acc[2][TK];
#pragma unroll
          for (int i = 0; i < 2; ++i)
#pragma unroll
              for (int k = 0; k < TK; ++k) acc[i][k] = 0.f;
#pragma unroll 4
          for (int j = 0; j < 1024; ++j) { const float w0 = w_out[(size_t)j * 1024 + tid], w1 = w_out[(size_t)j * 1024 + tid + 512];
#pragma unroll
              for (int k = 0; k < TK; ++k) { const float o = oa[k * 1024 + j]; acc[0][k] += o * w0; acc[1][k] += o * w1; } }
#pragma unroll
          for (int k = 0; k < TK; ++k) { x1[k * 1024 + tid] = x[(size_t)(t0 + k) * 1024 + tid] + acc[0][k]; x1[k * 1024 + tid + 512] = x[(size_t)(t0 + k) * 1024 + tid + 512] + acc[1][k]; } }
        __syncthreads();
        if (wv < TK) { float ss = 0.f; for (int i = lane; i < 1024; i += 64) ss += x1[wv * 1024 + i] * x1[wv * 1024 + i]; ss = wave_sum(ss); if (lane == 0) rs[wv] = rsqrtf(ss * (1.f / DM) + EPS); }
        __syncthreads();
        for (int i = tid; i < TK * 1024; i += 512) oa[i] = x1[i] * rs[i >> 10] * a.in[I_MXN][i & 1023];
        __syncthreads();
        { const int j = tid & 255, hf = tid >> 8; float acc[TK];
#pragma unroll
          for (int k = 0; k < TK; ++k) acc[k] = 0.f;
#pragma unroll 4
          for (int d = hf * 512; d < hf * 512 + 512; ++d) { const float w = wq[(size_t)d * 256 + j];
#pragma unroll
              for (int k = 0; k < TK; ++k) acc[k] += oa[k * 1024 + d] * w; }
#pragma unroll
          for (int k = 0; k < TK; ++k) tmp[k * 512 + tid] = acc[k]; }
        __syncthreads();
        for (int i = tid; i < TK * 256; i += 512) { const int k = i >> 8, j = i & 255; qb[i] = tmp[k * 512 + j] + tmp[k * 512 + 256 + j]; }
        __syncthreads();
        if (tid < TK * 4) { float* src = qb + tid * 64; float ss = 0.f; for (int d = 0; d < 64; ++d) ss += src[d] * src[d];
            const float r = rsqrtf(ss * (1.f / 64.f) + EPS) * 0.125f; for (int d = 0; d < 64; ++d) src[d] = src[d] * r * a.in[I_MQN][d]; }
        __syncthreads();
        { const int h = tid >> 7, m0 = (tid & 127) * 2;
#pragma unroll
          for (int mm = 0; mm < 2; ++mm) { const int m = m0 + mm; const bf16_t* kr = MK + ((size_t)(b * MH + h) * NMEM + m) * DH; float acc[TK];
#pragma unroll
              for (int k = 0; k < TK; ++k) acc[k] = 0.f;
#pragma unroll 8
              for (int d = 0; d < 64; ++d) { const float kv = bf2f(kr[d]);
#pragma unroll
                  for (int k = 0; k < TK; ++k) acc[k] += qb[k * 256 + h * 64 + d] * kv; }
#pragma unroll
              for (int k = 0; k < TK; ++k) scm[(k * 4 + h) * 256 + m] = acc[k]; } }
        __syncthreads();
        for (int row = wv; row < TK * 4; row += 8) { float* r = scm + row * 256; float m = -1e30f;
            for (int i = lane; i < 256; i += 64) m = fmaxf(m, r[i]); m = wave_max(m);
            float s = 0.f; for (int i = lane; i < 256; i += 64) { const float e = __expf(r[i] - m); r[i] = e; s += e; } s = wave_sum(s);
            const float inv = 1.f / s; for (int i = lane; i < 256; i += 64) r[i] *= inv; }
        __syncthreads();
        { const int hd = tid & 255, h = hd >> 6, d = hd & 63, k0 = (tid >> 8) * 2; float a0 = 0.f, a1 = 0.f;
#pragma unroll 4
          for (int m = 0; m < 256; ++m) { const float v = bf2f(MV[((size_t)(b * MH + h) * NMEM + m) * DH + d]); a0 += scm[((k0) * 4 + h) * 256 + m] * v; a1 += scm[((k0 + 1) * 4 + h) * 256 + m] * v; }
          ob[k0 * 256 + hd] = a0; ob[(k0 + 1) * 256 + hd] = a1; }
        __syncthreads();
        { float acc[2][TK];
#pragma unroll
          for (int i = 0; i < 2; ++i)
#pragma unroll
              for (int k = 0; k < TK; ++k) acc[i][k] = 0.f;
#pragma unroll 4
          for (int j = 0; j < 256; ++j) { const float w0 = wo[(size_t)j * 1024 + tid], w1 = wo[(size_t)j * 1024 + tid + 512];
#pragma unroll
              for (int k = 0; k < TK; ++k) { const float o = ob[k * 256 + j]; acc[0][k] += o * w0; acc[1][k] += o * w1; } }
          __syncthreads();
#pragma unroll
          for (int k = 0; k < TK; ++k) { x1[k * 1024 + tid] += acc[0][k]; x1[k * 1024 + tid + 512] += acc[1][k]; } }
        __syncthreads();
        if (wv < TK) { float ss = 0.f; for (int i = lane; i < 1024; i += 64) ss += x1[wv * 1024 + i] * x1[wv * 1024 + i]; ss = wave_sum(ss); if (lane == 0) rs[wv] = rsqrtf(ss * (1.f / DM) + EPS); }
        __syncthreads();
        for (int i = tid; i < TK * 1024; i += 512) oa[i] = x1[i] * rs[i >> 10] * a.in[I_FFN][i & 1023];
        __syncthreads();
        for (int dd = wv; dd < TK * 36; dd += 8) { const int k = dd / 36, j = dd % 36; float acc = 0.f;
            if (j < 4) { for (int d = lane; d < 1024; d += 64) acc += oa[k * 1024 + d] * a.in[I_RGW][d * 4 + j]; }
            else { const int gg = (j - 4) >> 3, e = (j - 4) & 7; for (int d = lane; d < 1024; d += 64) acc += oa[k * 1024 + d] * a.in[I_REW][((size_t)gg * 1024 + d) * 8 + e]; }
            acc = wave_sum(acc);
            if (lane == 0) lg[dd] = acc + (j < 4 ? a.in[I_RGB][j] : a.in[I_REB][j - 4]); }
        __syncthreads();
        if (tid < TK) { const float* l = lg + tid * 36; int grp = 0; float gm = l[0];
            for (int j = 1; j < 4; ++j) if (l[j] > gm) { gm = l[j]; grp = j; }
            float gs = 0.f; for (int j = 0; j < 4; ++j) gs += __expf(l[j] - gm);
            const float gw = 1.f / gs;
            const float* el = l + 4 + grp * 8; int e0 = 0; float v0 = el[0];
            for (int j = 1; j < 8; ++j) if (el[j] > v0) { v0 = el[j]; e0 = j; }
            int e1 = -1; float v1 = 0.f;
            for (int j = 0; j < 8; ++j) if (j != e0) { if (e1 < 0 || el[j] > v1) { v1 = el[j]; e1 = j; } }
            const float p1 = __expf(v1 - v0); const float den = 1.f + p1;
            eid[tid * 2] = grp * 8 + e0; eid[tid * 2 + 1] = grp * 8 + e1; ew[tid * 2] = gw / den; ew[tid * 2 + 1] = gw * p1 / den; }
        __syncthreads();
        float yacc[2][TK];
#pragma unroll
        for (int i = 0; i < 2; ++i)
#pragma unroll
            for (int k = 0; k < TK; ++k) yacc[i][k] = 0.f;
#pragma unroll
        for (int k = 0; k < TK; ++k) {
            for (int kk = 0; kk < 2; ++kk) {
                const int e = eid[k * 2 + kk]; const float wgt = ew[k * 2 + kk];
                { const int f = tid & 255, hf = tid >> 8; const float* W = (hf == 0 ? a.in[I_EWG] : a.in[I_EWU]) + (size_t)e * 1024 * 256; float acc = 0.f;
#pragma unroll 8
                  for (int d = 0; d < 1024; ++d) acc += oa[k * 1024 + d] * W[(size_t)d * 256 + f];
                  tmp[tid] = acc; }
                __syncthreads();
                if (tid < 256) hidb[tid] = siluf(tmp[tid]) * tmp[256 + tid];
                __syncthreads();
                { const float* W = a.in[I_EWD] + (size_t)e * 256 * 1024; float a0 = 0.f, a1 = 0.f;
#pragma unroll 4
                  for (int f = 0; f < 256; ++f) { const float hv = hidb[f]; a0 += hv * W[(size_t)f * 1024 + tid]; a1 += hv * W[(size_t)f * 1024 + tid + 512]; }
                  yacc[0][k] += wgt * a0; yacc[1][k] += wgt * a1; }
                __syncthreads();
            }
        }
#pragma unroll
        for (int k = 0; k < TK; ++k) { a.out[(size_t)(t0 + k) * 1024 + tid] = x1[k * 1024 + tid] + yacc[0][k]; a.out[(size_t)(t0 + k) * 1024 + tid + 512] = x1[k * 1024 + tid + 512] + yacc[1][k]; }
    }
}

__global__ void __launch_bounds__(NTHR, 2) fwd_kernel(Args a) {
    extern __shared__ __attribute__((aligned(16))) unsigned char lds_raw[];
    float* lds = (float*)lds_raw;
    volatile LAS unsigned* misc = (volatile LAS unsigned*)((LAS unsigned char*)lds_raw + LDS_MISC);
    if (threadIdx.x < 64) misc[threadIdx.x] = 0u;
    __syncthreads();
    XcdBarrier bar = xcd_barrier_post((unsigned*)(a.ws + WS_CTL), misc + 8);

    phase_proj(a, lds);
    phase_memkv(a, lds);
    xcd_barrier(bar);
    phase_compress(a, lds);
    xcd_barrier(bar);
    phase_nsa(a, lds);
    phase_ret(a, lds);
    xcd_barrier(bar);
    phase_tail(a, lds);
}

extern "C" void kernel_launch(void* const* d_in, const int* in_sizes, int n_in, void* d_out, int out_size, void* d_ws, size_t ws_size, hipStream_t stream) {
    static int grid = 0;
    if (grid == 0) {
        if (n_in != 32 || ws_size < WS_END) { fprintf(stderr, "kernel_launch: unexpected n_in %d / ws %zu\n", n_in, ws_size); grid = -1; return; }
        int dev = 0, cus = 0, per_cu = 0;
        if (hipGetDevice(&dev) != hipSuccess || hipDeviceGetAttribute(&cus, hipDeviceAttributeMultiprocessorCount, dev) != hipSuccess) { grid = -1; return; }
        if (hipFuncSetAttribute((const void*)fwd_kernel, hipFuncAttributeMaxDynamicSharedMemorySize, LDS_BYTES) != hipSuccess) { fprintf(stderr, "kernel_launch: hipFuncSetAttribute failed\n"); grid = -1; return; }
        if (hipOccupancyMaxActiveBlocksPerMultiprocessor(&per_cu, (const void*)fwd_kernel, NTHR, LDS_BYTES) != hipSuccess || per_cu < 1) { fprintf(stderr, "kernel_launch: occupancy query says %d blocks per CU\n", per_cu); (void)hipGetLastError(); grid = -1; return; }
        grid = cus;
    }
    if (grid < 0) return;
    (void)hipMemsetAsync((char*)d_ws + WS_CTL, 0, CTL_ZERO_BYTES, stream);
    Args a{};
    for (int i = 0; i < 32; ++i) a.in[i] = (const float*)d_in[i];
    a.out = (float*)d_out; a.ws = (unsigned char*)d_ws;
    hipLaunchKernelGGL(fwd_kernel, dim3(grid), dim3(NTHR), LDS_BYTES, stream, a);
}
```

```cpp
#include <hip/hip_runtime.h>
#include <cstdint>
#include <cstdio>

#define DI __device__ __forceinline__
#define LAS __attribute__((address_space(3)))
#define GAS __attribute__((address_space(1)))

constexpr int NB = 8, NS = 2048, DM = 1024, NT = NB * NS;
constexpr int NG = 2, NR = 4, DH = 64, NHA = 8, NHR = 8;
constexpr int PROJ = 3352;
constexpr int NCMP = 127, NSEL = 32, TOPK = 8, WIN = 512;
constexpr int NMEM = 256, MH = 4, MW = 256;
constexpr int NGRP = 4, EPG = 8, NEXP = 32, EFF = 256;
constexpr float EPS = 1e-6f;
constexpr int NTHR = 512, NWAVE = 8;

typedef unsigned short bf16_t;

DI int opaque_tid() { int t = threadIdx.x; asm volatile("" : "+v"(t)); return t; }
DI unsigned short f2bf(float f) { unsigned u = __float_as_uint(f); u += 0x7fffu + ((u >> 16) & 1u); return (unsigned short)(u >> 16); }
DI float bf2f(unsigned short h) { return __uint_as_float(((unsigned)h) << 16); }
DI float wave_sum(float v) {
#pragma unroll
    for (int o = 1; o < 64; o <<= 1) v += __shfl_xor(v, o);
    return v;
}
DI float wave_max(float v) {
#pragma unroll
    for (int o = 1; o < 64; o <<= 1) v = fmaxf(v, __shfl_xor(v, o));
    return v;
}
DI float siluf(float x) { return x / (1.f + __expf(-x)); }
DI float sigmf(float x) { return 1.f / (1.f + __expf(-x)); }

constexpr size_t MiB = 1u << 20;
constexpr size_t WS_CTL = 0, CTL_ZERO_BYTES = 64 * 1024;
constexpr size_t WS_GATES = 1 * MiB;
constexpr size_t WS_MK = 3 * MiB;
constexpr size_t WS_MV = 4 * MiB;
constexpr size_t WS_KCMP = 5 * MiB;
constexpr size_t WS_VCMP = 5 * MiB + 512 * 1024;
constexpr size_t WS_ROUTE = 7 * MiB;
constexpr size_t WS_LIST = 8 * MiB;
constexpr size_t WS_LISTW = 10 * MiB;
constexpr size_t WS_WOUT_T = 23 * MiB;
constexpr size_t WS_WGU_T = 28 * MiB;
constexpr size_t WS_WD_T = 60 * MiB;
constexpr size_t WS_H3 = 112 * MiB;
constexpr size_t WS_Y = 172 * MiB;
constexpr size_t WS_HID = 236 * MiB;
constexpr int CW_CNT = 8192;
constexpr size_t WS_ROPE = 6 * MiB;
constexpr size_t WS_WIN_T = 16 * MiB;
constexpr size_t WS_XN = 80 * MiB;
constexpr size_t WS_OA = 80 * MiB;
constexpr size_t WS_Q = 112 * MiB;
constexpr size_t WS_KV = 128 * MiB;
constexpr size_t WS_STT = 156 * MiB;
constexpr size_t WS_RET = 172 * MiB;
constexpr size_t WS_END = 256 * MiB;
constexpr size_t KV_STRIDE = (size_t)NB * NG * NS * DH;
constexpr size_t RET_STRIDE = (size_t)NB * NHR * NS * DH;

#define XB_TMO      128
#define XB_XCNT(j)  (256  + 64 * (j))
#define XB_XSUB(j)  (1280 + 64 * (j))
#define XB_XGEN(j)  (2304 + 64 * (j))
#define XB_TOP      3328
#define XB_TOPGEN   3392
#define XCD_BAR_WORDS 3456
#define XB_SPIN_CAP (1u << 22)
DI unsigned xb_ld(unsigned* p)              { return __hip_atomic_load(p, __ATOMIC_RELAXED, __HIP_MEMORY_SCOPE_AGENT); }
DI unsigned xb_add(unsigned* p, unsigned v) { return __hip_atomic_fetch_add(p, v, __ATOMIC_RELAXED, __HIP_MEMORY_SCOPE_AGENT); }
DI unsigned xb_xcc_id() { return (unsigned)__builtin_amdgcn_s_getreg((3 << 11) | 20) & 0xFu; }
#define XB_SPIN(cond, bar) do { unsigned _sp = 0; while (cond) { __builtin_amdgcn_s_sleep(1); \
    if ((++_sp & 255u) == 0u) { if (xb_ld(&(bar)[XB_TMO])) break; if (_sp > XB_SPIN_CAP) { atomicAdd(&(bar)[XB_TMO], 1u); break; } } } } while (0)
struct XcdBarrier { unsigned* bar; unsigned x; volatile LAS unsigned* st; };
DI XcdBarrier xcd_barrier_post(unsigned* bar, volatile LAS unsigned* st) {
    XcdBarrier b; b.bar = bar; b.x = xb_xcc_id(); b.st = st;
    if (threadIdx.x == 0) (void)xb_add(&bar[XB_XCNT(b.x)], 1u);
    return b;
}
DI void xcd_barrier_complete(unsigned* bar, unsigned x, unsigned& nloc, unsigned& nx) {
    const unsigned G = gridDim.x * gridDim.y * gridDim.z;
    unsigned sum, cnt, mine, sp = 0u;
    for (;;) {
        sum = 0u; cnt = 0u; mine = 0u;
#pragma unroll
        for (unsigned j = 0; j < 16; ++j) { const unsigned c = xb_ld(&bar[XB_XCNT(j)]); sum += c; cnt += (c > 0u) ? 1u : 0u; mine = (j == x) ? c : mine; }
        if (sum == G) break;
        __builtin_amdgcn_s_sleep(1);
        if ((++sp & 255u) == 0u) { if (xb_ld(&bar[XB_TMO])) break; if (sp > XB_SPIN_CAP) { atomicAdd(&bar[XB_TMO], 1u); break; } }
    }
    nloc = mine > 0u ? mine : 1u; nx = cnt > 0u ? cnt : 1u;
}
DI void xcd_barrier(const XcdBarrier& b) {
    asm volatile("s_waitcnt vmcnt(0)" ::: "memory");
    __syncthreads();
    if (threadIdx.x == 0) {
        unsigned* bar = b.bar;
        __builtin_amdgcn_s_waitcnt(0);
        unsigned nloc = b.st[0], nx = b.st[1];
        if (nloc == 0u) { xcd_barrier_complete(bar, b.x, nloc, nx); b.st[0] = nloc; b.st[1] = nx; }
        const unsigned old = xb_add(&bar[XB_XSUB(b.x)], 1u);
        const unsigned gen = old / nloc;
        if (old + 1u == (gen + 1u) * nloc) {
            __builtin_amdgcn_fence(__ATOMIC_RELEASE, "agent");
            asm volatile("s_waitcnt vmcnt(0)" ::: "memory");
            const unsigned og = xb_add(&bar[XB_TOP], 1u);
            const unsigned tg = og / nx;
            if (og + 1u == (tg + 1u) * nx) xb_add(&bar[XB_TOPGEN], 1u);
            else XB_SPIN(xb_ld(&bar[XB_TOPGEN]) == tg, bar);
            __builtin_amdgcn_fence(__ATOMIC_ACQUIRE, "agent");
            xb_add(&bar[XB_XGEN(b.x)], 1u);
            asm volatile("s_waitcnt vmcnt(0)" ::: "memory");
        } else {
            XB_SPIN(xb_ld(&bar[XB_XGEN(b.x)]) == gen, bar);
            __builtin_amdgcn_fence(__ATOMIC_ACQUIRE, "agent");
            asm volatile("s_waitcnt vmcnt(0)" ::: "memory");
        }
    }
    __syncthreads();
}

namespace pg8 {
#define PG8_LAS __attribute__((address_space(3)))
typedef unsigned short bf16_t;
typedef short bf16x8 __attribute__((ext_vector_type(8)));
typedef float f32x4 __attribute__((ext_vector_type(4)));
typedef unsigned u32x4 __attribute__((ext_vector_type(4)));
constexpr int BM = 256, BK = 64, HALF = 128, HTB = HALF * BK * 2  , STAGE_BYTES = 8 * HTB, NXCD = 8, WGM = 8;

__host__ __device__ __forceinline__ int lds_byte(int r, int c) { const int st = (r >> 4) * 2 + (c >> 5), rr = r & 15, cc = c & 31, ob = rr * 64 + cc * 2; return st * 1024 + (ob ^ (((ob >> 9) & 1) << 5)); }
__host__ __device__ __forceinline__ void stage_rc(int b, int& R, int& C) { const int st = b / 1024, sb = b % 1024, swz = sb ^ (((sb >> 9) & 1) << 5); R = (st >> 1) * 16 + swz / 64; C = (st & 1) * 32 + (swz % 64) / 2; }
__host__ __device__ __forceinline__ int perm32(int rho) { const int n = rho >> 4, i = rho & 15; return 8 * (i >> 2) + 4 * n + (i & 3); }

struct Unit { int pm, pn; };
struct Gemm { const bf16_t* A; const bf16_t* Bt; int M, N, K; };

struct StaticOrder {
    int nM, nN, nwg, G, c;
    __host__ __device__ void init(int M, int N, int G_, int c_) { nM = M / BM; nN = N / BM; nwg = nM * nN; G = G_; c = c_; }
    __host__ __device__ bool next(int i, Unit& u) const {
        const long L = (long)i * G + c; if (L >= nwg) return false;
        int wgid = (int)L; { const int q = nwg / NXCD, r = nwg % NXCD, xcd = wgid % NXCD, off = wgid / NXCD; wgid = (xcd < r ? xcd * (q + 1) : r * (q + 1) + (xcd - r) * q) + off; }
        const int nig = WGM * nN, gid = wgid / nig, fm = gid * WGM, gsz = (nM - fm) < WGM ? (nM - fm) : WGM;
        u.pm = fm + ((wgid % nig) % gsz); u.pn = (wgid % nig) / gsz; return true;
    }
    __device__ __forceinline__ void a_ready(const Unit&) const {}
    __device__ __forceinline__ void done(const Unit&) const {}
};


template <class Epi, class Sched, bool ALIGN_EPI = false, bool SP2 = false>
__device__ __forceinline__ void gemm_phase(PG8_LAS unsigned char* lds, const Gemm g, const Sched& S, const Epi& E) {
    const int tid = opaque_tid(), wid = __builtin_amdgcn_readfirstlane(tid >> 6), lane = tid & 63, wr = wid >> 2, wc = wid & 3, fr = lane & 15, fq = lane >> 4;
    const int K = g.K, nt = K / BK;
    unsigned voffA[2], voffB[2];
#pragma unroll
    for (int i = 0; i < 2; ++i) { int R, C; stage_rc(tid * 16 + i * 8192, R, C); const int Rb = Epi::PERM ? ((R & ~31) + perm32(R & 31)) : R;
        voffA[i] = (unsigned)(R * K + C) * 2u; voffB[i] = (unsigned)(Rb * K + C) * 2u; }
    const size_t kstep = (size_t)(BK * 2);
    const size_t hstep = (size_t)HALF * K * 2;
    const size_t tstep = 2 * hstep;
    const unsigned ldsw = (unsigned)wid * 1024u;
    const int aoff = lds_byte(wr * 64 + fr, fq * 8), boff = lds_byte(wc * 32 + fr, fq * 8);
#define PG8_SA(b, h) (((b) * 2 + (h)) * HTB)
#define PG8_SB(b, h) ((4 + (b) * 2 + (h)) * HTB)
#define PG8_STAGE(bufoff, gbase, voff) do { _Pragma("unroll") for (int _i = 0; _i < 2; ++_i) \
        __builtin_amdgcn_global_load_lds((const unsigned*)((const char*)(gbase) + (voff)[_i]), (PG8_LAS unsigned*)(lds + (bufoff) + ldsw + _i * 8192), 16, 0, 0); } while (0)
#define PG8_LDA(dst, b, h) do { _Pragma("unroll") for (int m = 0; m < 4; ++m) _Pragma("unroll") for (int k = 0; k < 2; ++k) dst[m][k] = *(const PG8_LAS bf16x8*)(lds + PG8_SA(b, h) + aoff + m * 2048 + k * 1024); } while (0)
#define PG8_LDB(dst, b, h) do { _Pragma("unroll") for (int n = 0; n < 2; ++n) _Pragma("unroll") for (int k = 0; k < 2; ++k) dst[n][k] = *(const PG8_LAS bf16x8*)(lds + PG8_SB(b, h) + boff + n * 2048 + k * 1024); } while (0)
#define PG8_MMA(ai, bj, At, Bt) do { __builtin_amdgcn_s_setprio(1); _Pragma("unroll") for (int m = 0; m < 4; ++m) _Pragma("unroll") for (int n = 0; n < 2; ++n) _Pragma("unroll") for (int k = 0; k < 2; ++k) \
        acc[ai][bj][m][n] = __builtin_amdgcn_mfma_f32_16x16x32_bf16(Bt[n][k], At[m][k], acc[ai][bj][m][n], 0, 0, 0); __builtin_amdgcn_s_setprio(0); } while (0)
#define PG8_WAIT_V(n) asm volatile("s_waitcnt vmcnt(" #n ")" ::: "memory")
#define PG8_WAIT_L(n) asm volatile("s_waitcnt lgkmcnt(" #n ")" ::: "memory")
#define PG8_BAR __builtin_amdgcn_s_barrier()
#define PG8_SCHED __builtin_amdgcn_sched_barrier(0)
    Unit cur, nxt; int ui = 0;
    if (!S.next(0, cur)) return;
    f32x4 acc[2][2][4][2];
#pragma unroll
    for (int a = 0; a < 2; ++a)
#pragma unroll
        for (int b = 0; b < 2; ++b)
#pragma unroll
            for (int m = 0; m < 4; ++m)
#pragma unroll
                for (int n = 0; n < 2; ++n) acc[a][b][m][n] = (f32x4){0.f, 0.f, 0.f, 0.f};
    bf16x8 At[4][2], B0[2][2], B1[2][2];
    const char* cA = (const char*)g.A + (size_t)cur.pm * tstep; const char* cB = (const char*)g.Bt + (size_t)cur.pn * tstep;
    S.a_ready(cur);
    if constexpr (SP2) {
        PG8_STAGE(PG8_SB(0, 0), cB, voffB); PG8_STAGE(PG8_SB(0, 1), cB + hstep, voffB); PG8_STAGE(PG8_SA(0, 0), cA, voffA); PG8_STAGE(PG8_SA(0, 1), cA + hstep, voffA);
        if (wr == 1) PG8_BAR;
        PG8_WAIT_V(2); PG8_BAR;
        PG8_STAGE(PG8_SB(1, 0), cB + kstep, voffB); PG8_STAGE(PG8_SA(1, 0), cA + kstep, voffA); PG8_STAGE(PG8_SB(1, 1), cB + hstep + kstep, voffB);
        PG8_WAIT_V(6); PG8_BAR;
    } else {
        PG8_STAGE(PG8_SB(0, 0), cB, voffB); PG8_STAGE(PG8_SA(0, 0), cA, voffA); PG8_STAGE(PG8_SB(0, 1), cB + hstep, voffB); PG8_STAGE(PG8_SA(0, 1), cA + hstep, voffA);
        if (wr == 1) PG8_BAR;
        PG8_WAIT_V(4); PG8_BAR;
        PG8_STAGE(PG8_SB(1, 0), cB + kstep, voffB); PG8_STAGE(PG8_SA(1, 0), cA + kstep, voffA); PG8_STAGE(PG8_SB(1, 1), cB + hstep + kstep, voffB);
        PG8_WAIT_V(6); PG8_BAR;
    }
    for (;;) {
        const bool has_next = S.next(ui + 1, nxt);
        const char* nA = has_next ? (const char*)g.A + (size_t)nxt.pm * tstep : cA; const char* nB = has_next ? (const char*)g.Bt + (size_t)nxt.pn * tstep : cB;
        for (int t = 0; t < nt; t += 2) {
            const bool last = (t == nt - 2);
            const char* a1 = cA + (size_t)(t + 1) * kstep;
            const char* a2 = last ? nA : cA + (size_t)(t + 2) * kstep; const char* b2 = last ? nB : cB + (size_t)(t + 2) * kstep;
            const char* a3 = a2 + kstep; const char* b3 = b2 + kstep;
            if (last && has_next) S.a_ready(nxt);
            if constexpr (SP2) {
            PG8_LDB(B0, 0, 0); PG8_LDB(B1, 0, 1); PG8_SCHED; PG8_LDA(At, 0, 0); PG8_STAGE(PG8_SA(1, 1), a1 + hstep, voffA);
            PG8_WAIT_V(8); PG8_WAIT_L(0); PG8_BAR; PG8_MMA(0, 0, At, B0); PG8_MMA(0, 1, At, B1); PG8_BAR; PG8_SCHED;
            PG8_LDA(At, 0, 1); PG8_STAGE(PG8_SB(0, 0), b2, voffB); PG8_STAGE(PG8_SB(0, 1), b2 + hstep, voffB); PG8_STAGE(PG8_SA(0, 0), a2, voffA);
            PG8_WAIT_V(8); PG8_WAIT_L(0); PG8_BAR; PG8_MMA(1, 0, At, B0); PG8_MMA(1, 1, At, B1); PG8_BAR; PG8_SCHED;
            PG8_LDB(B0, 1, 0); PG8_LDB(B1, 1, 1); PG8_SCHED; PG8_LDA(At, 1, 0); PG8_STAGE(PG8_SA(0, 1), a2 + hstep, voffA);
            PG8_WAIT_V(8); PG8_WAIT_L(0); PG8_BAR; PG8_MMA(0, 0, At, B0); PG8_MMA(0, 1, At, B1); PG8_BAR; PG8_SCHED;
            PG8_LDA(At, 1, 1); PG8_STAGE(PG8_SB(1, 0), b3, voffB); PG8_STAGE(PG8_SB(1, 1), b3 + hstep, voffB); PG8_STAGE(PG8_SA(1, 0), a3, voffA);
            PG8_WAIT_V(8); PG8_WAIT_L(0); PG8_BAR; PG8_MMA(1, 0, At, B0); PG8_MMA(1, 1, At, B1); PG8_BAR; PG8_SCHED;
            } else {
            PG8_LDB(B0, 0, 0); PG8_SCHED; PG8_LDA(At, 0, 0); PG8_STAGE(PG8_SA(1, 1), a1 + hstep, voffA);
            PG8_WAIT_L(8); PG8_BAR; PG8_WAIT_L(0); PG8_MMA(0, 0, At, B0); PG8_BAR; PG8_SCHED;
            PG8_LDB(B1, 0, 1); PG8_STAGE(PG8_SB(0, 0), b2, voffB);
            PG8_BAR; PG8_WAIT_L(0); PG8_MMA(0, 1, At, B1); PG8_BAR;
            PG8_LDA(At, 0, 1); PG8_STAGE(PG8_SA(0, 0), a2, voffA);
            PG8_BAR; PG8_WAIT_L(0); PG8_MMA(1, 0, At, B0); PG8_BAR; PG8_SCHED;
            PG8_STAGE(PG8_SB(0, 1), b2 + hstep, voffB);
            PG8_WAIT_V(6); PG8_BAR; PG8_MMA(1, 1, At, B1); PG8_BAR;
            PG8_LDB(B0, 1, 0); PG8_SCHED; PG8_LDA(At, 1, 0); PG8_STAGE(PG8_SA(0, 1), a2 + hstep, voffA);
            PG8_WAIT_L(8); PG8_BAR; PG8_WAIT_L(0); PG8_MMA(0, 0, At, B0); PG8_BAR; PG8_SCHED;
            PG8_LDB(B1, 1, 1); PG8_STAGE(PG8_SB(1, 0), b3, voffB);
            PG8_BAR; PG8_WAIT_L(0); PG8_MMA(0, 1, At, B1); PG8_BAR;
            PG8_LDA(At, 1, 1); PG8_STAGE(PG8_SA(1, 0), a3, voffA);
            PG8_BAR; PG8_WAIT_L(0); PG8_MMA(1, 0, At, B0); PG8_BAR; PG8_SCHED;
            PG8_STAGE(PG8_SB(1, 1), b3 + hstep, voffB);
            PG8_WAIT_V(6); PG8_BAR; PG8_MMA(1, 1, At, B1); PG8_BAR;
            }
        }
        if constexpr (ALIGN_EPI) { if (wr == 0) PG8_BAR; }
        if constexpr (!Epi::AFTER_DRAIN) { E(acc, cur, wr, wc, fr, fq); S.done(cur); }
        if (!has_next) break;
#pragma unroll
        for (int a = 0; a < 2; ++a)
#pragma unroll
            for (int b = 0; b < 2; ++b)
#pragma unroll
                for (int m = 0; m < 4; ++m)
#pragma unroll
                    for (int n = 0; n < 2; ++n) acc[a][b][m][n] = (f32x4){0.f, 0.f, 0.f, 0.f};
        cur = nxt; cA = nA; cB = nB; ++ui;
        if constexpr (ALIGN_EPI) { if (wr == 1) PG8_BAR; }
    }
    PG8_WAIT_V(0);
    if constexpr (!ALIGN_EPI) { if (wr == 0) PG8_BAR; }
    PG8_BAR;
    if constexpr (Epi::AFTER_DRAIN) { E.fused(acc, cur, wr, wc, fr, fq, lds, wid, lane); S.done(cur); }
#undef PG8_SA
#undef PG8_SB
#undef PG8_STAGE
#undef PG8_LDA
#undef PG8_LDB
#undef PG8_MMA
#undef PG8_WAIT_V
#undef PG8_WAIT_L
#undef PG8_BAR
#undef PG8_SCHED
}

struct UnitG { const char* A; const char* B; unsigned ao[2][2]; int pn, e, rt, cnt, row0; };
template <class Epi, class Sched>
__device__ __forceinline__ void gemm_phase_g(PG8_LAS unsigned char* lds, const int K, const Sched& S, const Epi& E) {
    const int tid = opaque_tid(), wid = __builtin_amdgcn_readfirstlane(tid >> 6), lane = tid & 63, wr = wid >> 2, wc = wid & 3, fr = lane & 15, fq = lane >> 4;
    const int nt = K / BK;
    unsigned voffB[2];
#pragma unroll
    for (int i = 0; i < 2; ++i) { int R, C; stage_rc(tid * 16 + i * 8192, R, C); const int Rb = Epi::PERM ? ((R & ~31) + perm32(R & 31)) : R; voffB[i] = (unsigned)(Rb * K + C) * 2u; }
    const size_t kstep = (size_t)(BK * 2);
    const size_t hstepB = (size_t)HALF * K * 2;
    const unsigned ldsw = (unsigned)wid * 1024u;
    const int aoff = lds_byte(wr * 64 + fr, fq * 8), boff = lds_byte(wc * 32 + fr, fq * 8);
#define PG8_SA(b, h) (((b) * 2 + (h)) * HTB)
#define PG8_SB(b, h) ((4 + (b) * 2 + (h)) * HTB)
#define PG8_STAGE(bufoff, gbase, voff) do { _Pragma("unroll") for (int _i = 0; _i < 2; ++_i) \
        __builtin_amdgcn_global_load_lds((const unsigned*)((const char*)(gbase) + (voff)[_i]), (PG8_LAS unsigned*)(lds + (bufoff) + ldsw + _i * 8192), 16, 0, 0); } while (0)
#define PG8_LDA(dst, b, h) do { _Pragma("unroll") for (int m = 0; m < 4; ++m) _Pragma("unroll") for (int k = 0; k < 2; ++k) dst[m][k] = *(const PG8_LAS bf16x8*)(lds + PG8_SA(b, h) + aoff + m * 2048 + k * 1024); } while (0)
#define PG8_LDB(dst, b, h) do { _Pragma("unroll") for (int n = 0; n < 2; ++n) _Pragma("unroll") for (int k = 0; k < 2; ++k) dst[n][k] = *(const PG8_LAS bf16x8*)(lds + PG8_SB(b, h) + boff + n * 2048 + k * 1024); } while (0)
#define PG8_MMA(ai, bj, At, Bt) do { __builtin_amdgcn_s_setprio(1); _Pragma("unroll") for (int m = 0; m < 4; ++m) _Pragma("unroll") for (int n = 0; n < 2; ++n) _Pragma("unroll") for (int k = 0; k < 2; ++k) \
        acc[ai][bj][m][n] = __builtin_amdgcn_mfma_f32_16x16x32_bf16(Bt[n][k], At[m][k], acc[ai][bj][m][n], 0, 0, 0); __builtin_amdgcn_s_setprio(0); } while (0)
#define PG8_WAIT_V(n) asm volatile("s_waitcnt vmcnt(" #n ")" ::: "memory")
#define PG8_WAIT_L(n) asm volatile("s_waitcnt lgkmcnt(" #n ")" ::: "memory")
#define PG8_BAR __builtin_amdgcn_s_barrier()
#define PG8_SCHED __builtin_amdgcn_sched_barrier(0)
    UnitG cur, nxt; int ui = 0;
    if (!S.next(0, cur)) return;
    f32x4 acc[2][2][4][2];
#pragma unroll
    for (int a = 0; a < 2; ++a)
#pragma unroll
        for (int b = 0; b < 2; ++b)
#pragma unroll
            for (int m = 0; m < 4; ++m)
#pragma unroll
                for (int n = 0; n < 2; ++n) acc[a][b][m][n] = (f32x4){0.f, 0.f, 0.f, 0.f};
    bf16x8 At[4][2], B0[2][2], B1[2][2];
    const char* cA = cur.A; const char* cB = cur.B;
    PG8_STAGE(PG8_SB(0, 0), cB, voffB); PG8_STAGE(PG8_SB(0, 1), cB + hstepB, voffB); PG8_STAGE(PG8_SA(0, 0), cA, cur.ao[0]); PG8_STAGE(PG8_SA(0, 1), cA, cur.ao[1]);
    if (wr == 1) PG8_BAR;
    PG8_WAIT_V(2); PG8_BAR;
    PG8_STAGE(PG8_SB(1, 0), cB + kstep, voffB); PG8_STAGE(PG8_SA(1, 0), cA + kstep, cur.ao[0]); PG8_STAGE(PG8_SB(1, 1), cB + hstepB + kstep, voffB);
    PG8_WAIT_V(6); PG8_BAR;
    for (;;) {
        const bool has_next = S.next(ui + 1, nxt);
        if (!has_next) nxt = cur;
        const char* nA = nxt.A; const char* nB = nxt.B;
        for (int t = 0; t < nt; t += 2) {
            const bool last = (t == nt - 2);
            const char* a1 = cA + (size_t)(t + 1) * kstep;
            const char* a2 = last ? nA : cA + (size_t)(t + 2) * kstep; const char* b2 = last ? nB : cB + (size_t)(t + 2) * kstep;
            const char* a3 = a2 + kstep; const char* b3 = b2 + kstep;
            unsigned x0[2], x1[2];
#pragma unroll
            for (int i = 0; i < 2; ++i) { x0[i] = last ? nxt.ao[0][i] : cur.ao[0][i]; x1[i] = last ? nxt.ao[1][i] : cur.ao[1][i]; }
            PG8_LDB(B0, 0, 0); PG8_LDB(B1, 0, 1); PG8_SCHED; PG8_LDA(At, 0, 0); PG8_STAGE(PG8_SA(1, 1), a1, cur.ao[1]);
            PG8_WAIT_V(8); PG8_WAIT_L(0); PG8_BAR; PG8_MMA(0, 0, At, B0); PG8_MMA(0, 1, At, B1); PG8_BAR; PG8_SCHED;
            PG8_LDA(At, 0, 1); PG8_STAGE(PG8_SB(0, 0), b2, voffB); PG8_STAGE(PG8_SB(0, 1), b2 + hstepB, voffB); PG8_STAGE(PG8_SA(0, 0), a2, x0);
            PG8_WAIT_V(8); PG8_WAIT_L(0); PG8_BAR; PG8_MMA(1, 0, At, B0); PG8_MMA(1, 1, At, B1); PG8_BAR; PG8_SCHED;
            PG8_LDB(B0, 1, 0); PG8_LDB(B1, 1, 1); PG8_SCHED; PG8_LDA(At, 1, 0); PG8_STAGE(PG8_SA(0, 1), a2, x1);
            PG8_WAIT_V(8); PG8_WAIT_L(0); PG8_BAR; PG8_MMA(0, 0, At, B0); PG8_MMA(0, 1, At, B1); PG8_BAR; PG8_SCHED;
            PG8_LDA(At, 1, 1); PG8_STAGE(PG8_SB(1, 0), b3, voffB); PG8_STAGE(PG8_SB(1, 1), b3 + hstepB, voffB); PG8_STAGE(PG8_SA(1, 0), a3, x0);
            PG8_WAIT_V(8); PG8_WAIT_L(0); PG8_BAR; PG8_MMA(1, 0, At, B0); PG8_MMA(1, 1, At, B1); PG8_BAR; PG8_SCHED;
        }
        if (wr == 0) PG8_BAR;
        E(acc, cur, wr, wc, fr, fq);
        if (!has_next) break;
#pragma unroll
        for (int a = 0; a < 2; ++a)
#pragma unroll
            for (int b = 0; b < 2; ++b)
#pragma unroll
                for (int m = 0; m < 4; ++m)
#pragma unroll
                    for (int n = 0; n < 2; ++n) acc[a][b][m][n] = (f32x4){0.f, 0.f, 0.f, 0.f};
        cur = nxt; cA = nA; cB = nB; ++ui;
        if (wr == 1) PG8_BAR;
    }
    PG8_WAIT_V(0);
    PG8_BAR;
#undef PG8_SA
#undef PG8_SB
#undef PG8_STAGE
#undef PG8_LDA
#undef PG8_LDB
#undef PG8_MMA
#undef PG8_WAIT_V
#undef PG8_WAIT_L
#undef PG8_BAR
#undef PG8_SCHED
}
}


struct Args {
    const float* in[32];
    float* out;
    unsigned char* ws;
};
struct Ctx { const LAS unsigned long long* tab; float* out; unsigned char* ws; };
DI const float* inptr(const LAS unsigned long long* tab, int i) {
    const unsigned long long v = tab[i];
    const unsigned lo = __builtin_amdgcn_readfirstlane((unsigned)v), hi = __builtin_amdgcn_readfirstlane((unsigned)(v >> 32));
    return (const float*)(((unsigned long long)hi << 32) | lo);
}
#define AIN(i) inptr(a.tab, (i))
enum {
    I_X = 0, I_MEM, I_MIXN, I_WIN, I_QN, I_KCN, I_KSN, I_KWN, I_POSK, I_POSV, I_CKW1, I_CKW2, I_CVW1, I_CVW2,
    I_NSAON, I_RETON, I_WOUT, I_MXN, I_MKVN, I_MWQ, I_MWKV, I_MQN, I_MKN, I_MWO, I_FFN, I_RGW, I_RGB, I_REW, I_REB,
    I_EWG, I_EWU, I_EWD
};

#ifndef OPT_PROJ
#define OPT_PROJ 1
#endif
#ifndef OPT_TAIL
#define OPT_TAIL 1
#endif
constexpr int LDS_BYTES = 147456;
constexpr int LDS_MISC = 147456 - 256;
constexpr int LDS_PTAB = 147456 - 1024;


typedef unsigned v4u __attribute__((ext_vector_type(4)));
typedef float f32x4v __attribute__((ext_vector_type(4)));
DI unsigned pk2(float lo, float hi) { return (unsigned)f2bf(lo) | ((unsigned)f2bf(hi) << 16); }
constexpr int NPROJ = 3584;
DI void transpose_item(const float* W, int ldw, int k0, int srcc0, int nvalid, bf16_t* WT, int K, int row0, LAS float* scr, int lane) {
    const int n = lane & 31;
#pragma unroll 8
    for (int i = 0; i < 32; ++i) { const int kk = 2 * i + (lane >> 5); scr[kk * 33 + n] = (n < nvalid) ? W[(size_t)(k0 + kk) * ldw + srcc0 + n] : 0.f; }
    asm volatile("s_waitcnt lgkmcnt(0)" ::: "memory");
    const int c = lane & 7;
#pragma unroll
    for (int j = 0; j < 4; ++j) { const int nn = (lane >> 3) + 8 * j; const LAS float* sp = scr + (8 * c) * 33 + nn;
        v4u o; o.x = pk2(sp[0 * 33], sp[1 * 33]); o.y = pk2(sp[2 * 33], sp[3 * 33]); o.z = pk2(sp[4 * 33], sp[5 * 33]); o.w = pk2(sp[6 * 33], sp[7 * 33]);
        *(v4u*)(WT + (size_t)(row0 + nn) * K + k0 + 8 * c) = o; }
    asm volatile("s_waitcnt lgkmcnt(0)" ::: "memory");
}
DI int proj_src(int vh, int d0, int& srcc0) {
    if (vh < 8) { srcc0 = vh * 64 + d0; return 32; }
    if (vh < 20) { srcc0 = 512 + (vh - 8) * 64 + d0; return 32; }
    if (vh < 52) { srcc0 = 1304 + (vh - 20) * 64 + d0; return 32; }
    if (vh == 52 && d0 == 0) { srcc0 = 1280; return 24; }
    srcc0 = 0; return 0;
}
DI void phase_prologue(const Ctx& a, unsigned char* lds_raw) {
    const int tid = opaque_tid(), lane = tid & 63, wv = __builtin_amdgcn_readfirstlane(tid >> 6);
    LAS float* scr = (LAS float*)((LAS unsigned char*)lds_raw + wv * 16384);
    const int gw = blockIdx.x * NWAVE + wv, NGW = gridDim.x * NWAVE;
    bf16_t* WinT = (bf16_t*)(a.ws + WS_WIN_T);
    for (int it = gw; it < 16 * (NPROJ / 32); it += NGW) {
        const int kb = it / (NPROJ / 32), rg = it % (NPROJ / 32);
        const int pn = rg >> 3, r8 = rg & 7, bj = r8 >> 2, wc = r8 & 3; int srcc0; const int nv = proj_src(pn * 4 + wc, 32 * bj, srcc0);
        transpose_item(AIN(I_WIN), PROJ, kb * 64, srcc0, nv, WinT, 1024, rg * 32, scr, lane);
    }
    { bf16_t* WT = (bf16_t*)(a.ws + WS_WOUT_T);
      for (int it = gw; it < 16 * 32; it += NGW) { const int kb = it >> 5, rg = it & 31; transpose_item(AIN(I_WOUT), 1024, kb * 64, rg * 32, 32, WT, 1024, rg * 32, scr, lane); } }
    { bf16_t* WT = (bf16_t*)(a.ws + WS_WGU_T);
      for (int it = gw; it < NEXP * 16 * 16; it += NGW) { const int e = it >> 8, kb = (it >> 4) & 15, rg = it & 15; const int pn = rg >> 3, bj = (rg >> 2) & 1, q = rg & 3;
          transpose_item(AIN(bj ? I_EWU : I_EWG) + (size_t)e * 1024 * 256, 256, kb * 64, 128 * pn + 32 * q, 32, WT + (size_t)e * 512 * 1024, 1024, rg * 32, scr, lane); } }
    { bf16_t* WT = (bf16_t*)(a.ws + WS_WD_T);
      for (int it = gw; it < NEXP * 4 * 32; it += NGW) { const int e = it >> 7, kb = (it >> 5) & 3, rg = it & 31;
          transpose_item(AIN(I_EWD) + (size_t)e * 256 * 1024, 1024, kb * 64, rg * 32, 32, WT + (size_t)e * 1024 * 256, 256, rg * 32, scr, lane); } }
    bf16_t* XN = (bf16_t*)(a.ws + WS_XN);
    for (int m = gw; m < NT; m += NGW) {
        const f32x4v* xr = (const f32x4v*)(AIN(I_X) + (size_t)m * DM) + lane; const f32x4v* gr = (const f32x4v*)AIN(I_MIXN) + lane;
        f32x4v v[4]; float ss = 0.f;
#pragma unroll
        for (int j = 0; j < 4; ++j) { v[j] = xr[64 * j]; ss += (v[j].x * v[j].x + v[j].y * v[j].y) + (v[j].z * v[j].z + v[j].w * v[j].w); }
        const float rstd = rsqrtf(wave_sum(ss) * (1.f / DM) + EPS);
        unsigned long long* o8 = (unsigned long long*)(XN + (size_t)m * DM) + lane;
#pragma unroll
        for (int j = 0; j < 4; ++j) { const f32x4v g = gr[64 * j]; o8[64 * j] = (unsigned long long)pk2(v[j].x * rstd * g.x, v[j].y * rstd * g.y) | ((unsigned long long)pk2(v[j].z * rstd * g.z, v[j].w * rstd * g.w) << 32); }
    }
    float* rope = (float*)(a.ws + WS_ROPE);
    for (int i = blockIdx.x * NTHR + tid; i < NS * 32; i += gridDim.x * NTHR) {
        const int s = i >> 5, k = i & 31; const float inv = exp2f(-(float)k * (13.287712379549449f / 32.f));
        float sn, cs; sincosf((float)s * inv, &sn, &cs); rope[i] = cs; rope[NS * 32 + i] = sn;
    }
}

typedef float f32x2t __attribute__((ext_vector_type(2))); typedef __bf16 bf16x2t __attribute__((ext_vector_type(2)));
DI unsigned cvtpk(float lo, float hi) { f32x2t v = {lo, hi}; bf16x2t b = __builtin_convertvector(v, bf16x2t); return __builtin_bit_cast(unsigned, b); }
struct EpiProj {
    static constexpr bool PERM = true, AFTER_DRAIN = false;
    bf16_t* Q; bf16_t* KV; bf16_t* RET; float* GATES; const float* qn; const float* ksn; const float* kwn; const float* rope;
    DI void operator()(const pg8::f32x4 (&acc)[2][2][4][2], const pg8::Unit& u, int wr, int wc, int fr, int fq) const {
        const int vh = u.pn * 4 + wc;
        if (vh > 52) return;
        const int b = u.pm >> 3, s0 = (u.pm & 7) * 256;
        int kind = 0; const float* gain = nullptr; float scale = 1.f; bf16_t* hb = nullptr; int rstride = 64;
        if (vh < 8) { kind = 1; gain = qn; scale = 0.125f; hb = Q + (size_t)(u.pm * 256) * 512 + vh * 64; rstride = 512; }
        else if (vh < 20) { const int i = (vh - 8) >> 1, g = (vh - 8) & 1; hb = KV + (size_t)i * KV_STRIDE + ((size_t)(b * NG + g) * NS + s0) * DH;
            if (i == 2) { kind = 1; gain = ksn; } else if (i == 4) { kind = 1; gain = kwn; } }
        else if (vh < 52) { const int rr = (vh - 20) >> 3, h = (vh - 20) & 7; hb = RET + (size_t)rr * RET_STRIDE + ((size_t)(b * NHR + h) * NS + s0) * DH;
            if (rr < 2) { kind = 2; scale = (rr == 1) ? 0.125f : 1.f; } }
        else kind = 3;
        float g[2][8];
#pragma unroll
        for (int bj = 0; bj < 2; ++bj)
#pragma unroll
            for (int j = 0; j < 8; ++j) g[bj][j] = (kind == 1) ? gain[32 * bj + 8 * fq + j] : 1.f;
#pragma unroll
        for (int ai = 0; ai < 2; ++ai)
#pragma unroll
            for (int m = 0; m < 4; ++m) {
                const int rl = ai * 128 + wr * 64 + m * 16 + fr;
                float v[2][8];
#pragma unroll
                for (int bj = 0; bj < 2; ++bj)
#pragma unroll
                    for (int n = 0; n < 2; ++n)
#pragma unroll
                        for (int i = 0; i < 4; ++i) v[bj][4 * n + i] = acc[ai][bj][m][n][i];
                if (kind == 1) {
                    float ss = 0.f;
#pragma unroll
                    for (int bj = 0; bj < 2; ++bj)
#pragma unroll
                        for (int j = 0; j < 8; ++j) ss += v[bj][j] * v[bj][j];
                    ss += __shfl_xor(ss, 16); ss += __shfl_xor(ss, 32);
                    const float r = rsqrtf(ss * (1.f / 64.f) + EPS) * scale;
#pragma unroll
                    for (int bj = 0; bj < 2; ++bj)
#pragma unroll
                        for (int j = 0; j < 8; ++j) v[bj][j] = v[bj][j] * r * g[bj][j];
                } else if (kind == 2) {
                    const f32x4v* cp = (const f32x4v*)(rope + (size_t)(s0 + rl) * 32 + 8 * fq); const f32x4v* sp = (const f32x4v*)(rope + NS * 32 + (size_t)(s0 + rl) * 32 + 8 * fq);
                    const f32x4v c0 = cp[0], c1 = cp[1], n0 = sp[0], n1 = sp[1];
                    const float cs[8] = {c0.x, c0.y, c0.z, c0.w, c1.x, c1.y, c1.z, c1.w}; const float sn[8] = {n0.x, n0.y, n0.z, n0.w, n1.x, n1.y, n1.z, n1.w};
#pragma unroll
                    for (int j = 0; j < 8; ++j) { const float x1 = v[0][j], x2 = v[1][j]; v[0][j] = (x1 * cs[j] - x2 * sn[j]) * scale; v[1][j] = (x1 * sn[j] + x2 * cs[j]) * scale; }
                }
                if (kind == 3) {
                    if (fq < 3) { float* gp = GATES + (size_t)(u.pm * 256 + rl) * 24 + 8 * fq;
                        *(f32x4v*)gp = (f32x4v){v[0][0], v[0][1], v[0][2], v[0][3]}; *(f32x4v*)(gp + 4) = (f32x4v){v[0][4], v[0][5], v[0][6], v[0][7]}; }
                } else {
                    bf16_t* rp = hb + (size_t)rl * rstride + 8 * fq;
#pragma unroll
                    for (int bj = 0; bj < 2; ++bj) { v4u w; w.x = cvtpk(v[bj][0], v[bj][1]); w.y = cvtpk(v[bj][2], v[bj][3]); w.z = cvtpk(v[bj][4], v[bj][5]); w.w = cvtpk(v[bj][6], v[bj][7]);
                        *(v4u*)(rp + 32 * bj) = w; }
                }
            }
    }
};
DI void phase_proj_mfma(const Ctx& a, unsigned char* lds_raw) {
    pg8::Gemm g{(const bf16_t*)(a.ws + WS_XN), (const bf16_t*)(a.ws + WS_WIN_T), NT, NPROJ, DM};
    pg8::StaticOrder S; S.init(NT, NPROJ, (int)gridDim.x, (int)blockIdx.x);
    EpiProj E{(bf16_t*)(a.ws + WS_Q), (bf16_t*)(a.ws + WS_KV), (bf16_t*)(a.ws + WS_RET), (float*)(a.ws + WS_GATES), AIN(I_QN), AIN(I_KSN), AIN(I_KWN), (const float*)(a.ws + WS_ROPE)};
    pg8::gemm_phase<EpiProj, pg8::StaticOrder, true, true>((PG8_LAS unsigned char*)lds_raw, g, S, E);
}

DI void phase_proj(const Ctx& a, float* lds) {
    const int tid = opaque_tid(), lane = tid & 63, wv = tid >> 6;
    float* xs = lds;
    float* pr = lds + 4 * 1024;
    const float* x = AIN(I_X); const float* w_in = AIN(I_WIN); const float* mixn = AIN(I_MIXN);
    bf16_t* Q = (bf16_t*)(a.ws + WS_Q); bf16_t* KV = (bf16_t*)(a.ws + WS_KV); bf16_t* RET = (bf16_t*)(a.ws + WS_RET);
    float* GATES = (float*)(a.ws + WS_GATES);
    for (int tg = blockIdx.x; tg < NT / 4; tg += gridDim.x) {
        __syncthreads();
        if (wv < 4) {
            const float* xr = x + (size_t)(tg * 4 + wv) * DM;
            float v[16]; float ss = 0.f;
#pragma unroll
            for (int i = 0; i < 16; ++i) { v[i] = xr[lane + 64 * i]; ss += v[i] * v[i]; }
            ss = wave_sum(ss);
            const float rstd = rsqrtf(ss * (1.f / DM) + EPS);
#pragma unroll
            for (int i = 0; i < 16; ++i) xs[wv * 1024 + lane + 64 * i] = v[i] * rstd * mixn[lane + 64 * i];
        }
        __syncthreads();
        float acc[7][4];
#pragma unroll
        for (int i = 0; i < 7; ++i)
#pragma unroll
            for (int k = 0; k < 4; ++k) acc[i][k] = 0.f;
        for (int d = 0; d < DM; d += 2) {
            float w0[7], w1[7];
#pragma unroll
            for (int i = 0; i < 7; ++i) { const int c = tid + 512 * i; w0[i] = (c < PROJ) ? w_in[(size_t)d * PROJ + c] : 0.f; w1[i] = (c < PROJ) ? w_in[(size_t)(d + 1) * PROJ + c] : 0.f; }
            float xa[4], xb[4];
#pragma unroll
            for (int k = 0; k < 4; ++k) { xa[k] = xs[k * 1024 + d]; xb[k] = xs[k * 1024 + d + 1]; }
#pragma unroll
            for (int i = 0; i < 7; ++i)
#pragma unroll
                for (int k = 0; k < 4; ++k) { acc[i][k] += xa[k] * w0[i]; acc[i][k] += xb[k] * w1[i]; }
        }
#pragma unroll
        for (int i = 0; i < 7; ++i) { const int c = tid + 512 * i; if (c < PROJ) {
#pragma unroll
            for (int k = 0; k < 4; ++k) pr[k * PROJ + c] = acc[i][k]; } }
        __syncthreads();
        if (tid < 208) {
            const int k = tid / 52, v = tid % 52; const int t = tg * 4 + k, b = t / NS, s = t % NS;
            const float* p = pr + k * PROJ;
            if (v < 8) {
                const float* src = p + v * 64; float ss = 0.f;
                for (int d = 0; d < 64; ++d) ss += src[d] * src[d];
                const float rstd = rsqrtf(ss * (1.f / 64.f) + EPS) * 0.125f;
                bf16_t* dst = Q + (size_t)t * 512 + v * 64;
                for (int d = 0; d < 64; ++d) dst[d] = f2bf(src[d] * rstd * AIN(I_QN)[d]);
            } else if (v < 20) {
                const int i = (v - 8) >> 1, g = (v - 8) & 1;
                const float* src = p + 512 + i * 128 + g * 64;
                bf16_t* dst = KV + (size_t)i * KV_STRIDE + ((size_t)(b * NG + g) * NS + s) * DH;
                if (i == 2 || i == 4) {
                    const float* gn = (i == 2) ? AIN(I_KSN) : AIN(I_KWN); float ss = 0.f;
                    for (int d = 0; d < 64; ++d) ss += src[d] * src[d];
                    const float rstd = rsqrtf(ss * (1.f / 64.f) + EPS);
                    for (int d = 0; d < 64; ++d) dst[d] = f2bf(src[d] * rstd * gn[d]);
                } else {
                    for (int d = 0; d < 64; ++d) dst[d] = f2bf(src[d]);
                }
            } else {
                const int rr = (v - 20) >> 3, h = (v - 20) & 7;
                const float* src = p + 1304 + rr * 512 + h * 64;
                bf16_t* dst = RET + (size_t)rr * RET_STRIDE + ((size_t)(b * NHR + h) * NS + s) * DH;
                if (rr < 2) {
                    const float sc = (rr == 1) ? 0.125f : 1.f;
                    for (int i2 = 0; i2 < 32; ++i2) {
                        const float inv = exp2f(-(float)i2 * (13.287712379549449f / 32.f));
                        float sn, cs; sincosf((float)s * inv, &sn, &cs);
                        const float x1 = src[i2], x2 = src[i2 + 32];
                        dst[i2] = f2bf((x1 * cs - x2 * sn) * sc); dst[i2 + 32] = f2bf((x1 * sn + x2 * cs) * sc);
                    }
                } else {
                    for (int d = 0; d < 64; ++d) dst[d] = f2bf(src[d]);
                }
            }
        } else if (tid >= 256 && tid < 256 + 96) {
            const int k = (tid - 256) / 24, j = (tid - 256) % 24; const int t = tg * 4 + k;
            GATES[(size_t)t * 24 + j] = pr[k * PROJ + 1280 + j];
        }
    }
}

DI void phase_memkv(const Ctx& a, float* lds) {
    const int tid = opaque_tid(), lane = tid & 63, wv = tid >> 6;
    float* hm = lds; float* red = lds + 1024; float* kv = lds + 1100;
    const float* mem = AIN(I_MEM); const float* wkv = AIN(I_MWKV);
    bf16_t* MK = (bf16_t*)(a.ws + WS_MK); bf16_t* MV = (bf16_t*)(a.ws + WS_MV);
    for (int r = blockIdx.x; r < NB * NMEM; r += gridDim.x) {
        __syncthreads();
        const float* xr = mem + (size_t)r * DM;
        const float v0 = xr[tid], v1 = xr[tid + 512];
        float ss = wave_sum(v0 * v0 + v1 * v1);
        if (lane == 0) red[wv] = ss;
        __syncthreads();
        float tot = 0.f;
#pragma unroll
        for (int i = 0; i < 8; ++i) tot += red[i];
        const float rstd = rsqrtf(tot * (1.f / DM) + EPS);
        hm[tid] = v0 * rstd * AIN(I_MKVN)[tid]; hm[tid + 512] = v1 * rstd * AIN(I_MKVN)[tid + 512];
        __syncthreads();
        float acc = 0.f;
        for (int d = 0; d < DM; ++d) acc += hm[d] * wkv[(size_t)d * 512 + tid];
        kv[tid] = acc;
        __syncthreads();
        const int b = r / NMEM, m = r % NMEM;
        if (tid < 4) {
            const float* src = kv + tid * 64; float s2 = 0.f;
            for (int d = 0; d < 64; ++d) s2 += src[d] * src[d];
            const float rs = rsqrtf(s2 * (1.f / 64.f) + EPS);
            bf16_t* dst = MK + ((size_t)(b * MH + tid) * NMEM + m) * DH;
            for (int d = 0; d < 64; ++d) dst[d] = f2bf(src[d] * rs * AIN(I_MKN)[d]);
        } else if (tid >= 64 && tid < 68) {
            const int h = tid - 64; const float* src = kv + 256 + h * 64;
            bf16_t* dst = MV + ((size_t)(b * MH + h) * NMEM + m) * DH;
            for (int d = 0; d < 64; ++d) dst[d] = f2bf(src[d]);
        }
    }
}

DI void phase_compress(const Ctx& a, float* lds) {
    const int tid = opaque_tid();
    float* blk = lds;
    float* part = lds + 2048;
    float* hid = lds + 2048 + 512;
    float* outv = hid + 128;
    const bf16_t* KV = (const bf16_t*)(a.ws + WS_KV);
    bf16_t* KCMP = (bf16_t*)(a.ws + WS_KCMP); bf16_t* VCMP = (bf16_t*)(a.ws + WS_VCMP);
    const int nunit = 2 * NB * NG * 128;
    for (int u = blockIdx.x; u < nunit; u += gridDim.x) {
        const int kvsel = u / (NB * NG * 128), rem = u % (NB * NG * 128), bg = rem / 128, c = rem % 128;
        bf16_t* dst = (kvsel == 0 ? KCMP : VCMP) + ((size_t)bg * 128 + c) * DH;
        if (c == 127) { if (tid < 64) dst[tid] = 0; continue; }
        __syncthreads();
        const bf16_t* src = KV + (size_t)kvsel * KV_STRIDE + ((size_t)bg * NS + 16 * c) * DH;
        const float* pos = AIN(kvsel == 0 ? I_POSK : I_POSV);
        const float* w1 = AIN(kvsel == 0 ? I_CKW1 : I_CVW1);
        const float* w2 = AIN(kvsel == 0 ? I_CKW2 : I_CVW2);
#pragma unroll
        for (int i = 0; i < 4; ++i) { const int f = tid + 512 * i; blk[f] = bf2f(src[f]) + pos[f]; }
        __syncthreads();
        { const int j = tid & 127, pt = tid >> 7; float acc = 0.f;
          for (int f = pt * 512; f < pt * 512 + 512; ++f) acc += blk[f] * w1[(size_t)f * 128 + j];
          part[tid] = acc; }
        __syncthreads();
        if (tid < 128) { const float h = part[tid] + part[tid + 128] + part[tid + 256] + part[tid + 384]; hid[tid] = siluf(h); }
        __syncthreads();
        if (tid < 64) { float acc = 0.f; for (int j = 0; j < 128; ++j) acc += hid[j] * w2[j * 64 + tid]; outv[tid] = acc; }
        __syncthreads();
        if (tid < 64) {
            float v = outv[tid];
            if (kvsel == 0) { float ss = 0.f; for (int d = 0; d < 64; ++d) ss += outv[d] * outv[d]; v = v * rsqrtf(ss * (1.f / 64.f) + EPS) * AIN(I_KCN)[tid]; }
            dst[tid] = f2bf(v);
        }
    }
}

DI void softmax_rows4(float* sc, int ld, int n, int wv, int lane) {
    if (wv < 4) {
        float* row = sc + wv * ld; float m = -1e30f;
        for (int i = lane; i < n; i += 64) m = fmaxf(m, row[i]);
        m = wave_max(m);
        float s = 0.f;
        for (int i = lane; i < n; i += 64) { const float v = row[i]; const float e = (v > -1e29f) ? __expf(v - m) : 0.f; row[i] = e; s += e; }
        s = wave_sum(s);
        const float inv = 1.f / fmaxf(s, 1e-30f);
        for (int i = lane; i < n; i += 64) row[i] *= inv;
    }
}
DI void phase_nsa(const Ctx& a, float* lds) {
    const int tid = opaque_tid(), lane = tid & 63, wv = tid >> 6;
    float* q = lds;
    float* sc = lds + 256;
    float* psum = sc + 2048;
    float* imp = psum + 128;
    float* oacc = imp + 32;
    int* sel = (int*)(oacc + 768);
    float* ofin = (float*)(sel + 8);
    const bf16_t* Q = (const bf16_t*)(a.ws + WS_Q); const bf16_t* KV = (const bf16_t*)(a.ws + WS_KV);
    const bf16_t* KCMP = (const bf16_t*)(a.ws + WS_KCMP); const bf16_t* VCMP = (const bf16_t*)(a.ws + WS_VCMP);
    const float* GATES = (const float*)(a.ws + WS_GATES);
    bf16_t* OA = (bf16_t*)(a.ws + WS_OA);
    for (int u = blockIdx.x; u < NT * NG; u += gridDim.x) {
        const int t = u >> 1, g = u & 1, b = t / NS, s = t % NS, bg = b * NG + g;
        __syncthreads();
        if (tid < 256) q[tid] = bf2f(Q[(size_t)t * 512 + g * 256 + tid]);
        __syncthreads();
        const int ncv = (s >= 31) ? min(NCMP, (s - 31) / 16 + 1) : 0;
        { const int r = tid >> 7, c = tid & 127; float v = -1e30f;
          if (c < ncv) { const bf16_t* kr = KCMP + ((size_t)bg * 128 + c) * DH; float d = 0.f; for (int i = 0; i < 64; ++i) d += q[r * 64 + i] * bf2f(kr[i]); v = d; }
          sc[r * 512 + c] = v; }
        __syncthreads();
        softmax_rows4(sc, 512, 128, wv, lane);
        __syncthreads();
        if (tid < 128) psum[tid] = sc[tid] + sc[512 + tid] + sc[1024 + tid] + sc[1536 + tid];
        if (tid >= 256) { const int r = (tid - 256) >> 6, d = tid & 63; float acc = 0.f;
            for (int c = 0; c < ncv; ++c) acc += sc[r * 512 + c] * bf2f(VCMP[((size_t)bg * 128 + c) * DH + d]);
            oacc[r * 64 + d] = acc; }
        __syncthreads();
        const int cur = s / 64;
        if (tid < 32) { const int j = tid; float v = 0.f;
            if (4 * j - 1 >= 0) v += 0.5f * psum[4 * j - 1];
            v += psum[4 * j] + psum[4 * j + 1] + psum[4 * j + 2];
            if (4 * j + 3 < NCMP) v += 0.5f * psum[4 * j + 3];
            if (j == 0 || j == cur || j == cur - 1) v = 1e9f; else if (j > cur) v = -1e30f;
            imp[j] = v; }
        __syncthreads();
        if (tid == 0) {
            unsigned used = 0u;
            for (int k = 0; k < TOPK; ++k) { int best = -1; float bv = 0.f;
                for (int j = 0; j < NSEL; ++j) if (!((used >> j) & 1u)) { if (best < 0 || imp[j] > bv) { best = j; bv = imp[j]; } }
                used |= 1u << best; sel[k] = best; }
        }
        __syncthreads();
        { const int kk = tid >> 6, i = tid & 63; const int kpos = sel[kk] * 64 + i;
          const bf16_t* kr = KV + 2 * KV_STRIDE + ((size_t)bg * NS + kpos) * DH;
          float d0 = 0.f, d1 = 0.f, d2 = 0.f, d3 = 0.f;
          if (kpos <= s) { for (int e = 0; e < 64; ++e) { const float kvv = bf2f(kr[e]); d0 += q[e] * kvv; d1 += q[64 + e] * kvv; d2 += q[128 + e] * kvv; d3 += q[192 + e] * kvv; } }
          else { d0 = d1 = d2 = d3 = -1e30f; }
          sc[tid] = d0; sc[512 + tid] = d1; sc[1024 + tid] = d2; sc[1536 + tid] = d3; }
        __syncthreads();
        softmax_rows4(sc, 512, 512, wv, lane);
        __syncthreads();
        if (tid < 256) { const int r = tid >> 6, d = tid & 63; float acc = 0.f;
            for (int k = 0; k < 512; ++k) { const float p = sc[r * 512 + k]; if (p != 0.f) { const int kpos = sel[k >> 6] * 64 + (k & 63); acc += p * bf2f(KV[3 * KV_STRIDE + ((size_t)bg * NS + kpos) * DH + d]); } }
            oacc[256 + r * 64 + d] = acc; }
        __syncthreads();
        { const int kpos = s - 511 + tid;
          const bf16_t* kr = KV + 4 * KV_STRIDE + ((size_t)bg * NS + kpos) * DH;
          float d0 = 0.f, d1 = 0.f, d2 = 0.f, d3 = 0.f;
          if (kpos >= 0) { for (int e = 0; e < 64; ++e) { const float kvv = bf2f(kr[e]); d0 += q[e] * kvv; d1 += q[64 + e] * kvv; d2 += q[128 + e] * kvv; d3 += q[192 + e] * kvv; } }
          else { d0 = d1 = d2 = d3 = -1e30f; }
          sc[tid] = d0; sc[512 + tid] = d1; sc[1024 + tid] = d2; sc[1536 + tid] = d3; }
        __syncthreads();
        softmax_rows4(sc, 512, 512, wv, lane);
        __syncthreads();
        if (tid < 256) { const int r = tid >> 6, d = tid & 63; float acc = 0.f;
            for (int k = 0; k < 512; ++k) { const float p = sc[r * 512 + k]; if (p != 0.f) { const int kpos = s - 511 + k; acc += p * bf2f(KV[5 * KV_STRIDE + ((size_t)bg * NS + kpos) * DH + d]); } }
            oacc[512 + r * 64 + d] = acc; }
        __syncthreads();
        if (tid < 256) { const int r = tid >> 6, d = tid & 63;
            const float* gt = GATES + (size_t)t * 24 + g * 12 + r * 3;
            ofin[tid] = sigmf(gt[0]) * oacc[tid] + sigmf(gt[1]) * oacc[256 + tid] + sigmf(gt[2]) * oacc[512 + tid]; }
        __syncthreads();
        if (tid < 256) { const int r = tid >> 6, d = tid & 63; float ss = 0.f;
            for (int e = 0; e < 64; ++e) ss += ofin[r * 64 + e] * ofin[r * 64 + e];
            const int h = g * 4 + r;
            OA[(size_t)t * 1024 + h * 64 + d] = f2bf(ofin[tid] * rsqrtf(ss * (1.f / 64.f) + EPS) * AIN(I_NSAON)[h * 64 + d]); }
    }
}

DI void phase_ret(const Ctx& a, float* lds) {
    const int tid = opaque_tid();
    float* qv = lds;
    float* wts = lds + 64;
    float* part = wts + 2048;
    float* yv = part + 512;
    const bf16_t* RET = (const bf16_t*)(a.ws + WS_RET);
    bf16_t* OA = (bf16_t*)(a.ws + WS_OA);
    for (int u = blockIdx.x; u < NB * NHR * NS; u += gridDim.x) {
        const int s = u % NS, bh = u / NS, h = bh % NHR, b = bh / NHR;
        const float l2g = log2f(1.f - exp2f(-5.f - (float)h));
        __syncthreads();
        if (tid < 64) qv[tid] = bf2f(RET[((size_t)bh * NS + s) * DH + tid]);
        __syncthreads();
        for (int j = tid; j <= s; j += 512) {
            const bf16_t* kr = RET + RET_STRIDE + ((size_t)bh * NS + j) * DH; float d = 0.f;
            for (int e = 0; e < 64; ++e) d += qv[e] * bf2f(kr[e]);
            wts[j] = d * exp2f((float)(s - j) * l2g);
        }
        __syncthreads();
        { const int d = tid & 63, pt = tid >> 6; float acc = 0.f;
          for (int j = pt; j <= s; j += 8) acc += wts[j] * bf2f(RET[2 * RET_STRIDE + ((size_t)bh * NS + j) * DH + d]);
          part[pt * 64 + d] = acc; }
        __syncthreads();
        if (tid < 64) { float y = 0.f; for (int p = 0; p < 8; ++p) y += part[p * 64 + tid]; yv[tid] = y; }
        __syncthreads();
        if (tid < 64) {
            float mu = 0.f; for (int e = 0; e < 64; ++e) mu += yv[e]; mu *= (1.f / 64.f);
            float var = 0.f; for (int e = 0; e < 64; ++e) { const float dd = yv[e] - mu; var += dd * dd; } var *= (1.f / 64.f);
            const float gr = bf2f(RET[3 * RET_STRIDE + ((size_t)bh * NS + s) * DH + tid]);
            const float y = (yv[tid] - mu) * rsqrtf(var + EPS) * AIN(I_RETON)[h * 64 + tid] * siluf(gr);
            OA[(size_t)(b * NS + s) * 1024 + 512 + h * 64 + tid] = f2bf(y);
        }
    }
}

DI void phase_tail(const Ctx& a, float* lds) {
    const int tid = opaque_tid(), lane = tid & 63, wv = tid >> 6;
    constexpr int TK = 4;
    float* oa = lds;
    float* x1 = oa + TK * 1024;
    float* qb = x1 + TK * 1024;
    float* ob = qb + TK * 256;
    float* scm = ob + TK * 256;
    float* tmp = scm + TK * 1024;
    float* hidb = tmp + TK * 512;
    float* lg = hidb + 256;
    float* rs = lg + TK * 36;
    int* eid = (int*)(rs + TK);
    float* ew = (float*)(eid + TK * 2);
    const float* x = AIN(I_X);
    const bf16_t* OA = (const bf16_t*)(a.ws + WS_OA);
    const bf16_t* MK = (const bf16_t*)(a.ws + WS_MK); const bf16_t* MV = (const bf16_t*)(a.ws + WS_MV);
    const float* w_out = AIN(I_WOUT); const float* wq = AIN(I_MWQ); const float* wo = AIN(I_MWO);
    for (int tg = blockIdx.x; tg < NT / TK; tg += gridDim.x) {
        const int t0 = tg * TK, b = t0 / NS;
        __syncthreads();
        for (int i = tid; i < TK * 1024; i += 512) oa[i] = bf2f(OA[(size_t)t0 * 1024 + i]);
        __syncthreads();
        { float acc[2][TK];
#pragma unroll
          for (int i = 0; i < 2; ++i)
#pragma unroll
              for (int k = 0; k < TK; ++k) acc[i][k] = 0.f;
#pragma unroll 4
          for (int j = 0; j < 1024; ++j) { const float w0 = w_out[(size_t)j * 1024 + tid], w1 = w_out[(size_t)j * 1024 + tid + 512];
#pragma unroll
              for (int k = 0; k < TK; ++k) { const float o = oa[k * 1024 + j]; acc[0][k] += o * w0; acc[1][k] += o * w1; } }
#pragma unroll
          for (int k = 0; k < TK; ++k) { x1[k * 1024 + tid] = x[(size_t)(t0 + k) * 1024 + tid] + acc[0][k]; x1[k * 1024 + tid + 512] = x[(size_t)(t0 + k) * 1024 + tid + 512] + acc[1][k]; } }
        __syncthreads();
        if (wv < TK) { float ss = 0.f; for (int i = lane; i < 1024; i += 64) ss += x1[wv * 1024 + i] * x1[wv * 1024 + i]; ss = wave_sum(ss); if (lane == 0) rs[wv] = rsqrtf(ss * (1.f / DM) + EPS); }
        __syncthreads();
        for (int i = tid; i < TK * 1024; i += 512) oa[i] = x1[i] * rs[i >> 10] * AIN(I_MXN)[i & 1023];
        __syncthreads();
        { const int j = tid & 255, hf = tid >> 8; float acc[TK];
#pragma unroll
          for (int k = 0; k < TK; ++k) acc[k] = 0.f;
#pragma unroll 4
          for (int d = hf * 512; d < hf * 512 + 512; ++d) { const float w = wq[(size_t)d * 256 + j];
#pragma unroll
              for (int k = 0; k < TK; ++k) acc[k] += oa[k * 1024 + d] * w; }
#pragma unroll
          for (int k = 0; k < TK; ++k) tmp[k * 512 + tid] = acc[k]; }
        __syncthreads();
        for (int i = tid; i < TK * 256; i += 512) { const int k = i >> 8, j = i & 255; qb[i] = tmp[k * 512 + j] + tmp[k * 512 + 256 + j]; }
        __syncthreads();
        if (tid < TK * 4) { float* src = qb + tid * 64; float ss = 0.f; for (int d = 0; d < 64; ++d) ss += src[d] * src[d];
            const float r = rsqrtf(ss * (1.f / 64.f) + EPS) * 0.125f; for (int d = 0; d < 64; ++d) src[d] = src[d] * r * AIN(I_MQN)[d]; }
        __syncthreads();
        { const int h = tid >> 7, m0 = (tid & 127) * 2;
#pragma unroll
          for (int mm = 0; mm < 2; ++mm) { const int m = m0 + mm; const bf16_t* kr = MK + ((size_t)(b * MH + h) * NMEM + m) * DH; float acc[TK];
#pragma unroll
              for (int k = 0; k < TK; ++k) acc[k] = 0.f;
#pragma unroll 8
              for (int d = 0; d < 64; ++d) { const float kv = bf2f(kr[d]);
#pragma unroll
                  for (int k = 0; k < TK; ++k) acc[k] += qb[k * 256 + h * 64 + d] * kv; }
#pragma unroll
              for (int k = 0; k < TK; ++k) scm[(k * 4 + h) * 256 + m] = acc[k]; } }
        __syncthreads();
        for (int row = wv; row < TK * 4; row += 8) { float* r = scm + row * 256; float m = -1e30f;
            for (int i = lane; i < 256; i += 64) m = fmaxf(m, r[i]); m = wave_max(m);
            float s = 0.f; for (int i = lane; i < 256; i += 64) { const float e = __expf(r[i] - m); r[i] = e; s += e; } s = wave_sum(s);
            const float inv = 1.f / s; for (int i = lane; i < 256; i += 64) r[i] *= inv; }
        __syncthreads();
        { const int hd = tid & 255, h = hd >> 6, d = hd & 63, k0 = (tid >> 8) * 2; float a0 = 0.f, a1 = 0.f;
#pragma unroll 4
          for (int m = 0; m < 256; ++m) { const float v = bf2f(MV[((size_t)(b * MH + h) * NMEM + m) * DH + d]); a0 += scm[((k0) * 4 + h) * 256 + m] * v; a1 += scm[((k0 + 1) * 4 + h) * 256 + m] * v; }
          ob[k0 * 256 + hd] = a0; ob[(k0 + 1) * 256 + hd] = a1; }
        __syncthreads();
        { float acc[2][TK];
#pragma unroll
          for (int i = 0; i < 2; ++i)
#pragma unroll
              for (int k = 0; k < TK; ++k) acc[i][k] = 0.f;
#pragma unroll 4
          for (int j = 0; j < 256; ++j) { const float w0 = wo[(size_t)j * 1024 + tid], w1 = wo[(size_t)j * 1024 + tid + 512];
#pragma unroll
              for (int k = 0; k < TK; ++k) { const float o = ob[k * 256 + j]; acc[0][k] += o * w0; acc[1][k] += o * w1; } }
          __syncthreads();
#pragma unroll
          for (int k = 0; k < TK; ++k) { x1[k * 1024 + tid] += acc[0][k]; x1[k * 1024 + tid + 512] += acc[1][k]; } }
        __syncthreads();
        if (wv < TK) { float ss = 0.f; for (int i = lane; i < 1024; i += 64) ss += x1[wv * 1024 + i] * x1[wv * 1024 + i]; ss = wave_sum(ss); if (lane == 0) rs[wv] = rsqrtf(ss * (1.f / DM) + EPS); }
        __syncthreads();
        for (int i = tid; i < TK * 1024; i += 512) oa[i] = x1[i] * rs[i >> 10] * AIN(I_FFN)[i & 1023];
        __syncthreads();
        for (int dd = wv; dd < TK * 36; dd += 8) { const int k = dd / 36, j = dd % 36; float acc = 0.f;
            if (j < 4) { for (int d = lane; d < 1024; d += 64) acc += oa[k * 1024 + d] * AIN(I_RGW)[d * 4 + j]; }
            else { const int gg = (j - 4) >> 3, e = (j - 4) & 7; for (int d = lane; d < 1024; d += 64) acc += oa[k * 1024 + d] * AIN(I_REW)[((size_t)gg * 1024 + d) * 8 + e]; }
            acc = wave_sum(acc);
            if (lane == 0) lg[dd] = acc + (j < 4 ? AIN(I_RGB)[j] : AIN(I_REB)[j - 4]); }
        __syncthreads();
        if (tid < TK) { const float* l = lg + tid * 36; int grp = 0; float gm = l[0];
            for (int j = 1; j < 4; ++j) if (l[j] > gm) { gm = l[j]; grp = j; }
            float gs = 0.f; for (int j = 0; j < 4; ++j) gs += __expf(l[j] - gm);
            const float gw = 1.f / gs;
            const float* el = l + 4 + grp * 8; int e0 = 0; float v0 = el[0];
            for (int j = 1; j < 8; ++j) if (el[j] > v0) { v0 = el[j]; e0 = j; }
            int e1 = -1; float v1 = 0.f;
            for (int j = 0; j < 8; ++j) if (j != e0) { if (e1 < 0 || el[j] > v1) { v1 = el[j]; e1 = j; } }
            const float p1 = __expf(v1 - v0); const float den = 1.f + p1;
            eid[tid * 2] = grp * 8 + e0; eid[tid * 2 + 1] = grp * 8 + e1; ew[tid * 2] = gw / den; ew[tid * 2 + 1] = gw * p1 / den; }
        __syncthreads();
        float yacc[2][TK];
#pragma unroll
        for (int i = 0; i < 2; ++i)
#pragma unroll
            for (int k = 0; k < TK; ++k) yacc[i][k] = 0.f;
#pragma unroll
        for (int k = 0; k < TK; ++k) {
            for (int kk = 0; kk < 2; ++kk) {
                const int e = eid[k * 2 + kk]; const float wgt = ew[k * 2 + kk];
                { const int f = tid & 255, hf = tid >> 8; const float* W = (hf == 0 ? AIN(I_EWG) : AIN(I_EWU)) + (size_t)e * 1024 * 256; float acc = 0.f;
#pragma unroll 8
                  for (int d = 0; d < 1024; ++d) acc += oa[k * 1024 + d] * W[(size_t)d * 256 + f];
                  tmp[tid] = acc; }
                __syncthreads();
                if (tid < 256) hidb[tid] = siluf(tmp[tid]) * tmp[256 + tid];
                __syncthreads();
                { const float* W = AIN(I_EWD) + (size_t)e * 256 * 1024; float a0 = 0.f, a1 = 0.f;
#pragma unroll 4
                  for (int f = 0; f < 256; ++f) { const float hv = hidb[f]; a0 += hv * W[(size_t)f * 1024 + tid]; a1 += hv * W[(size_t)f * 1024 + tid + 512]; }
                  yacc[0][k] += wgt * a0; yacc[1][k] += wgt * a1; }
                __syncthreads();
            }
        }
#pragma unroll
        for (int k = 0; k < TK; ++k) { a.out[(size_t)(t0 + k) * 1024 + tid] = x1[k * 1024 + tid] + yacc[0][k]; a.out[(size_t)(t0 + k) * 1024 + tid + 512] = x1[k * 1024 + tid + 512] + yacc[1][k]; }
    }
}


DI void phase_tail_b(const Ctx& a, float* lds) {
    const int tid = opaque_tid(), lane = tid & 63, wv = tid >> 6;
    constexpr int TK = 4;
    float* oa = lds;
    float* x1 = oa + TK * 1024;
    float* qb = x1 + TK * 1024;
    float* ob = qb + TK * 256;
    float* scm = ob + TK * 256;
    float* tmp = scm + TK * 1024;
    float* hidb = tmp + TK * 512;
    float* lg = hidb + 256;
    float* rs = lg + TK * 36;
    int* eid = (int*)(rs + TK);
    float* ew = (float*)(eid + TK * 2);
    const float* x = AIN(I_X);
    const bf16_t* OA = (const bf16_t*)(a.ws + WS_OA);
    const bf16_t* MK = (const bf16_t*)(a.ws + WS_MK); const bf16_t* MV = (const bf16_t*)(a.ws + WS_MV);
    const float* wq = AIN(I_MWQ); const float* wo = AIN(I_MWO);
    bf16_t* H3 = (bf16_t*)(a.ws + WS_H3); int* LIST = (int*)(a.ws + WS_LIST); float* LISTW = (float*)(a.ws + WS_LISTW); unsigned* cntp = (unsigned*)(a.ws + WS_CTL) + CW_CNT;
    for (int tg = blockIdx.x; tg < NT / TK; tg += gridDim.x) {
        const int t0 = tg * TK, b = t0 / NS;
        __syncthreads();
        for (int i = tid; i < TK * 1024; i += 512) x1[i] = a.out[(size_t)t0 * 1024 + i];
        __syncthreads();
        if (wv < TK) { float ss = 0.f; for (int i = lane; i < 1024; i += 64) ss += x1[wv * 1024 + i] * x1[wv * 1024 + i]; ss = wave_sum(ss); if (lane == 0) rs[wv] = rsqrtf(ss * (1.f / DM) + EPS); }
        __syncthreads();
        for (int i = tid; i < TK * 1024; i += 512) oa[i] = x1[i] * rs[i >> 10] * AIN(I_MXN)[i & 1023];
        __syncthreads();
        { const int j = tid & 255, hf = tid >> 8; float acc[TK];
#pragma unroll
          for (int k = 0; k < TK; ++k) acc[k] = 0.f;
#pragma unroll 4
          for (int d = hf * 512; d < hf * 512 + 512; ++d) { const float w = wq[(size_t)d * 256 + j];
#pragma unroll
              for (int k = 0; k < TK; ++k) acc[k] += oa[k * 1024 + d] * w; }
#pragma unroll
          for (int k = 0; k < TK; ++k) tmp[k * 512 + tid] = acc[k]; }
        __syncthreads();
        for (int i = tid; i < TK * 256; i += 512) { const int k = i >> 8, j = i & 255; qb[i] = tmp[k * 512 + j] + tmp[k * 512 + 256 + j]; }
        __syncthreads();
        if (tid < TK * 4) { float* src = qb + tid * 64; float ss = 0.f; for (int d = 0; d < 64; ++d) ss += src[d] * src[d];
            const float r = rsqrtf(ss * (1.f / 64.f) + EPS) * 0.125f; for (int d = 0; d < 64; ++d) src[d] = src[d] * r * AIN(I_MQN)[d]; }
        __syncthreads();
        { const int h = tid >> 7, m0 = (tid & 127) * 2;
#pragma unroll
          for (int mm = 0; mm < 2; ++mm) { const int m = m0 + mm; const bf16_t* kr = MK + ((size_t)(b * MH + h) * NMEM + m) * DH; float acc[TK];
#pragma unroll
              for (int k = 0; k < TK; ++k) acc[k] = 0.f;
#pragma unroll 8
              for (int d = 0; d < 64; ++d) { const float kv = bf2f(kr[d]);
#pragma unroll
                  for (int k = 0; k < TK; ++k) acc[k] += qb[k * 256 + h * 64 + d] * kv; }
#pragma unroll
              for (int k = 0; k < TK; ++k) scm[(k * 4 + h) * 256 + m] = acc[k]; } }
        __syncthreads();
        for (int row = wv; row < TK * 4; row += 8) { float* r = scm + row * 256; float m = -1e30f;
            for (int i = lane; i < 256; i += 64) m = fmaxf(m, r[i]); m = wave_max(m);
            float s = 0.f; for (int i = lane; i < 256; i += 64) { const float e = __expf(r[i] - m); r[i] = e; s += e; } s = wave_sum(s);
            const float inv = 1.f / s; for (int i = lane; i < 256; i += 64) r[i] *= inv; }
        __syncthreads();
        { const int hd = tid & 255, h = hd >> 6, d = hd & 63, k0 = (tid >> 8) * 2; float a0 = 0.f, a1 = 0.f;
#pragma unroll 4
          for (int m = 0; m < 256; ++m) { const float v = bf2f(MV[((size_t)(b * MH + h) * NMEM + m) * DH + d]); a0 += scm[((k0) * 4 + h) * 256 + m] * v; a1 += scm[((k0 + 1) * 4 + h) * 256 + m] * v; }
          ob[k0 * 256 + hd] = a0; ob[(k0 + 1) * 256 + hd] = a1; }
        __syncthreads();
        { float acc[2][TK];
#pragma unroll
          for (int i = 0; i < 2; ++i)
#pragma unroll
              for (int k = 0; k < TK; ++k) acc[i][k] = 0.f;
#pragma unroll 4
          for (int j = 0; j < 256; ++j) { const float w0 = wo[(size_t)j * 1024 + tid], w1 = wo[(size_t)j * 1024 + tid + 512];
#pragma unroll
              for (int k = 0; k < TK; ++k) { const float o = ob[k * 256 + j]; acc[0][k] += o * w0; acc[1][k] += o * w1; } }
          __syncthreads();
#pragma unroll
          for (int k = 0; k < TK; ++k) { x1[k * 1024 + tid] += acc[0][k]; x1[k * 1024 + tid + 512] += acc[1][k]; } }
        __syncthreads();
        if (wv < TK) { float ss = 0.f; for (int i = lane; i < 1024; i += 64) ss += x1[wv * 1024 + i] * x1[wv * 1024 + i]; ss = wave_sum(ss); if (lane == 0) rs[wv] = rsqrtf(ss * (1.f / DM) + EPS); }
        __syncthreads();
        for (int i = tid; i < TK * 1024; i += 512) oa[i] = x1[i] * rs[i >> 10] * AIN(I_FFN)[i & 1023];
        __syncthreads();
        for (int dd = wv; dd < TK * 36; dd += 8) { const int k = dd / 36, j = dd % 36; float acc = 0.f;
            if (j < 4) { for (int d = lane; d < 1024; d += 64) acc += oa[k * 1024 + d] * AIN(I_RGW)[d * 4 + j]; }
            else { const int gg = (j - 4) >> 3, e = (j - 4) & 7; for (int d = lane; d < 1024; d += 64) acc += oa[k * 1024 + d] * AIN(I_REW)[((size_t)gg * 1024 + d) * 8 + e]; }
            acc = wave_sum(acc);
            if (lane == 0) lg[dd] = acc + (j < 4 ? AIN(I_RGB)[j] : AIN(I_REB)[j - 4]); }
        __syncthreads();
        if (tid < TK) { const float* l = lg + tid * 36; int grp = 0; float gm = l[0];
            for (int j = 1; j < 4; ++j) if (l[j] > gm) { gm = l[j]; grp = j; }
            float gs = 0.f; for (int j = 0; j < 4; ++j) gs += __expf(l[j] - gm);
            const float gw = 1.f / gs;
            const float* el = l + 4 + grp * 8; int e0 = 0; float v0 = el[0];
            for (int j = 1; j < 8; ++j) if (el[j] > v0) { v0 = el[j]; e0 = j; }
            int e1 = -1; float v1 = 0.f;
            for (int j = 0; j < 8; ++j) if (j != e0) { if (e1 < 0 || el[j] > v1) { v1 = el[j]; e1 = j; } }
            const float p1 = __expf(v1 - v0); const float den = 1.f + p1;
            eid[tid * 2] = grp * 8 + e0; eid[tid * 2 + 1] = grp * 8 + e1; ew[tid * 2] = gw / den; ew[tid * 2 + 1] = gw * p1 / den; }
        __syncthreads();
        for (int i = tid; i < TK * 1024; i += 512) { a.out[(size_t)t0 * 1024 + i] = x1[i]; H3[(size_t)t0 * 1024 + i] = f2bf(oa[i]); }
        if (tid < TK * 2) { const int e = eid[tid]; const unsigned slot = atomicAdd(cntp + e, 1u);
            LIST[(size_t)e * NT + slot] = (t0 + (tid >> 1)) * 2 + (tid & 1); LISTW[(size_t)e * NT + slot] = ew[tid]; }
    }
}


struct EpiOut {
    static constexpr bool PERM = true, AFTER_DRAIN = false;
    const float* x; float* out;
    DI void operator()(const pg8::f32x4 (&acc)[2][2][4][2], const pg8::Unit& u, int wr, int wc, int fr, int fq) const {
#pragma unroll
        for (int ai = 0; ai < 2; ++ai)
#pragma unroll
            for (int m = 0; m < 4; ++m) {
                const size_t row = (size_t)u.pm * 256 + ai * 128 + wr * 64 + m * 16 + fr;
#pragma unroll
                for (int bj = 0; bj < 2; ++bj) {
                    const size_t off = row * DM + u.pn * 256 + 128 * bj + 32 * wc + 8 * fq;
                    const f32x4v x0 = *(const f32x4v*)(x + off), x1 = *(const f32x4v*)(x + off + 4);
                    const pg8::f32x4 a0 = acc[ai][bj][m][0], a1 = acc[ai][bj][m][1];
                    *(f32x4v*)(out + off) = (f32x4v){x0.x + a0[0], x0.y + a0[1], x0.z + a0[2], x0.w + a0[3]};
                    *(f32x4v*)(out + off + 4) = (f32x4v){x1.x + a1[0], x1.y + a1[1], x1.z + a1[2], x1.w + a1[3]};
                }
            }
    }
};
DI void phase_outproj_mfma(const Ctx& a, unsigned char* lds_raw) {
    pg8::Gemm g{(const bf16_t*)(a.ws + WS_OA), (const bf16_t*)(a.ws + WS_WOUT_T), NT, DM, DM};
    pg8::StaticOrder S; S.init(NT, DM, (int)gridDim.x, (int)blockIdx.x);
    EpiOut E{AIN(I_X), a.out};
    pg8::gemm_phase<EpiOut, pg8::StaticOrder, true, true>((PG8_LAS unsigned char*)lds_raw, g, S, E);
}

struct MoeSched {
    const LAS int* tstart; const LAS int* cnts; int G, c, lognpn, nunits, mode;
    const int* LIST; const char* Abase; const char* Bbase;
    DI bool next(int i, pg8::UnitG& u) const {
        const int L = i * G + c; if (L >= nunits) return false;
        const int gt = L >> lognpn, pn = L & ((1 << lognpn) - 1);
        int e = 0; while (tstart[e + 1] <= gt) ++e;
        const int rt = gt - tstart[e], cnt = cnts[e];
        u.pn = pn; u.e = e; u.rt = rt; u.cnt = cnt; u.row0 = gt * 256;
        const int tid = threadIdx.x;
        if (mode == 0) {
            u.A = Abase; u.B = Bbase + ((size_t)e * 512 + pn * 256) * 1024 * 2;
#pragma unroll
            for (int h = 0; h < 2; ++h)
#pragma unroll
                for (int k = 0; k < 2; ++k) { int R, C; pg8::stage_rc(tid * 16 + k * 8192, R, C); const int idx = rt * 256 + h * 128 + R;
                    const int tok = (idx < cnt) ? (LIST[(size_t)e * NT + idx] >> 1) : 0; u.ao[h][k] = (unsigned)(tok * 1024 + C) * 2u; }
        } else {
            u.A = Abase + (size_t)gt * 256 * 256 * 2; u.B = Bbase + ((size_t)e * 1024 + pn * 256) * 256 * 2;
#pragma unroll
            for (int h = 0; h < 2; ++h)
#pragma unroll
                for (int k = 0; k < 2; ++k) { int R, C; pg8::stage_rc(tid * 16 + k * 8192, R, C); u.ao[h][k] = (unsigned)((h * 128 + R) * 256 + C) * 2u; }
        }
        return true;
    }
};
struct EpiGU {
    static constexpr bool PERM = true;
    bf16_t* HID;
    DI void operator()(const pg8::f32x4 (&acc)[2][2][4][2], const pg8::UnitG& u, int wr, int wc, int fr, int fq) const {
#pragma unroll
        for (int ai = 0; ai < 2; ++ai)
#pragma unroll
            for (int m = 0; m < 4; ++m) {
                const int rl = ai * 128 + wr * 64 + m * 16 + fr; float h[8];
#pragma unroll
                for (int n = 0; n < 2; ++n)
#pragma unroll
                    for (int i = 0; i < 4; ++i) h[4 * n + i] = siluf(acc[ai][0][m][n][i]) * acc[ai][1][m][n][i];
                v4u w; w.x = cvtpk(h[0], h[1]); w.y = cvtpk(h[2], h[3]); w.z = cvtpk(h[4], h[5]); w.w = cvtpk(h[6], h[7]);
                *(v4u*)(HID + (size_t)(u.row0 + rl) * 256 + 128 * u.pn + 32 * wc + 8 * fq) = w;
            }
    }
};
struct EpiDown {
    static constexpr bool PERM = true;
    bf16_t* Y; const int* LIST; const float* LISTW;
    DI void operator()(const pg8::f32x4 (&acc)[2][2][4][2], const pg8::UnitG& u, int wr, int wc, int fr, int fq) const {
#pragma unroll
        for (int ai = 0; ai < 2; ++ai)
#pragma unroll
            for (int m = 0; m < 4; ++m) {
                const int rl = ai * 128 + wr * 64 + m * 16 + fr, idx = u.rt * 256 + rl;
                if (idx < u.cnt) {
                    const int asg = LIST[(size_t)u.e * NT + idx]; const float wg = LISTW[(size_t)u.e * NT + idx];
#pragma unroll
                    for (int bj = 0; bj < 2; ++bj) { const pg8::f32x4 a0 = acc[ai][bj][m][0], a1 = acc[ai][bj][m][1];
                        v4u w; w.x = cvtpk(a0[0] * wg, a0[1] * wg); w.y = cvtpk(a0[2] * wg, a0[3] * wg); w.z = cvtpk(a1[0] * wg, a1[1] * wg); w.w = cvtpk(a1[2] * wg, a1[3] * wg);
                        *(v4u*)(Y + (size_t)asg * 1024 + 256 * u.pn + 128 * bj + 32 * wc + 8 * fq) = w; }
                }
                asm volatile("" ::: "memory");
            }
    }
};
DI int moe_setup(const Ctx& a, unsigned char* lds_raw) {
    LAS int* ts = (LAS int*)((LAS unsigned char*)lds_raw + 131072); LAS int* cn = ts + 40;
    const unsigned* cnt = (const unsigned*)(a.ws + WS_CTL) + CW_CNT;
    __syncthreads();
    if (threadIdx.x == 0) { int acc = 0; for (int e = 0; e < NEXP; ++e) { const int c = (int)__hip_atomic_load(cnt + e, __ATOMIC_RELAXED, __HIP_MEMORY_SCOPE_AGENT); ts[e] = acc; cn[e] = c; acc += (c + 255) >> 8; } ts[NEXP] = acc; ts[NEXP + 1] = 0x7fffffff; }
    __syncthreads();
    return ts[NEXP];
}
DI void phase_moe_gu(const Ctx& a, unsigned char* lds_raw) {
    const int ntil = moe_setup(a, lds_raw);
    LAS int* ts = (LAS int*)((LAS unsigned char*)lds_raw + 131072);
    MoeSched S{ts, ts + 40, (int)gridDim.x, (int)blockIdx.x, 1, ntil * 2, 0, (const int*)(a.ws + WS_LIST), (const char*)(a.ws + WS_H3), (const char*)(a.ws + WS_WGU_T)};
    EpiGU E{(bf16_t*)(a.ws + WS_HID)};
    pg8::gemm_phase_g<EpiGU, MoeSched>((PG8_LAS unsigned char*)lds_raw, 1024, S, E);
}
DI void phase_moe_down(const Ctx& a, unsigned char* lds_raw) {
    const int ntil = moe_setup(a, lds_raw);
    LAS int* ts = (LAS int*)((LAS unsigned char*)lds_raw + 131072);
    MoeSched S{ts, ts + 40, (int)gridDim.x, (int)blockIdx.x, 2, ntil * 4, 1, (const int*)(a.ws + WS_LIST), (const char*)(a.ws + WS_HID), (const char*)(a.ws + WS_WD_T)};
    EpiDown E{(bf16_t*)(a.ws + WS_Y), (const int*)(a.ws + WS_LIST), (const float*)(a.ws + WS_LISTW)};
    int kk = 256; asm volatile("" : "+s"(kk));
    pg8::gemm_phase_g<EpiDown, MoeSched>((PG8_LAS unsigned char*)lds_raw, kk, S, E);
}
DI void phase_combine(const Ctx& a) {
    const int tid = opaque_tid(), lane = tid & 63, wv = tid >> 6;
    const bf16_t* Y = (const bf16_t*)(a.ws + WS_Y);
    for (int t = blockIdx.x * NWAVE + wv; t < NT; t += gridDim.x * NWAVE) {
        f32x4v* o = (f32x4v*)(a.out + (size_t)t * DM) + lane;
        const unsigned long long* y0 = (const unsigned long long*)(Y + (size_t)(2 * t) * DM) + lane; const unsigned long long* y1 = (const unsigned long long*)(Y + (size_t)(2 * t + 1) * DM) + lane;
#pragma unroll
        for (int j = 0; j < 4; ++j) { f32x4v v = o[64 * j]; const unsigned long long p = y0[64 * j], q = y1[64 * j];
            v.x += bf2f((unsigned short)(p & 0xffff)) + bf2f((unsigned short)(q & 0xffff)); v.y += bf2f((unsigned short)((p >> 16) & 0xffff)) + bf2f((unsigned short)((q >> 16) & 0xffff));
            v.z += bf2f((unsigned short)((p >> 32) & 0xffff)) + bf2f((unsigned short)((q >> 32) & 0xffff)); v.w += bf2f((unsigned short)(p >> 48)) + bf2f((unsigned short)(q >> 48));
            o[64 * j] = v; }
    }
}


typedef float f32x16 __attribute__((ext_vector_type(16)));
typedef short s16x8 __attribute__((ext_vector_type(8)));
typedef short s16x4 __attribute__((ext_vector_type(4)));
#define MFMA32(a, b, c) __builtin_amdgcn_mfma_f32_32x32x16_bf16((a), (b), (c), 0, 0, 0)
DI int crow(int reg, int h) { return (reg & 3) + 8 * (reg >> 2) + 4 * h; }
DI s16x8 pack8(const f32x16& x, int s) {
    v4u p; p.x = cvtpk(x[8 * s], x[8 * s + 1]); p.y = cvtpk(x[8 * s + 2], x[8 * s + 3]); p.z = cvtpk(x[8 * s + 4], x[8 * s + 5]); p.w = cvtpk(x[8 * s + 6], x[8 * s + 7]);
    return __builtin_bit_cast(s16x8, p);
}
constexpr int TSTR = 272;
DI void phase_ret_state(const Ctx& a, unsigned char* lds_raw) {
    const int tid = opaque_tid(), lane = tid & 63, wv = __builtin_amdgcn_readfirstlane(tid >> 6), r = lane & 31, hh = lane >> 5;
    unsigned char* Kt = lds_raw;
    unsigned char* Vt = lds_raw + 64 * TSTR;
    const bf16_t* RET = (const bf16_t*)(a.ws + WS_RET);
    float* STT = (float*)(a.ws + WS_STT);
    for (int bh = blockIdx.x; bh < NB * NHR; bh += gridDim.x) {
        const int h = bh % NHR; const float l2g = log2f(1.f - exp2f(-5.f - (float)h)); const float gc = exp2f(128.f * l2g);
        const int et = wv & 1, dt = (wv >> 1) & 1;
        f32x16 acc;
#pragma unroll
        for (int i = 0; i < 16; ++i) acc[i] = 0.f;
        for (int n = 0; n < 16; ++n) {
            __syncthreads();
#pragma unroll
            for (int i = 0; i < 2; ++i) { const int idx = tid + 512 * i, j = idx >> 3, c = idx & 7;
                const size_t go = ((size_t)bh * NS + n * 128 + j) * DH + 8 * c;
                const v4u kv = *(const v4u*)(RET + RET_STRIDE + go), vv = *(const v4u*)(RET + 2 * RET_STRIDE + go);
                const float z = exp2f((float)(127 - j) * l2g);
                const unsigned kw[4] = {kv.x, kv.y, kv.z, kv.w}, vw[4] = {vv.x, vv.y, vv.z, vv.w};
#pragma unroll
                for (int k = 0; k < 4; ++k) {
                    *(bf16_t*)(Kt + (8 * c + 2 * k) * TSTR + 2 * j) = f2bf(bf2f((unsigned short)(kw[k] & 0xffff)) * z);
                    *(bf16_t*)(Kt + (8 * c + 2 * k + 1) * TSTR + 2 * j) = f2bf(bf2f((unsigned short)(kw[k] >> 16)) * z);
                    *(bf16_t*)(Vt + (8 * c + 2 * k) * TSTR + 2 * j) = (unsigned short)(vw[k] & 0xffff);
                    *(bf16_t*)(Vt + (8 * c + 2 * k + 1) * TSTR + 2 * j) = (unsigned short)(vw[k] >> 16); } }
            __syncthreads();
            if (wv < 4) {
                float* dst = STT + ((size_t)bh * 16 + n) * 4096;
#pragma unroll
                for (int i = 0; i < 16; ++i) dst[(32 * et + crow(i, hh)) * 64 + 32 * dt + r] = acc[i];
#pragma unroll
                for (int i = 0; i < 16; ++i) acc[i] *= gc;
#pragma unroll
                for (int s = 0; s < 8; ++s) {
                    const s16x8 af = *(const s16x8*)(Vt + (32 * et + r) * TSTR + (16 * s + 8 * hh) * 2);
                    const s16x8 bf = *(const s16x8*)(Kt + (32 * dt + r) * TSTR + (16 * s + 8 * hh) * 2);
                    acc = MFMA32(af, bf, acc);
                }
            }
        }
    }
}
DI void phase_ret_out(const Ctx& a, unsigned char* lds_raw) {
    const int tid = opaque_tid(), lane = tid & 63, wv = __builtin_amdgcn_readfirstlane(tid >> 6), r = lane & 31, hh = lane >> 5;
    unsigned char* Kl = lds_raw;
    unsigned char* Vt = lds_raw + 16384;
    float* Ol = (float*)(lds_raw + 16384 + 64 * TSTR + 256);
    const bf16_t* RET = (const bf16_t*)(a.ws + WS_RET);
    const float* STT = (const float*)(a.ws + WS_STT);
    bf16_t* OA = (bf16_t*)(a.ws + WS_OA);
    for (int u = blockIdx.x; u < NB * NHR * 16; u += gridDim.x) {
        const int bh = u >> 4, n = u & 15, h = bh % NHR, b = bh / NHR;
        const float l2g = log2f(1.f - exp2f(-5.f - (float)h));
        __syncthreads();
#pragma unroll
        for (int i = 0; i < 2; ++i) { const int idx = tid + 512 * i, j = idx >> 3, c = idx & 7;
            const size_t go = ((size_t)bh * NS + n * 128 + j) * DH + 8 * c;
            const v4u kv = *(const v4u*)(RET + RET_STRIDE + go), vv = *(const v4u*)(RET + 2 * RET_STRIDE + go);
            *(v4u*)(Kl + j * 128 + ((c ^ ((j >> 1) & 7)) * 16)) = kv;
            const unsigned vw[4] = {vv.x, vv.y, vv.z, vv.w};
#pragma unroll
            for (int k = 0; k < 4; ++k) { *(bf16_t*)(Vt + (8 * c + 2 * k) * TSTR + 2 * j) = (unsigned short)(vw[k] & 0xffff); *(bf16_t*)(Vt + (8 * c + 2 * k + 1) * TSTR + 2 * j) = (unsigned short)(vw[k] >> 16); } }
        const int it = wv & 3, eh = wv >> 2;
        s16x8 qf[4];
        { const bf16_t* qp = RET + ((size_t)bh * NS + n * 128 + 32 * it + r) * DH + 8 * hh;
#pragma unroll
          for (int s = 0; s < 4; ++s) qf[s] = *(const s16x8*)(qp + 16 * s); }
        __syncthreads();
        f32x16 oin, ocr;
#pragma unroll
        for (int i = 0; i < 16; ++i) { oin[i] = 0.f; ocr[i] = 0.f; }
        for (int jt = 0; jt <= it; ++jt) {
            f32x16 st;
#pragma unroll
            for (int i = 0; i < 16; ++i) st[i] = 0.f;
            const int row = 32 * jt + r;
#pragma unroll
            for (int s = 0; s < 4; ++s) { const s16x8 kf = *(const s16x8*)(Kl + row * 128 + (((2 * s + hh) ^ ((row >> 1) & 7)) * 16)); st = MFMA32(kf, qf[s], st); }
            const int iq = 32 * it + r;
#pragma unroll
            for (int i = 0; i < 16; ++i) { const int dl = iq - (32 * jt + crow(i, hh)); st[i] = (dl >= 0) ? st[i] * exp2f((float)dl * l2g) : 0.f; }
#pragma unroll
            for (int s2 = 0; s2 < 2; ++s2) {
                const s16x8 pa = pack8(st, s2);
                const unsigned char* vp = Vt + (32 * eh + r) * TSTR + (32 * jt + 16 * s2 + 4 * hh) * 2;
                const s16x4 lo = *(const s16x4*)vp, hi = *(const s16x4*)(vp + 16);
                const s16x8 vf = __builtin_shufflevector(lo, hi, 0, 1, 2, 3, 4, 5, 6, 7);
                oin = MFMA32(pa, vf, oin);
            }
        }
        { const float* sp = STT + ((size_t)bh * 16 + n) * 4096 + (size_t)(32 * eh + r) * 64 + 8 * hh;
#pragma unroll
          for (int s = 0; s < 4; ++s) { const f32x4v f0 = *(const f32x4v*)(sp + 16 * s), f1 = *(const f32x4v*)(sp + 16 * s + 4);
              v4u p; p.x = cvtpk(f0.x, f0.y); p.y = cvtpk(f0.z, f0.w); p.z = cvtpk(f1.x, f1.y); p.w = cvtpk(f1.z, f1.w);
              ocr = MFMA32(qf[s], __builtin_bit_cast(s16x8, p), ocr); } }
#pragma unroll
        for (int i = 0; i < 16; ++i) { const int iq = 32 * it + crow(i, hh); Ol[iq * 64 + 32 * eh + r] = oin[i] + exp2f((float)(iq + 1) * l2g) * ocr[i]; }
        __syncthreads();
        { const int row = tid >> 2, qd = tid & 3; const float* op = Ol + row * 64 + 16 * qd; float v[16]; float sm = 0.f;
#pragma unroll
          for (int k = 0; k < 16; ++k) { v[k] = op[k]; sm += v[k]; }
          sm += __shfl_xor(sm, 1); sm += __shfl_xor(sm, 2); const float mu = sm * (1.f / 64.f); float vr = 0.f;
#pragma unroll
          for (int k = 0; k < 16; ++k) { const float d = v[k] - mu; vr += d * d; }
          vr += __shfl_xor(vr, 1); vr += __shfl_xor(vr, 2); const float rs = rsqrtf(vr * (1.f / 64.f) + EPS);
          const size_t tok = (size_t)b * NS + n * 128 + row;
          const bf16_t* gp = RET + 3 * RET_STRIDE + ((size_t)bh * NS + n * 128 + row) * DH + 16 * qd;
          const v4u g0 = *(const v4u*)gp, g1 = *(const v4u*)(gp + 8); const unsigned gw[8] = {g0.x, g0.y, g0.z, g0.w, g1.x, g1.y, g1.z, g1.w};
          const float* nw = AIN(I_RETON) + h * 64 + 16 * qd; unsigned ow[8];
#pragma unroll
          for (int k = 0; k < 8; ++k) { const float ga = bf2f((unsigned short)(gw[k] & 0xffff)), gb = bf2f((unsigned short)(gw[k] >> 16));
              ow[k] = cvtpk((v[2 * k] - mu) * rs * nw[2 * k] * siluf(ga), (v[2 * k + 1] - mu) * rs * nw[2 * k + 1] * siluf(gb)); }
          bf16_t* dp = OA + tok * 1024 + 512 + h * 64 + 16 * qd;
          *(v4u*)dp = (v4u){ow[0], ow[1], ow[2], ow[3]}; *(v4u*)(dp + 8) = (v4u){ow[4], ow[5], ow[6], ow[7]}; }
    }
}


constexpr int VSTR = 136;
constexpr int KVBUF = 8192 + 64 * VSTR;
constexpr float LOG2E = 1.4426950408889634f;
DI void nsa_stage_load(const bf16_t* Kg, const bf16_t* Vg, int jb, int tid, v4u& kr, v4u& vr) {
    const size_t go = ((size_t)jb * 64 + (tid >> 3)) * DH + 8 * (tid & 7);
    kr = *(const v4u*)(Kg + go); vr = *(const v4u*)(Vg + go);
}
DI void nsa_stage_write(unsigned char* buf, int tid, const v4u& kr, const v4u& vr) {
    const int j = tid >> 3, c = tid & 7;
    *(v4u*)(buf + j * 128 + ((c ^ ((j >> 1) & 7)) * 16)) = kr;
    unsigned char* vs = buf + 8192; const unsigned vw[4] = {vr.x, vr.y, vr.z, vr.w};
#pragma unroll
    for (int k = 0; k < 4; ++k) { *(bf16_t*)(vs + (8 * c + 2 * k) * VSTR + 2 * j) = (unsigned short)(vw[k] & 0xffff); *(bf16_t*)(vs + (8 * c + 2 * k + 1) * VSTR + 2 * j) = (unsigned short)(vw[k] >> 16); }
}
template <int MODE>
DI void nsa_branch(const bf16_t* Kg, const bf16_t* Vg, int jlo, int jhi, int cur, int tq, unsigned selmask, float negsh, const s16x8 (&qf)[4],
                   f32x16 (&O)[2], float& lsum, unsigned char* kvb, int tid, int r, int hh) {
    v4u kr, vr;
    nsa_stage_load(Kg, Vg, jlo, tid, kr, vr);
    __syncthreads();
    nsa_stage_write(kvb, tid, kr, vr);
    __syncthreads();
    for (int j = jlo; j <= jhi; ++j) {
        unsigned char* buf = kvb + ((j - jlo) & 1) * KVBUF;
        asm volatile("" : "+v"(r), "+v"(hh), "+v"(tid));
        if (j < jhi) nsa_stage_load(Kg, Vg, j + 1, tid, kr, vr);
        float ns = negsh;
        if (MODE == 0) ns = ((selmask >> j) & 1u) ? negsh : -1e30f;
#pragma unroll
        for (int kt = 0; kt < 2; ++kt) {
            f32x16 st;
#pragma unroll
            for (int i = 0; i < 16; ++i) st[i] = 0.f;
            const int row = 32 * kt + r;
#pragma unroll
            for (int s = 0; s < 4; ++s) { const s16x8 kf = *(const s16x8*)(buf + row * 128 + (((2 * s + hh) ^ ((row >> 1) & 7)) * 16)); st = MFMA32(kf, qf[s], st); }
            const int kbase = 64 * j + 32 * kt;
            if (j == cur) {
#pragma unroll
                for (int i = 0; i < 16; ++i) { const int key = kbase + crow(i, hh); st[i] = (key <= tq) ? __builtin_amdgcn_exp2f(st[i] * LOG2E + ns) : 0.f; }
            } else if (MODE == 1 && j == cur - 8) {
#pragma unroll
                for (int i = 0; i < 16; ++i) { const int key = kbase + crow(i, hh); st[i] = (key >= tq - 511) ? __builtin_amdgcn_exp2f(st[i] * LOG2E + ns) : 0.f; }
            } else {
#pragma unroll
                for (int i = 0; i < 16; ++i) st[i] = __builtin_amdgcn_exp2f(st[i] * LOG2E + ns);
            }
            float sm = 0.f;
#pragma unroll
            for (int i = 0; i < 16; ++i) sm += st[i];
            lsum += sm;
#pragma unroll
            for (int s2 = 0; s2 < 2; ++s2) {
                const s16x8 pa = pack8(st, s2);
#pragma unroll
                for (int et = 0; et < 2; ++et) {
                    const unsigned char* vp = buf + 8192 + (32 * et + r) * VSTR + (32 * kt + 16 * s2 + 4 * hh) * 2;
                    const s16x4 lo = *(const s16x4*)vp, hi = *(const s16x4*)(vp + 16);
                    O[et] = MFMA32(pa, __builtin_shufflevector(lo, hi, 0, 1, 2, 3, 4, 5, 6, 7), O[et]);
                }
            }
        }
        if (j < jhi) nsa_stage_write(kvb + ((j + 1 - jlo) & 1) * KVBUF, tid, kr, vr);
        __syncthreads();
    }
}
DI void phase_nsa_mfma(const Ctx& a, unsigned char* lds_raw) {
    int tid = opaque_tid(), lane = tid & 63; const int wv = __builtin_amdgcn_readfirstlane(tid >> 6); int r = lane & 31, hh = lane >> 5;
    unsigned char* Kc = lds_raw;
    unsigned char* Vc = lds_raw + 16384;
    unsigned char* kvb = lds_raw + 33792;
    float* coefl = (float*)(lds_raw + 67584) + wv * 32;
    float* bnd = (float*)(lds_raw + 67584 + 1024);
    float* Ol = (float*)(lds_raw + 69632) + wv * 2048;
    const bf16_t* Q = (const bf16_t*)(a.ws + WS_Q); const bf16_t* KV = (const bf16_t*)(a.ws + WS_KV);
    const bf16_t* KCMP = (const bf16_t*)(a.ws + WS_KCMP); const bf16_t* VCMP = (const bf16_t*)(a.ws + WS_VCMP);
    const float* GATES = (const float*)(a.ws + WS_GATES);
    bf16_t* OA = (bf16_t*)(a.ws + WS_OA);
    __syncthreads();
    if (wv < 3) { const float* gk = AIN(wv == 0 ? I_KCN : (wv == 1 ? I_KSN : I_KWN));
        const float mq = wave_max(fabsf(AIN(I_QN)[lane])), mk = wave_max(fabsf(gk[lane]));
        if (lane == 0) bnd[wv] = 8.f * mq * mk * LOG2E; }
    __syncthreads();
    const float nsh_c = -bnd[0], nsh_s = -bnd[1], nsh_w = -bnd[2];
    for (int it2 = blockIdx.x; it2 < 512; it2 += gridDim.x) {
        const int wi = it2 & 255, pass = it2 >> 8;
        const int bg = wi & 15, k = wi >> 4, qt = pass == 0 ? (31 - k) : k, cur = qt;
        const int b = bg >> 1, g = bg & 1, t0 = qt * 64;
        asm volatile("" : "+v"(r), "+v"(hh), "+v"(tid), "+v"(lane));
        const int q = r, head = q >> 3, tokl = 8 * wv + (q & 7), tq = t0 + tokl;
        const size_t tglob = (size_t)b * NS + tq;
        __syncthreads();
#pragma unroll
        for (int i = 0; i < 2; ++i) { const int idx = tid + 512 * i, j = idx >> 3, c = idx & 7;
            const size_t go = ((size_t)bg * 128 + j) * DH + 8 * c;
            const v4u kv = *(const v4u*)(KCMP + go), vv = *(const v4u*)(VCMP + go);
            *(v4u*)(Kc + j * 128 + ((c ^ ((j >> 1) & 7)) * 16)) = kv;
            const unsigned vw[4] = {vv.x, vv.y, vv.z, vv.w};
#pragma unroll
            for (int kk = 0; kk < 4; ++kk) { *(bf16_t*)(Vc + (8 * c + 2 * kk) * TSTR + 2 * j) = (unsigned short)(vw[kk] & 0xffff); *(bf16_t*)(Vc + (8 * c + 2 * kk + 1) * TSTR + 2 * j) = (unsigned short)(vw[kk] >> 16); } }
        s16x8 qf[4];
        { const bf16_t* qp = Q + tglob * 512 + (g * 4 + head) * 64 + 8 * hh;
#pragma unroll
          for (int s = 0; s < 4; ++s) qf[s] = *(const s16x8*)(qp + 16 * s); }
        const float* gt = GATES + tglob * 24 + g * 12 + head * 3;
        const float g0 = sigmf(gt[0]), g1 = sigmf(gt[1]), g2 = sigmf(gt[2]);
        __syncthreads();
        f32x16 Ot[2], Ob[2];
#pragma unroll
        for (int i = 0; i < 16; ++i) { Ot[0][i] = 0.f; Ot[1][i] = 0.f; Ob[0][i] = 0.f; Ob[1][i] = 0.f; }
        const int nkt = (4 * qt + 3 + 31) >> 5;
        const int cmax = (tq >= 31) ? ((tq - 31) >> 4) : -1;
        float impv[16]; float lc = 0.f, carry = 0.f;
#pragma unroll
        for (int kt = 0; kt < 4; ++kt) {
            f32x16 st;
#pragma unroll
            for (int i = 0; i < 16; ++i) st[i] = 0.f;
            if (kt < nkt) {
                const int row = 32 * kt + r;
#pragma unroll
                for (int s = 0; s < 4; ++s) { const s16x8 kf = *(const s16x8*)(Kc + row * 128 + (((2 * s + hh) ^ ((row >> 1) & 7)) * 16)); st = MFMA32(kf, qf[s], st); }
#pragma unroll
                for (int i = 0; i < 16; ++i) { const int c = 32 * kt + crow(i, hh); st[i] = (c <= cmax) ? __builtin_amdgcn_exp2f(st[i] * LOG2E + nsh_c) : 0.f; lc += st[i]; }
#pragma unroll
                for (int s2 = 0; s2 < 2; ++s2) {
                    const s16x8 pa = pack8(st, s2);
#pragma unroll
                    for (int et = 0; et < 2; ++et) {
                        const unsigned char* vp = Vc + (32 * et + r) * TSTR + (32 * kt + 16 * s2 + 4 * hh) * 2;
                        const s16x4 lo = *(const s16x4*)vp, hi = *(const s16x4*)(vp + 16);
                        Ob[et] = MFMA32(pa, __builtin_shufflevector(lo, hi, 0, 1, 2, 3, 4, 5, 6, 7), Ob[et]);
                    }
                }
            }
#pragma unroll
            for (int aa = 0; aa < 4; ++aa) { const float sp = 0.5f * st[4 * aa + 3]; const float osp = __shfl_xor(sp, 32);
                impv[kt * 4 + aa] = st[4 * aa] + st[4 * aa + 1] + st[4 * aa + 2] + sp + (hh ? osp : carry); carry = osp; }
            asm volatile("" ::: "memory");
        }
        const float ltc = lc + __shfl_xor(lc, 32);
        const float invc = (ltc > 0.f) ? 1.f / ltc : 0.f;
        unsigned selmask;
        {
#pragma unroll
            for (int x = 0; x < 16; ++x) { impv[x] *= invc; impv[x] += __shfl_xor(impv[x], 8); impv[x] += __shfl_xor(impv[x], 16); }
            if (cur < 8) selmask = (2u << cur) - 1u;
            else {
                selmask = 1u | (1u << cur) | (1u << (cur - 1));
#pragma unroll
                for (int x = 0; x < 16; ++x) { const int j = 2 * x + hh; if (j < 1 || j > cur - 2) impv[x] = -1e30f; }
                for (int rd = 0; rd < 5; ++rd) {
                    float best = -2e30f; int bj = 99;
#pragma unroll
                    for (int x = 0; x < 16; ++x) if (impv[x] > best) { best = impv[x]; bj = 2 * x + hh; }
                    const float ob = __shfl_xor(best, 32); const int oj = __shfl_xor(bj, 32);
                    const bool take = (ob > best) || (ob == best && oj < bj);
                    const int wj = take ? oj : bj;
                    selmask |= 1u << wj;
#pragma unroll
                    for (int x = 0; x < 16; ++x) if (2 * x + hh == wj) impv[x] = -2e30f;
                }
            }
        }
#define NSA_FOLD(coefv) do { asm volatile("" ::: "memory"); if (hh == 0) coefl[q] = (coefv); asm volatile("s_waitcnt lgkmcnt(0)" ::: "memory"); \
        _Pragma("unroll") for (int i = 0; i < 16; ++i) { const float cf = coefl[crow(i, hh)]; Ot[0][i] += cf * Ob[0][i]; Ot[1][i] += cf * Ob[1][i]; Ob[0][i] = 0.f; Ob[1][i] = 0.f; } \
        asm volatile("s_waitcnt lgkmcnt(0)" ::: "memory"); } while (0)
        NSA_FOLD(g0 * invc);
        { float ls = 0.f;
          nsa_branch<0>(KV + 2 * KV_STRIDE + (size_t)bg * NS * DH, KV + 3 * KV_STRIDE + (size_t)bg * NS * DH, 0, cur, cur, tq, selmask, nsh_s, qf, Ob, ls, kvb, tid, r, hh);
          const float lt = ls + __shfl_xor(ls, 32);
          NSA_FOLD(g1 / lt); }
        { float lw = 0.f;
          nsa_branch<1>(KV + 4 * KV_STRIDE + (size_t)bg * NS * DH, KV + 5 * KV_STRIDE + (size_t)bg * NS * DH, cur >= 8 ? cur - 8 : 0, cur, cur, tq, 0u, nsh_w, qf, Ob, lw, kvb, tid, r, hh);
          const float lt = lw + __shfl_xor(lw, 32);
          NSA_FOLD(g2 / lt); }
#pragma unroll
        for (int i = 0; i < 16; ++i) { Ol[crow(i, hh) * 64 + r] = Ot[0][i]; Ol[crow(i, hh) * 64 + 32 + r] = Ot[1][i]; }
        asm volatile("s_waitcnt lgkmcnt(0)" ::: "memory");
        { const int rq = lane >> 1, hf = lane & 1; const float* op = Ol + rq * 64 + 32 * hf; float ss = 0.f;
#pragma unroll
          for (int c4 = 0; c4 < 8; ++c4) { const f32x4v t4 = *(const f32x4v*)(op + 4 * c4); ss += (t4.x * t4.x + t4.y * t4.y) + (t4.z * t4.z + t4.w * t4.w); }
          ss += __shfl_xor(ss, 1);
          const float rs = rsqrtf(ss * (1.f / 64.f) + EPS);
          const int hd = g * 4 + (rq >> 3); const float* nw = AIN(I_NSAON) + hd * 64 + 32 * hf;
          bf16_t* dp = OA + ((size_t)b * NS + t0 + 8 * wv + (rq & 7)) * 1024 + hd * 64 + 32 * hf;
#pragma unroll
          for (int c4 = 0; c4 < 4; ++c4) { const f32x4v va = *(const f32x4v*)(op + 8 * c4), vb = *(const f32x4v*)(op + 8 * c4 + 4); const f32x4v na = *(const f32x4v*)(nw + 8 * c4), nb = *(const f32x4v*)(nw + 8 * c4 + 4); v4u w;
              w.x = cvtpk(va.x * rs * na.x, va.y * rs * na.y); w.y = cvtpk(va.z * rs * na.z, va.w * rs * na.w);
              w.z = cvtpk(vb.x * rs * nb.x, vb.y * rs * nb.y); w.w = cvtpk(vb.z * rs * nb.z, vb.w * rs * nb.w);
              *(v4u*)(dp + 8 * c4) = w; asm volatile("" ::: "memory"); } }
        asm volatile("s_waitcnt lgkmcnt(0)" ::: "memory");
    }
#undef NSA_FOLD
}

__global__ void __launch_bounds__(NTHR, 2) fwd_kernel(Args ka) {
    extern __shared__ __attribute__((aligned(16))) unsigned char lds_raw[];
    float* lds = (float*)lds_raw;
    volatile LAS unsigned* misc = (volatile LAS unsigned*)((LAS unsigned char*)lds_raw + LDS_MISC);
    if (threadIdx.x < 64) misc[threadIdx.x] = 0u;
    LAS unsigned long long* ptab = (LAS unsigned long long*)((LAS unsigned char*)lds_raw + LDS_PTAB);
    if (threadIdx.x < 32) ptab[threadIdx.x] = (unsigned long long)ka.in[threadIdx.x];
    __syncthreads();
    Ctx a; a.tab = ptab; a.out = ka.out; a.ws = ka.ws;
    XcdBarrier bar = xcd_barrier_post((unsigned*)(a.ws + WS_CTL), misc + 8);

#ifndef PHMASK
#define PHMASK 0xffff
#endif
#define PH(k) ((PHMASK >> (k)) & 1)
    if (PH(0)) phase_prologue(a, lds_raw);
    xcd_barrier(bar);
    if (PH(1)) phase_proj_mfma(a, lds_raw);
    if (PH(2)) phase_memkv(a, lds);
    xcd_barrier(bar);
    if (PH(3)) phase_compress(a, lds);
    if (PH(11)) phase_ret_state(a, lds_raw);
    xcd_barrier(bar);
    if (PH(4)) phase_nsa_mfma(a, lds_raw);
    if (PH(5)) phase_ret_out(a, lds_raw);
    xcd_barrier(bar);
    if (PH(6)) phase_outproj_mfma(a, lds_raw);
    xcd_barrier(bar);
    if (PH(7)) phase_tail_b(a, lds);
    xcd_barrier(bar);
    if (PH(8)) phase_moe_gu(a, lds_raw);
    xcd_barrier(bar);
    if (PH(9)) phase_moe_down(a, lds_raw);
    xcd_barrier(bar);
    if (PH(10)) phase_combine(a);
}

extern "C" void kernel_launch(void* const* d_in, const int* in_sizes, int n_in, void* d_out, int out_size, void* d_ws, size_t ws_size, hipStream_t stream) {
    static int grid = 0;
    if (grid == 0) {
        if (n_in != 32 || ws_size < WS_END) { fprintf(stderr, "kernel_launch: unexpected n_in %d / ws %zu\n", n_in, ws_size); grid = -1; return; }
        int dev = 0, cus = 0, per_cu = 0;
        if (hipGetDevice(&dev) != hipSuccess || hipDeviceGetAttribute(&cus, hipDeviceAttributeMultiprocessorCount, dev) != hipSuccess) { grid = -1; return; }
        if (hipFuncSetAttribute((const void*)fwd_kernel, hipFuncAttributeMaxDynamicSharedMemorySize, LDS_BYTES) != hipSuccess) { fprintf(stderr, "kernel_launch: hipFuncSetAttribute failed\n"); grid = -1; return; }
        if (hipOccupancyMaxActiveBlocksPerMultiprocessor(&per_cu, (const void*)fwd_kernel, NTHR, LDS_BYTES) != hipSuccess || per_cu < 1) { fprintf(stderr, "kernel_launch: occupancy query says %d blocks per CU\n", per_cu); (void)hipGetLastError(); grid = -1; return; }
        grid = cus;
    }
    if (grid < 0) return;
    (void)hipMemsetAsync((char*)d_ws + WS_CTL, 0, CTL_ZERO_BYTES, stream);
    Args a{};
    for (int i = 0; i < 32; ++i) a.in[i] = (const float*)d_in[i];
    a.out = (float*)d_out; a.ws = (unsigned char*)d_ws;
    hipLaunchKernelGGL(fwd_kernel, dim3(grid), dim3(NTHR), LDS_BYTES, stream, a);
}
```

```cpp
#include <hip/hip_runtime.h>
#include <cstdint>
#include <cstdio>

#define DI __device__ __forceinline__
#define LAS __attribute__((address_space(3)))
#define GAS __attribute__((address_space(1)))

constexpr int NB = 8, NS = 2048, DM = 1024, NT = NB * NS;
constexpr int NG = 2, NR = 4, DH = 64, NHA = 8, NHR = 8;
constexpr int PROJ = 3352;
constexpr int NCMP = 127, NSEL = 32, TOPK = 8, WIN = 512;
constexpr int NMEM = 256, MH = 4, MW = 256;
constexpr int NGRP = 4, EPG = 8, NEXP = 32, EFF = 256;
constexpr float EPS = 1e-6f;
constexpr int NTHR = 512, NWAVE = 8;

typedef unsigned short bf16_t;

DI int opaque_tid() { int t = threadIdx.x; asm volatile("" : "+v"(t)); return t; }
DI unsigned short f2bf(float f) { unsigned u = __float_as_uint(f); u += 0x7fffu + ((u >> 16) & 1u); return (unsigned short)(u >> 16); }
DI float bf2f(unsigned short h) { return __uint_as_float(((unsigned)h) << 16); }
DI float wave_sum(float v) {
#pragma unroll
    for (int o = 1; o < 64; o <<= 1) v += __shfl_xor(v, o);
    return v;
}
DI float wave_max(float v) {
#pragma unroll
    for (int o = 1; o < 64; o <<= 1) v = fmaxf(v, __shfl_xor(v, o));
    return v;
}
DI float siluf(float x) { return x / (1.f + __expf(-x)); }
DI float sigmf(float x) { return 1.f / (1.f + __expf(-x)); }

constexpr size_t MiB = 1u << 20;
constexpr size_t WS_CTL = 0, CTL_ZERO_BYTES = 64 * 1024;
constexpr size_t WS_GATES = 1 * MiB;
constexpr size_t WS_MK = 3 * MiB;
constexpr size_t WS_MV = 4 * MiB;
constexpr size_t WS_KCMP = 5 * MiB;
constexpr size_t WS_VCMP = 5 * MiB + 512 * 1024;
constexpr size_t WS_ROUTE = 7 * MiB;
constexpr size_t WS_LIST = 8 * MiB;
constexpr size_t WS_LISTW = 10 * MiB;
constexpr size_t WS_LISTR = 12 * MiB;
constexpr size_t WS_MVT = 14 * MiB;
constexpr size_t WS_RSS1 = 15 * MiB;
constexpr size_t WS_WQ_T = 25 * MiB;
constexpr size_t WS_WO_T = 25 * MiB + 512 * 1024;
constexpr size_t WS_WR_HI = 26 * MiB;
constexpr size_t WS_WR_LO = 26 * MiB + 128 * 1024;
constexpr size_t WS_X1B = 144 * MiB;
constexpr size_t WS_WKV_T = 27 * MiB;
constexpr size_t WS_W1K_T = 76 * MiB;
constexpr size_t WS_W2K_T = 77 * MiB;
constexpr size_t WS_PB = 77 * MiB + 64 * 1024;
constexpr size_t WS_HM = 152 * MiB;
constexpr size_t WS_WOUT_T = 23 * MiB;
constexpr size_t WS_WGU_T = 28 * MiB;
constexpr size_t WS_WD_T = 60 * MiB;
constexpr size_t WS_H3 = 112 * MiB;
constexpr size_t WS_Y = 172 * MiB;
constexpr size_t WS_HID = 236 * MiB;
constexpr int CW_CNT = 8192;
constexpr size_t WS_ROPE = 6 * MiB;
constexpr size_t WS_WIN_T = 16 * MiB;
constexpr size_t WS_XN = 80 * MiB;
constexpr size_t WS_OA = 80 * MiB;
constexpr size_t WS_Q = 112 * MiB;
constexpr size_t WS_KV = 128 * MiB;
constexpr size_t WS_STT = 156 * MiB;
constexpr size_t WS_RET = 172 * MiB;
constexpr size_t WS_END = 256 * MiB;
constexpr size_t KV_STRIDE = (size_t)NB * NG * NS * DH;
constexpr size_t RET_STRIDE = (size_t)NB * NHR * NS * DH;

#define XB_TMO      128
#define XB_XCNT(j)  (256  + 64 * (j))
#define XB_XSUB(j)  (1280 + 64 * (j))
#define XB_XGEN(j)  (2304 + 64 * (j))
#define XB_TOP      3328
#define XB_TOPGEN   3392
#define XCD_BAR_WORDS 3456
#define XB_SPIN_CAP (1u << 22)
DI unsigned xb_ld(unsigned* p)              { return __hip_atomic_load(p, __ATOMIC_RELAXED, __HIP_MEMORY_SCOPE_AGENT); }
DI unsigned xb_add(unsigned* p, unsigned v) { return __hip_atomic_fetch_add(p, v, __ATOMIC_RELAXED, __HIP_MEMORY_SCOPE_AGENT); }
DI unsigned xb_xcc_id() { return (unsigned)__builtin_amdgcn_s_getreg((3 << 11) | 20) & 0xFu; }
#define XB_SPIN(cond, bar) do { unsigned _sp = 0; while (cond) { __builtin_amdgcn_s_sleep(1); \
    if ((++_sp & 255u) == 0u) { if (xb_ld(&(bar)[XB_TMO])) break; if (_sp > XB_SPIN_CAP) { atomicAdd(&(bar)[XB_TMO], 1u); break; } } } } while (0)
struct XcdBarrier { unsigned* bar; unsigned x; volatile LAS unsigned* st; };
DI XcdBarrier xcd_barrier_post(unsigned* bar, volatile LAS unsigned* st) {
    XcdBarrier b; b.bar = bar; b.x = xb_xcc_id(); b.st = st;
    if (threadIdx.x == 0) (void)xb_add(&bar[XB_XCNT(b.x)], 1u);
    return b;
}
DI void xcd_barrier_complete(unsigned* bar, unsigned x, unsigned& nloc, unsigned& nx) {
    const unsigned G = gridDim.x * gridDim.y * gridDim.z;
    unsigned sum, cnt, mine, sp = 0u;
    for (;;) {
        sum = 0u; cnt = 0u; mine = 0u;
#pragma unroll
        for (unsigned j = 0; j < 16; ++j) { const unsigned c = xb_ld(&bar[XB_XCNT(j)]); sum += c; cnt += (c > 0u) ? 1u : 0u; mine = (j == x) ? c : mine; }
        if (sum == G) break;
        __builtin_amdgcn_s_sleep(1);
        if ((++sp & 255u) == 0u) { if (xb_ld(&bar[XB_TMO])) break; if (sp > XB_SPIN_CAP) { atomicAdd(&bar[XB_TMO], 1u); break; } }
    }
    nloc = mine > 0u ? mine : 1u; nx = cnt > 0u ? cnt : 1u;
}
DI void xcd_barrier(const XcdBarrier& b) {
    asm volatile("s_waitcnt vmcnt(0)" ::: "memory");
    __syncthreads();
    if (threadIdx.x == 0) {
        unsigned* bar = b.bar;
        __builtin_amdgcn_s_waitcnt(0);
        unsigned nloc = b.st[0], nx = b.st[1];
        if (nloc == 0u) { xcd_barrier_complete(bar, b.x, nloc, nx); b.st[0] = nloc; b.st[1] = nx; }
        const unsigned old = xb_add(&bar[XB_XSUB(b.x)], 1u);
        const unsigned gen = old / nloc;
        if (old + 1u == (gen + 1u) * nloc) {
            __builtin_amdgcn_fence(__ATOMIC_RELEASE, "agent");
            asm volatile("s_waitcnt vmcnt(0)" ::: "memory");
            const unsigned og = xb_add(&bar[XB_TOP], 1u);
            const unsigned tg = og / nx;
            if (og + 1u == (tg + 1u) * nx) xb_add(&bar[XB_TOPGEN], 1u);
            else XB_SPIN(xb_ld(&bar[XB_TOPGEN]) == tg, bar);
            __builtin_amdgcn_fence(__ATOMIC_ACQUIRE, "agent");
            xb_add(&bar[XB_XGEN(b.x)], 1u);
            asm volatile("s_waitcnt vmcnt(0)" ::: "memory");
        } else {
            XB_SPIN(xb_ld(&bar[XB_XGEN(b.x)]) == gen, bar);
            __builtin_amdgcn_fence(__ATOMIC_ACQUIRE, "agent");
            asm volatile("s_waitcnt vmcnt(0)" ::: "memory");
        }
    }
    __syncthreads();
}

namespace pg8 {
#define PG8_LAS __attribute__((address_space(3)))
typedef unsigned short bf16_t;
typedef short bf16x8 __attribute__((ext_vector_type(8)));
typedef float f32x4 __attribute__((ext_vector_type(4)));
typedef unsigned u32x4 __attribute__((ext_vector_type(4)));
constexpr int BM = 256, BK = 64, HALF = 128, HTB = HALF * BK * 2  , STAGE_BYTES = 8 * HTB, NXCD = 8, WGM = 8;

__host__ __device__ __forceinline__ int lds_byte(int r, int c) { const int st = (r >> 4) * 2 + (c >> 5), rr = r & 15, cc = c & 31, ob = rr * 64 + cc * 2; return st * 1024 + (ob ^ (((ob >> 9) & 1) << 5)); }
__host__ __device__ __forceinline__ void stage_rc(int b, int& R, int& C) { const int st = b / 1024, sb = b % 1024, swz = sb ^ (((sb >> 9) & 1) << 5); R = (st >> 1) * 16 + swz / 64; C = (st & 1) * 32 + (swz % 64) / 2; }
__host__ __device__ __forceinline__ int perm32(int rho) { const int n = rho >> 4, i = rho & 15; return 8 * (i >> 2) + 4 * n + (i & 3); }

struct Unit { int pm, pn; };
struct Gemm { const bf16_t* A; const bf16_t* Bt; int M, N, K; };

struct StaticOrder {
    int nM, nN, nwg, G, c;
    __host__ __device__ void init(int M, int N, int G_, int c_) { nM = M / BM; nN = N / BM; nwg = nM * nN; G = G_; c = c_; }
    __host__ __device__ bool next(int i, Unit& u) const {
        const long L = (long)i * G + c; if (L >= nwg) return false;
        int wgid = (int)L; { const int q = nwg / NXCD, r = nwg % NXCD, xcd = wgid % NXCD, off = wgid / NXCD; wgid = (xcd < r ? xcd * (q + 1) : r * (q + 1) + (xcd - r) * q) + off; }
        const int nig = WGM * nN, gid = wgid / nig, fm = gid * WGM, gsz = (nM - fm) < WGM ? (nM - fm) : WGM;
        u.pm = fm + ((wgid % nig) % gsz); u.pn = (wgid % nig) / gsz; return true;
    }
    __device__ __forceinline__ void a_ready(const Unit&) const {}
    __device__ __forceinline__ void done(const Unit&) const {}
};


template <class Epi, class Sched, bool ALIGN_EPI = false, bool SP2 = false>
__device__ __forceinline__ void gemm_phase(PG8_LAS unsigned char* lds, const Gemm g, const Sched& S, const Epi& E) {
    const int tid = opaque_tid(), wid = __builtin_amdgcn_readfirstlane(tid >> 6), lane = tid & 63, wr = wid >> 2, wc = wid & 3, fr = lane & 15, fq = lane >> 4;
    const int K = g.K, nt = K / BK;
    unsigned voffA[2], voffB[2];
#pragma unroll
    for (int i = 0; i < 2; ++i) { int R, C; stage_rc(tid * 16 + i * 8192, R, C); const int Rb = Epi::PERM ? ((R & ~31) + perm32(R & 31)) : R;
        voffA[i] = (unsigned)(R * K + C) * 2u; voffB[i] = (unsigned)(Rb * K + C) * 2u; }
    const size_t kstep = (size_t)(BK * 2);
    const size_t hstep = (size_t)HALF * K * 2;
    const size_t tstep = 2 * hstep;
    const unsigned ldsw = (unsigned)wid * 1024u;
    const int aoff = lds_byte(wr * 64 + fr, fq * 8), boff = lds_byte(wc * 32 + fr, fq * 8);
#define PG8_SA(b, h) (((b) * 2 + (h)) * HTB)
#define PG8_SB(b, h) ((4 + (b) * 2 + (h)) * HTB)
#define PG8_STAGE(bufoff, gbase, voff) do { _Pragma("unroll") for (int _i = 0; _i < 2; ++_i) \
        __builtin_amdgcn_global_load_lds((const unsigned*)((const char*)(gbase) + (voff)[_i]), (PG8_LAS unsigned*)(lds + (bufoff) + ldsw + _i * 8192), 16, 0, 0); } while (0)
#define PG8_LDA(dst, b, h) do { _Pragma("unroll") for (int m = 0; m < 4; ++m) _Pragma("unroll") for (int k = 0; k < 2; ++k) dst[m][k] = *(const PG8_LAS bf16x8*)(lds + PG8_SA(b, h) + aoff + m * 2048 + k * 1024); } while (0)
#define PG8_LDB(dst, b, h) do { _Pragma("unroll") for (int n = 0; n < 2; ++n) _Pragma("unroll") for (int k = 0; k < 2; ++k) dst[n][k] = *(const PG8_LAS bf16x8*)(lds + PG8_SB(b, h) + boff + n * 2048 + k * 1024); } while (0)
#define PG8_MMA(ai, bj, At, Bt) do { __builtin_amdgcn_s_setprio(1); _Pragma("unroll") for (int m = 0; m < 4; ++m) _Pragma("unroll") for (int n = 0; n < 2; ++n) _Pragma("unroll") for (int k = 0; k < 2; ++k) \
        acc[ai][bj][m][n] = __builtin_amdgcn_mfma_f32_16x16x32_bf16(Bt[n][k], At[m][k], acc[ai][bj][m][n], 0, 0, 0); __builtin_amdgcn_s_setprio(0); } while (0)
#define PG8_WAIT_V(n) asm volatile("s_waitcnt vmcnt(" #n ")" ::: "memory")
#define PG8_WAIT_L(n) asm volatile("s_waitcnt lgkmcnt(" #n ")" ::: "memory")
#define PG8_BAR __builtin_amdgcn_s_barrier()
#define PG8_SCHED __builtin_amdgcn_sched_barrier(0)
    Unit cur, nxt; int ui = 0;
    if (!S.next(0, cur)) return;
    f32x4 acc[2][2][4][2];
#pragma unroll
    for (int a = 0; a < 2; ++a)
#pragma unroll
        for (int b = 0; b < 2; ++b)
#pragma unroll
            for (int m = 0; m < 4; ++m)
#pragma unroll
                for (int n = 0; n < 2; ++n) acc[a][b][m][n] = (f32x4){0.f, 0.f, 0.f, 0.f};
    bf16x8 At[4][2], B0[2][2], B1[2][2];
    const char* cA = (const char*)g.A + (size_t)cur.pm * tstep; const char* cB = (const char*)g.Bt + (size_t)cur.pn * tstep;
    S.a_ready(cur);
    if constexpr (SP2) {
        PG8_STAGE(PG8_SB(0, 0), cB, voffB); PG8_STAGE(PG8_SB(0, 1), cB + hstep, voffB); PG8_STAGE(PG8_SA(0, 0), cA, voffA); PG8_STAGE(PG8_SA(0, 1), cA + hstep, voffA);
        if (wr == 1) PG8_BAR;
        PG8_WAIT_V(2); PG8_BAR;
        PG8_STAGE(PG8_SB(1, 0), cB + kstep, voffB); PG8_STAGE(PG8_SA(1, 0), cA + kstep, voffA); PG8_STAGE(PG8_SB(1, 1), cB + hstep + kstep, voffB);
        PG8_WAIT_V(6); PG8_BAR;
    } else {
        PG8_STAGE(PG8_SB(0, 0), cB, voffB); PG8_STAGE(PG8_SA(0, 0), cA, voffA); PG8_STAGE(PG8_SB(0, 1), cB + hstep, voffB); PG8_STAGE(PG8_SA(0, 1), cA + hstep, voffA);
        if (wr == 1) PG8_BAR;
        PG8_WAIT_V(4); PG8_BAR;
        PG8_STAGE(PG8_SB(1, 0), cB + kstep, voffB); PG8_STAGE(PG8_SA(1, 0), cA + kstep, voffA); PG8_STAGE(PG8_SB(1, 1), cB + hstep + kstep, voffB);
        PG8_WAIT_V(6); PG8_BAR;
    }
    for (;;) {
        const bool has_next = S.next(ui + 1, nxt);
        const char* nA = has_next ? (const char*)g.A + (size_t)nxt.pm * tstep : cA; const char* nB = has_next ? (const char*)g.Bt + (size_t)nxt.pn * tstep : cB;
        for (int t = 0; t < nt; t += 2) {
            const bool last = (t == nt - 2);
            const char* a1 = cA + (size_t)(t + 1) * kstep;
            const char* a2 = last ? nA : cA + (size_t)(t + 2) * kstep; const char* b2 = last ? nB : cB + (size_t)(t + 2) * kstep;
            const char* a3 = a2 + kstep; const char* b3 = b2 + kstep;
            if (last && has_next) S.a_ready(nxt);
            if constexpr (SP2) {
            PG8_LDB(B0, 0, 0); PG8_LDB(B1, 0, 1); PG8_SCHED; PG8_LDA(At, 0, 0); PG8_STAGE(PG8_SA(1, 1), a1 + hstep, voffA);
            PG8_WAIT_V(8); PG8_WAIT_L(0); PG8_BAR; PG8_MMA(0, 0, At, B0); PG8_MMA(0, 1, At, B1); PG8_BAR; PG8_SCHED;
            PG8_LDA(At, 0, 1); PG8_STAGE(PG8_SB(0, 0), b2, voffB); PG8_STAGE(PG8_SB(0, 1), b2 + hstep, voffB); PG8_STAGE(PG8_SA(0, 0), a2, voffA);
            PG8_WAIT_V(8); PG8_WAIT_L(0); PG8_BAR; PG8_MMA(1, 0, At, B0); PG8_MMA(1, 1, At, B1); PG8_BAR; PG8_SCHED;
            PG8_LDB(B0, 1, 0); PG8_LDB(B1, 1, 1); PG8_SCHED; PG8_LDA(At, 1, 0); PG8_STAGE(PG8_SA(0, 1), a2 + hstep, voffA);
            PG8_WAIT_V(8); PG8_WAIT_L(0); PG8_BAR; PG8_MMA(0, 0, At, B0); PG8_MMA(0, 1, At, B1); PG8_BAR; PG8_SCHED;
            PG8_LDA(At, 1, 1); PG8_STAGE(PG8_SB(1, 0), b3, voffB); PG8_STAGE(PG8_SB(1, 1), b3 + hstep, voffB); PG8_STAGE(PG8_SA(1, 0), a3, voffA);
            PG8_WAIT_V(8); PG8_WAIT_L(0); PG8_BAR; PG8_MMA(1, 0, At, B0); PG8_MMA(1, 1, At, B1); PG8_BAR; PG8_SCHED;
            } else {
            PG8_LDB(B0, 0, 0); PG8_SCHED; PG8_LDA(At, 0, 0); PG8_STAGE(PG8_SA(1, 1), a1 + hstep, voffA);
            PG8_WAIT_L(8); PG8_BAR; PG8_WAIT_L(0); PG8_MMA(0, 0, At, B0); PG8_BAR; PG8_SCHED;
            PG8_LDB(B1, 0, 1); PG8_STAGE(PG8_SB(0, 0), b2, voffB);
            PG8_BAR; PG8_WAIT_L(0); PG8_MMA(0, 1, At, B1); PG8_BAR;
            PG8_LDA(At, 0, 1); PG8_STAGE(PG8_SA(0, 0), a2, voffA);
            PG8_BAR; PG8_WAIT_L(0); PG8_MMA(1, 0, At, B0); PG8_BAR; PG8_SCHED;
            PG8_STAGE(PG8_SB(0, 1), b2 + hstep, voffB);
            PG8_WAIT_V(6); PG8_BAR; PG8_MMA(1, 1, At, B1); PG8_BAR;
            PG8_LDB(B0, 1, 0); PG8_SCHED; PG8_LDA(At, 1, 0); PG8_STAGE(PG8_SA(0, 1), a2 + hstep, voffA);
            PG8_WAIT_L(8); PG8_BAR; PG8_WAIT_L(0); PG8_MMA(0, 0, At, B0); PG8_BAR; PG8_SCHED;
            PG8_LDB(B1, 1, 1); PG8_STAGE(PG8_SB(1, 0), b3, voffB);
            PG8_BAR; PG8_WAIT_L(0); PG8_MMA(0, 1, At, B1); PG8_BAR;
            PG8_LDA(At, 1, 1); PG8_STAGE(PG8_SA(1, 0), a3, voffA);
            PG8_BAR; PG8_WAIT_L(0); PG8_MMA(1, 0, At, B0); PG8_BAR; PG8_SCHED;
            PG8_STAGE(PG8_SB(1, 1), b3 + hstep, voffB);
            PG8_WAIT_V(6); PG8_BAR; PG8_MMA(1, 1, At, B1); PG8_BAR;
            }
        }
        if constexpr (ALIGN_EPI) { if (wr == 0) PG8_BAR; }
        if constexpr (!Epi::AFTER_DRAIN) { E(acc, cur, wr, wc, fr, fq); S.done(cur); }
        if (!has_next) break;
#pragma unroll
        for (int a = 0; a < 2; ++a)
#pragma unroll
            for (int b = 0; b < 2; ++b)
#pragma unroll
                for (int m = 0; m < 4; ++m)
#pragma unroll
                    for (int n = 0; n < 2; ++n) acc[a][b][m][n] = (f32x4){0.f, 0.f, 0.f, 0.f};
        cur = nxt; cA = nA; cB = nB; ++ui;
        if constexpr (ALIGN_EPI) { if (wr == 1) PG8_BAR; }
    }
    PG8_WAIT_V(0);
    if constexpr (!ALIGN_EPI) { if (wr == 0) PG8_BAR; }
    PG8_BAR;
    if constexpr (Epi::AFTER_DRAIN) { E.fused(acc, cur, wr, wc, fr, fq, lds, wid, lane); S.done(cur); }
#undef PG8_SA
#undef PG8_SB
#undef PG8_STAGE
#undef PG8_LDA
#undef PG8_LDB
#undef PG8_MMA
#undef PG8_WAIT_V
#undef PG8_WAIT_L
#undef PG8_BAR
#undef PG8_SCHED
}

struct UnitG { const char* A; const char* B; unsigned ao[2][2]; int pn, e, rt, cnt, row0; };
template <class Epi, class Sched>
__device__ __forceinline__ void gemm_phase_g(PG8_LAS unsigned char* lds, const int K, const Sched& S, const Epi& E) {
    const int tid = opaque_tid(), wid = __builtin_amdgcn_readfirstlane(tid >> 6), lane = tid & 63, wr = wid >> 2, wc = wid & 3, fr = lane & 15, fq = lane >> 4;
    const int nt = K / BK;
    unsigned voffB[2];
#pragma unroll
    for (int i = 0; i < 2; ++i) { int R, C; stage_rc(tid * 16 + i * 8192, R, C); const int Rb = Epi::PERM ? ((R & ~31) + perm32(R & 31)) : R; voffB[i] = (unsigned)(Rb * K + C) * 2u; }
    const size_t kstep = (size_t)(BK * 2);
    const size_t hstepB = (size_t)HALF * K * 2;
    const unsigned ldsw = (unsigned)wid * 1024u;
    const int aoff = lds_byte(wr * 64 + fr, fq * 8), boff = lds_byte(wc * 32 + fr, fq * 8);
#define PG8_SA(b, h) (((b) * 2 + (h)) * HTB)
#define PG8_SB(b, h) ((4 + (b) * 2 + (h)) * HTB)
#define PG8_STAGE(bufoff, gbase, voff) do { _Pragma("unroll") for (int _i = 0; _i < 2; ++_i) \
        __builtin_amdgcn_global_load_lds((const unsigned*)((const char*)(gbase) + (voff)[_i]), (PG8_LAS unsigned*)(lds + (bufoff) + ldsw + _i * 8192), 16, 0, 0); } while (0)
#define PG8_LDA(dst, b, h) do { _Pragma("unroll") for (int m = 0; m < 4; ++m) _Pragma("unroll") for (int k = 0; k < 2; ++k) dst[m][k] = *(const PG8_LAS bf16x8*)(lds + PG8_SA(b, h) + aoff + m * 2048 + k * 1024); } while (0)
#define PG8_LDB(dst, b, h) do { _Pragma("unroll") for (int n = 0; n < 2; ++n) _Pragma("unroll") for (int k = 0; k < 2; ++k) dst[n][k] = *(const PG8_LAS bf16x8*)(lds + PG8_SB(b, h) + boff + n * 2048 + k * 1024); } while (0)
#define PG8_MMA(ai, bj, At, Bt) do { __builtin_amdgcn_s_setprio(1); _Pragma("unroll") for (int m = 0; m < 4; ++m) _Pragma("unroll") for (int n = 0; n < 2; ++n) _Pragma("unroll") for (int k = 0; k < 2; ++k) \
        acc[ai][bj][m][n] = __builtin_amdgcn_mfma_f32_16x16x32_bf16(Bt[n][k], At[m][k], acc[ai][bj][m][n], 0, 0, 0); __builtin_amdgcn_s_setprio(0); } while (0)
#define PG8_WAIT_V(n) asm volatile("s_waitcnt vmcnt(" #n ")" ::: "memory")
#define PG8_WAIT_L(n) asm volatile("s_waitcnt lgkmcnt(" #n ")" ::: "memory")
#define PG8_BAR __builtin_amdgcn_s_barrier()
#define PG8_SCHED __builtin_amdgcn_sched_barrier(0)
    UnitG cur, nxt; int ui = 0;
    if (!S.next(0, cur)) return;
    f32x4 acc[2][2][4][2];
#pragma unroll
    for (int a = 0; a < 2; ++a)
#pragma unroll
        for (int b = 0; b < 2; ++b)
#pragma unroll
            for (int m = 0; m < 4; ++m)
#pragma unroll
                for (int n = 0; n < 2; ++n) acc[a][b][m][n] = (f32x4){0.f, 0.f, 0.f, 0.f};
    bf16x8 At[4][2], B0[2][2], B1[2][2];
    const char* cA = cur.A; const char* cB = cur.B;
    PG8_STAGE(PG8_SB(0, 0), cB, voffB); PG8_STAGE(PG8_SB(0, 1), cB + hstepB, voffB); PG8_STAGE(PG8_SA(0, 0), cA, cur.ao[0]); PG8_STAGE(PG8_SA(0, 1), cA, cur.ao[1]);
    if (wr == 1) PG8_BAR;
    PG8_WAIT_V(2); PG8_BAR;
    PG8_STAGE(PG8_SB(1, 0), cB + kstep, voffB); PG8_STAGE(PG8_SA(1, 0), cA + kstep, cur.ao[0]); PG8_STAGE(PG8_SB(1, 1), cB + hstepB + kstep, voffB);
    PG8_WAIT_V(6); PG8_BAR;
    for (;;) {
        const bool has_next = S.next(ui + 1, nxt);
        if (!has_next) nxt = cur;
        const char* nA = nxt.A; const char* nB = nxt.B;
        for (int t = 0; t < nt; t += 2) {
            const bool last = (t == nt - 2);
            const char* a1 = cA + (size_t)(t + 1) * kstep;
            const char* a2 = last ? nA : cA + (size_t)(t + 2) * kstep; const char* b2 = last ? nB : cB + (size_t)(t + 2) * kstep;
            const char* a3 = a2 + kstep; const char* b3 = b2 + kstep;
            unsigned x0[2], x1[2];
#pragma unroll
            for (int i = 0; i < 2; ++i) { x0[i] = last ? nxt.ao[0][i] : cur.ao[0][i]; x1[i] = last ? nxt.ao[1][i] : cur.ao[1][i]; }
            PG8_LDB(B0, 0, 0); PG8_LDB(B1, 0, 1); PG8_SCHED; PG8_LDA(At, 0, 0); PG8_STAGE(PG8_SA(1, 1), a1, cur.ao[1]);
            PG8_WAIT_V(8); PG8_WAIT_L(0); PG8_BAR; PG8_MMA(0, 0, At, B0); PG8_MMA(0, 1, At, B1); PG8_BAR; PG8_SCHED;
            PG8_LDA(At, 0, 1); PG8_STAGE(PG8_SB(0, 0), b2, voffB); PG8_STAGE(PG8_SB(0, 1), b2 + hstepB, voffB); PG8_STAGE(PG8_SA(0, 0), a2, x0);
            PG8_WAIT_V(8); PG8_WAIT_L(0); PG8_BAR; PG8_MMA(1, 0, At, B0); PG8_MMA(1, 1, At, B1); PG8_BAR; PG8_SCHED;
            PG8_LDB(B0, 1, 0); PG8_LDB(B1, 1, 1); PG8_SCHED; PG8_LDA(At, 1, 0); PG8_STAGE(PG8_SA(0, 1), a2, x1);
            PG8_WAIT_V(8); PG8_WAIT_L(0); PG8_BAR; PG8_MMA(0, 0, At, B0); PG8_MMA(0, 1, At, B1); PG8_BAR; PG8_SCHED;
            PG8_LDA(At, 1, 1); PG8_STAGE(PG8_SB(1, 0), b3, voffB); PG8_STAGE(PG8_SB(1, 1), b3 + hstepB, voffB); PG8_STAGE(PG8_SA(1, 0), a3, x0);
            PG8_WAIT_V(8); PG8_WAIT_L(0); PG8_BAR; PG8_MMA(1, 0, At, B0); PG8_MMA(1, 1, At, B1); PG8_BAR; PG8_SCHED;
        }
        if (wr == 0) PG8_BAR;
        E(acc, cur, wr, wc, fr, fq);
        if (!has_next) break;
#pragma unroll
        for (int a = 0; a < 2; ++a)
#pragma unroll
            for (int b = 0; b < 2; ++b)
#pragma unroll
                for (int m = 0; m < 4; ++m)
#pragma unroll
                    for (int n = 0; n < 2; ++n) acc[a][b][m][n] = (f32x4){0.f, 0.f, 0.f, 0.f};
        cur = nxt; cA = nA; cB = nB; ++ui;
        if (wr == 1) PG8_BAR;
    }
    PG8_WAIT_V(0);
    PG8_BAR;
#undef PG8_SA
#undef PG8_SB
#undef PG8_STAGE
#undef PG8_LDA
#undef PG8_LDB
#undef PG8_MMA
#undef PG8_WAIT_V
#undef PG8_WAIT_L
#undef PG8_BAR
#undef PG8_SCHED
}
}


struct Args {
    const float* in[32];
    float* out;
    unsigned char* ws;
};
struct Ctx { const LAS unsigned long long* tab; float* out; unsigned char* ws; };
DI const float* inptr(const LAS unsigned long long* tab, int i) {
    const unsigned long long v = tab[i];
    const unsigned lo = __builtin_amdgcn_readfirstlane((unsigned)v), hi = __builtin_amdgcn_readfirstlane((unsigned)(v >> 32));
    return (const float*)(((unsigned long long)hi << 32) | lo);
}
#define AIN(i) inptr(a.tab, (i))
enum {
    I_X = 0, I_MEM, I_MIXN, I_WIN, I_QN, I_KCN, I_KSN, I_KWN, I_POSK, I_POSV, I_CKW1, I_CKW2, I_CVW1, I_CVW2,
    I_NSAON, I_RETON, I_WOUT, I_MXN, I_MKVN, I_MWQ, I_MWKV, I_MQN, I_MKN, I_MWO, I_FFN, I_RGW, I_RGB, I_REW, I_REB,
    I_EWG, I_EWU, I_EWD
};

#ifndef OPT_PROJ
#define OPT_PROJ 1
#endif
#ifndef OPT_MEMATTN
#define OPT_MEMATTN 1
#endif
#ifndef OPT_TAIL
#define OPT_TAIL 1
#endif
constexpr int LDS_BYTES = 147456;
constexpr int LDS_MISC = 147456 - 256;
constexpr int LDS_PTAB = 147456 - 1024;


typedef unsigned v4u __attribute__((ext_vector_type(4)));
typedef float f32x4v __attribute__((ext_vector_type(4)));
DI unsigned pk2(float lo, float hi) { return (unsigned)f2bf(lo) | ((unsigned)f2bf(hi) << 16); }
constexpr int NPROJ = 3584;
DI void transpose_item(const float* W, int ldw, int k0, int srcc0, int nvalid, bf16_t* WT, int K, int row0, LAS float* scr, int lane, const float* ksc = nullptr) {
    const int n = lane & 31;
#pragma unroll 8
    for (int i = 0; i < 32; ++i) { const int kk = 2 * i + (lane >> 5); float v = (n < nvalid) ? W[(size_t)(k0 + kk) * ldw + srcc0 + n] : 0.f; if (ksc) v *= ksc[k0 + kk]; scr[kk * 33 + n] = v; }
    asm volatile("s_waitcnt lgkmcnt(0)" ::: "memory");
    const int c = lane & 7;
#pragma unroll
    for (int j = 0; j < 4; ++j) { const int nn = (lane >> 3) + 8 * j; const LAS float* sp = scr + (8 * c) * 33 + nn;
        v4u o; o.x = pk2(sp[0 * 33], sp[1 * 33]); o.y = pk2(sp[2 * 33], sp[3 * 33]); o.z = pk2(sp[4 * 33], sp[5 * 33]); o.w = pk2(sp[6 * 33], sp[7 * 33]);
        *(v4u*)(WT + (size_t)(row0 + nn) * K + k0 + 8 * c) = o; }
    asm volatile("s_waitcnt lgkmcnt(0)" ::: "memory");
}
DI int proj_src(int vh, int d0, int& srcc0) {
    if (vh < 8) { srcc0 = vh * 64 + d0; return 32; }
    if (vh < 20) { srcc0 = 512 + (vh - 8) * 64 + d0; return 32; }
    if (vh < 52) { srcc0 = 1304 + (vh - 20) * 64 + d0; return 32; }
    if (vh == 52 && d0 == 0) { srcc0 = 1280; return 24; }
    srcc0 = 0; return 0;
}
DI void phase_prologue(const Ctx& a, unsigned char* lds_raw) {
    const int tid = opaque_tid(), lane = tid & 63, wv = __builtin_amdgcn_readfirstlane(tid >> 6);
    LAS float* scr = (LAS float*)((LAS unsigned char*)lds_raw + wv * 16384);
    const int gw = blockIdx.x * NWAVE + wv, NGW = gridDim.x * NWAVE;
    bf16_t* WinT = (bf16_t*)(a.ws + WS_WIN_T);
    for (int it = gw; it < 16 * (NPROJ / 32); it += NGW) {
        const int kb = it / (NPROJ / 32), rg = it % (NPROJ / 32);
        const int pn = rg >> 3, r8 = rg & 7, bj = r8 >> 2, wc = r8 & 3; int srcc0; const int nv = proj_src(pn * 4 + wc, 32 * bj, srcc0);
        transpose_item(AIN(I_WIN), PROJ, kb * 64, srcc0, nv, WinT, 1024, rg * 32, scr, lane);
    }
    { bf16_t* WT = (bf16_t*)(a.ws + WS_WOUT_T);
      for (int it = gw; it < 16 * 32; it += NGW) { const int kb = it >> 5, rg = it & 31; transpose_item(AIN(I_WOUT), 1024, kb * 64, rg * 32, 32, WT, 1024, rg * 32, scr, lane); } }
    const float* ffn = AIN(I_FFN);
    { bf16_t* WT = (bf16_t*)(a.ws + WS_WGU_T);
      for (int it = gw; it < NEXP * 16 * 16; it += NGW) { const int e = it >> 8, kb = (it >> 4) & 15, rg = it & 15; const int pn = rg >> 3, bj = (rg >> 2) & 1, q = rg & 3;
          transpose_item(AIN(bj ? I_EWU : I_EWG) + (size_t)e * 1024 * 256, 256, kb * 64, 128 * pn + 32 * q, 32, WT + (size_t)e * 512 * 1024, 1024, rg * 32, scr, lane, ffn); } }
    { bf16_t* WT = (bf16_t*)(a.ws + WS_WD_T);
      for (int it = gw; it < NEXP * 4 * 32; it += NGW) { const int e = it >> 7, kb = (it >> 5) & 3, rg = it & 31;
          transpose_item(AIN(I_EWD) + (size_t)e * 256 * 1024, 1024, kb * 64, rg * 32, 32, WT + (size_t)e * 1024 * 256, 256, rg * 32, scr, lane); } }
    { bf16_t* WT = (bf16_t*)(a.ws + WS_WQ_T); const float* mxn = AIN(I_MXN);
      for (int it = gw; it < 16 * 8; it += NGW) { const int kb = it >> 3, rg = it & 7; transpose_item(AIN(I_MWQ), 256, kb * 64, rg * 32, 32, WT, 1024, rg * 32, scr, lane, mxn); } }
    { bf16_t* WT = (bf16_t*)(a.ws + WS_WO_T);
      for (int it = gw; it < 4 * 32; it += NGW) { const int kb = it >> 5, rg = it & 31; transpose_item(AIN(I_MWO), 1024, kb * 64, rg * 32, 32, WT, 256, rg * 32, scr, lane); } }
    { bf16_t* WH = (bf16_t*)(a.ws + WS_WR_HI); bf16_t* WL = (bf16_t*)(a.ws + WS_WR_LO); const float* rgw = AIN(I_RGW); const float* rew = AIN(I_REW);
      for (int i = blockIdx.x * NTHR + tid; i < 48 * 1024; i += gridDim.x * NTHR) { const int n = i >> 10, d = i & 1023; float v = 0.f;
          if (n < 4) v = rgw[d * 4 + n]; else if (n < 36) v = rew[((size_t)((n - 4) >> 3) * 1024 + d) * 8 + ((n - 4) & 7)];
          v *= ffn[d]; const unsigned short hi = f2bf(v); WH[i] = hi; WL[i] = f2bf(v - bf2f(hi)); } }
    { float* rss = (float*)(a.ws + WS_RSS1); for (int i = blockIdx.x * NTHR + tid; i < NT; i += gridDim.x * NTHR) rss[i] = 0.f; }
    { bf16_t* WT = (bf16_t*)(a.ws + WS_WKV_T);
      for (int it = gw; it < 16 * 16; it += NGW) { const int kb = it >> 4, rg = it & 15; const int pn = rg >> 3, bj = (rg >> 2) & 1, wc = rg & 3;
          transpose_item(AIN(I_MWKV), 512, kb * 64, 256 * pn + 64 * wc + 32 * bj, 32, WT, 1024, rg * 32, scr, lane); } }
    for (int kv = 0; kv < 2; ++kv) {
        bf16_t* W1T = (bf16_t*)(a.ws + WS_W1K_T) + (size_t)kv * 128 * 2048; bf16_t* W2T = (bf16_t*)(a.ws + WS_W2K_T) + (size_t)kv * 64 * 128;
        const float* w1 = AIN(kv ? I_CVW1 : I_CKW1); const float* w2 = AIN(kv ? I_CVW2 : I_CKW2); const float* pos = AIN(kv ? I_POSV : I_POSK);
        for (int it = gw; it < 32 * 4; it += NGW) { const int kb = it >> 2, rg = it & 3; transpose_item(w1, 128, kb * 64, rg * 32, 32, W1T, 2048, rg * 32, scr, lane); }
        for (int it = gw; it < 2 * 2; it += NGW) { const int kb = it >> 1, rg = it & 1; transpose_item(w2, 64, kb * 64, rg * 32, 32, W2T, 128, rg * 32, scr, lane); }
        float* PB = (float*)(a.ws + WS_PB) + kv * 128;
        for (int j = gw; j < 128; j += NGW) { float acc = 0.f; for (int f = lane; f < 2048; f += 64) acc += pos[f] * w1[(size_t)f * 128 + j]; acc = wave_sum(acc); if (lane == 0) PB[j] = acc; }
    }
    { bf16_t* HM = (bf16_t*)(a.ws + WS_HM);
      for (int m = gw; m < NB * NMEM; m += NGW) {
        const f32x4v* xr = (const f32x4v*)(AIN(I_MEM) + (size_t)m * DM) + lane; const f32x4v* gr = (const f32x4v*)AIN(I_MKVN) + lane;
        f32x4v v[4]; float ss = 0.f;
#pragma unroll
        for (int j = 0; j < 4; ++j) { v[j] = xr[64 * j]; ss += (v[j].x * v[j].x + v[j].y * v[j].y) + (v[j].z * v[j].z + v[j].w * v[j].w); }
        const float rstd = rsqrtf(wave_sum(ss) * (1.f / DM) + EPS);
        unsigned long long* o8 = (unsigned long long*)(HM + (size_t)m * DM) + lane;
#pragma unroll
        for (int j = 0; j < 4; ++j) { const f32x4v g = gr[64 * j]; o8[64 * j] = (unsigned long long)pk2(v[j].x * rstd * g.x, v[j].y * rstd * g.y) | ((unsigned long long)pk2(v[j].z * rstd * g.z, v[j].w * rstd * g.w) << 32); }
      } }
    bf16_t* XN = (bf16_t*)(a.ws + WS_XN);
    for (int m = gw; m < NT; m += NGW) {
        const f32x4v* xr = (const f32x4v*)(AIN(I_X) + (size_t)m * DM) + lane; const f32x4v* gr = (const f32x4v*)AIN(I_MIXN) + lane;
        f32x4v v[4]; float ss = 0.f;
#pragma unroll
        for (int j = 0; j < 4; ++j) { v[j] = xr[64 * j]; ss += (v[j].x * v[j].x + v[j].y * v[j].y) + (v[j].z * v[j].z + v[j].w * v[j].w); }
        const float rstd = rsqrtf(wave_sum(ss) * (1.f / DM) + EPS);
        unsigned long long* o8 = (unsigned long long*)(XN + (size_t)m * DM) + lane;
#pragma unroll
        for (int j = 0; j < 4; ++j) { const f32x4v g = gr[64 * j]; o8[64 * j] = (unsigned long long)pk2(v[j].x * rstd * g.x, v[j].y * rstd * g.y) | ((unsigned long long)pk2(v[j].z * rstd * g.z, v[j].w * rstd * g.w) << 32); }
    }
    float* rope = (float*)(a.ws + WS_ROPE);
    for (int i = blockIdx.x * NTHR + tid; i < NS * 32; i += gridDim.x * NTHR) {
        const int s = i >> 5, k = i & 31; const float inv = exp2f(-(float)k * (13.287712379549449f / 32.f));
        float sn, cs; sincosf((float)s * inv, &sn, &cs); rope[i] = cs; rope[NS * 32 + i] = sn;
    }
}

typedef float f32x2t __attribute__((ext_vector_type(2))); typedef __bf16 bf16x2t __attribute__((ext_vector_type(2)));
DI unsigned cvtpk(float lo, float hi) { f32x2t v = {lo, hi}; bf16x2t b = __builtin_convertvector(v, bf16x2t); return __builtin_bit_cast(unsigned, b); }
struct EpiProj {
    static constexpr bool PERM = true, AFTER_DRAIN = false;
    bf16_t* Q; bf16_t* KV; bf16_t* RET; float* GATES; const float* qn; const float* ksn; const float* kwn; const float* rope;
    DI void operator()(const pg8::f32x4 (&acc)[2][2][4][2], const pg8::Unit& u, int wr, int wc, int fr, int fq) const {
        const int vh = u.pn * 4 + wc;
        if (vh > 52) return;
        const int b = u.pm >> 3, s0 = (u.pm & 7) * 256;
        int kind = 0; const float* gain = nullptr; float scale = 1.f; bf16_t* hb = nullptr; int rstride = 64;
        if (vh < 8) { kind = 1; gain = qn; scale = 0.125f; hb = Q + (size_t)(u.pm * 256) * 512 + vh * 64; rstride = 512; }
        else if (vh < 20) { const int i = (vh - 8) >> 1, g = (vh - 8) & 1; hb = KV + (size_t)i * KV_STRIDE + ((size_t)(b * NG + g) * NS + s0) * DH;
            if (i == 2) { kind = 1; gain = ksn; } else if (i == 4) { kind = 1; gain = kwn; } }
        else if (vh < 52) { const int rr = (vh - 20) >> 3, h = (vh - 20) & 7; hb = RET + (size_t)rr * RET_STRIDE + ((size_t)(b * NHR + h) * NS + s0) * DH;
            if (rr < 2) { kind = 2; scale = (rr == 1) ? 0.125f : 1.f; } }
        else kind = 3;
        float g[2][8];
#pragma unroll
        for (int bj = 0; bj < 2; ++bj)
#pragma unroll
            for (int j = 0; j < 8; ++j) g[bj][j] = (kind == 1) ? gain[32 * bj + 8 * fq + j] : 1.f;
#pragma unroll
        for (int ai = 0; ai < 2; ++ai)
#pragma unroll
            for (int m = 0; m < 4; ++m) {
                const int rl = ai * 128 + wr * 64 + m * 16 + fr;
                float v[2][8];
#pragma unroll
                for (int bj = 0; bj < 2; ++bj)
#pragma unroll
                    for (int n = 0; n < 2; ++n)
#pragma unroll
                        for (int i = 0; i < 4; ++i) v[bj][4 * n + i] = acc[ai][bj][m][n][i];
                if (kind == 1) {
                    float ss = 0.f;
#pragma unroll
                    for (int bj = 0; bj < 2; ++bj)
#pragma unroll
                        for (int j = 0; j < 8; ++j) ss += v[bj][j] * v[bj][j];
                    ss += __shfl_xor(ss, 16); ss += __shfl_xor(ss, 32);
                    const float r = rsqrtf(ss * (1.f / 64.f) + EPS) * scale;
#pragma unroll
                    for (int bj = 0; bj < 2; ++bj)
#pragma unroll
                        for (int j = 0; j < 8; ++j) v[bj][j] = v[bj][j] * r * g[bj][j];
                } else if (kind == 2) {
                    const f32x4v* cp = (const f32x4v*)(rope + (size_t)(s0 + rl) * 32 + 8 * fq); const f32x4v* sp = (const f32x4v*)(rope + NS * 32 + (size_t)(s0 + rl) * 32 + 8 * fq);
                    const f32x4v c0 = cp[0], c1 = cp[1], n0 = sp[0], n1 = sp[1];
                    const float cs[8] = {c0.x, c0.y, c0.z, c0.w, c1.x, c1.y, c1.z, c1.w}; const float sn[8] = {n0.x, n0.y, n0.z, n0.w, n1.x, n1.y, n1.z, n1.w};
#pragma unroll
                    for (int j = 0; j < 8; ++j) { const float x1 = v[0][j], x2 = v[1][j]; v[0][j] = (x1 * cs[j] - x2 * sn[j]) * scale; v[1][j] = (x1 * sn[j] + x2 * cs[j]) * scale; }
                }
                if (kind == 3) {
                    if (fq < 3) { float* gp = GATES + (size_t)(u.pm * 256 + rl) * 24 + 8 * fq;
                        *(f32x4v*)gp = (f32x4v){v[0][0], v[0][1], v[0][2], v[0][3]}; *(f32x4v*)(gp + 4) = (f32x4v){v[0][4], v[0][5], v[0][6], v[0][7]}; }
                } else {
                    bf16_t* rp = hb + (size_t)rl * rstride + 8 * fq;
#pragma unroll
                    for (int bj = 0; bj < 2; ++bj) { v4u w; w.x = cvtpk(v[bj][0], v[bj][1]); w.y = cvtpk(v[bj][2], v[bj][3]); w.z = cvtpk(v[bj][4], v[bj][5]); w.w = cvtpk(v[bj][6], v[bj][7]);
                        *(v4u*)(rp + 32 * bj) = w; }
                }
            }
    }
};
DI void phase_proj_mfma(const Ctx& a, unsigned char* lds_raw) {
    pg8::Gemm g{(const bf16_t*)(a.ws + WS_XN), (const bf16_t*)(a.ws + WS_WIN_T), NT, NPROJ, DM};
    pg8::StaticOrder S; S.init(NT, NPROJ, (int)gridDim.x, (int)blockIdx.x);
    EpiProj E{(bf16_t*)(a.ws + WS_Q), (bf16_t*)(a.ws + WS_KV), (bf16_t*)(a.ws + WS_RET), (float*)(a.ws + WS_GATES), AIN(I_QN), AIN(I_KSN), AIN(I_KWN), (const float*)(a.ws + WS_ROPE)};
    pg8::gemm_phase<EpiProj, pg8::StaticOrder, true, true>((PG8_LAS unsigned char*)lds_raw, g, S, E);
}

DI void phase_proj(const Ctx& a, float* lds) {
    const int tid = opaque_tid(), lane = tid & 63, wv = tid >> 6;
    float* xs = lds;
    float* pr = lds + 4 * 1024;
    const float* x = AIN(I_X); const float* w_in = AIN(I_WIN); const float* mixn = AIN(I_MIXN);
    bf16_t* Q = (bf16_t*)(a.ws + WS_Q); bf16_t* KV = (bf16_t*)(a.ws + WS_KV); bf16_t* RET = (bf16_t*)(a.ws + WS_RET);
    float* GATES = (float*)(a.ws + WS_GATES);
    for (int tg = blockIdx.x; tg < NT / 4; tg += gridDim.x) {
        __syncthreads();
        if (wv < 4) {
            const float* xr = x + (size_t)(tg * 4 + wv) * DM;
            float v[16]; float ss = 0.f;
#pragma unroll
            for (int i = 0; i < 16; ++i) { v[i] = xr[lane + 64 * i]; ss += v[i] * v[i]; }
            ss = wave_sum(ss);
            const float rstd = rsqrtf(ss * (1.f / DM) + EPS);
#pragma unroll
            for (int i = 0; i < 16; ++i) xs[wv * 1024 + lane + 64 * i] = v[i] * rstd * mixn[lane + 64 * i];
        }
        __syncthreads();
        float acc[7][4];
#pragma unroll
        for (int i = 0; i < 7; ++i)
#pragma unroll
            for (int k = 0; k < 4; ++k) acc[i][k] = 0.f;
        for (int d = 0; d < DM; d += 2) {
            float w0[7], w1[7];
#pragma unroll
            for (int i = 0; i < 7; ++i) { const int c = tid + 512 * i; w0[i] = (c < PROJ) ? w_in[(size_t)d * PROJ + c] : 0.f; w1[i] = (c < PROJ) ? w_in[(size_t)(d + 1) * PROJ + c] : 0.f; }
            float xa[4], xb[4];
#pragma unroll
            for (int k = 0; k < 4; ++k) { xa[k] = xs[k * 1024 + d]; xb[k] = xs[k * 1024 + d + 1]; }
#pragma unroll
            for (int i = 0; i < 7; ++i)
#pragma unroll
                for (int k = 0; k < 4; ++k) { acc[i][k] += xa[k] * w0[i]; acc[i][k] += xb[k] * w1[i]; }
        }
#pragma unroll
        for (int i = 0; i < 7; ++i) { const int c = tid + 512 * i; if (c < PROJ) {
#pragma unroll
            for (int k = 0; k < 4; ++k) pr[k * PROJ + c] = acc[i][k]; } }
        __syncthreads();
        if (tid < 208) {
            const int k = tid / 52, v = tid % 52; const int t = tg * 4 + k, b = t / NS, s = t % NS;
            const float* p = pr + k * PROJ;
            if (v < 8) {
                const float* src = p + v * 64; float ss = 0.f;
                for (int d = 0; d < 64; ++d) ss += src[d] * src[d];
                const float rstd = rsqrtf(ss * (1.f / 64.f) + EPS) * 0.125f;
                bf16_t* dst = Q + (size_t)t * 512 + v * 64;
                for (int d = 0; d < 64; ++d) dst[d] = f2bf(src[d] * rstd * AIN(I_QN)[d]);
            } else if (v < 20) {
                const int i = (v - 8) >> 1, g = (v - 8) & 1;
                const float* src = p + 512 + i * 128 + g * 64;
                bf16_t* dst = KV + (size_t)i * KV_STRIDE + ((size_t)(b * NG + g) * NS + s) * DH;
                if (i == 2 || i == 4) {
                    const float* gn = (i == 2) ? AIN(I_KSN) : AIN(I_KWN); float ss = 0.f;
                    for (int d = 0; d < 64; ++d) ss += src[d] * src[d];
                    const float rstd = rsqrtf(ss * (1.f / 64.f) + EPS);
                    for (int d = 0; d < 64; ++d) dst[d] = f2bf(src[d] * rstd * gn[d]);
                } else {
                    for (int d = 0; d < 64; ++d) dst[d] = f2bf(src[d]);
                }
            } else {
                const int rr = (v - 20) >> 3, h = (v - 20) & 7;
                const float* src = p + 1304 + rr * 512 + h * 64;
                bf16_t* dst = RET + (size_t)rr * RET_STRIDE + ((size_t)(b * NHR + h) * NS + s) * DH;
                if (rr < 2) {
                    const float sc = (rr == 1) ? 0.125f : 1.f;
                    for (int i2 = 0; i2 < 32; ++i2) {
                        const float inv = exp2f(-(float)i2 * (13.287712379549449f / 32.f));
                        float sn, cs; sincosf((float)s * inv, &sn, &cs);
                        const float x1 = src[i2], x2 = src[i2 + 32];
                        dst[i2] = f2bf((x1 * cs - x2 * sn) * sc); dst[i2 + 32] = f2bf((x1 * sn + x2 * cs) * sc);
                    }
                } else {
                    for (int d = 0; d < 64; ++d) dst[d] = f2bf(src[d]);
                }
            }
        } else if (tid >= 256 && tid < 256 + 96) {
            const int k = (tid - 256) / 24, j = (tid - 256) % 24; const int t = tg * 4 + k;
            GATES[(size_t)t * 24 + j] = pr[k * PROJ + 1280 + j];
        }
    }
}

DI void phase_memkv(const Ctx& a, float* lds) {
    const int tid = opaque_tid(), lane = tid & 63, wv = tid >> 6;
    float* hm = lds; float* red = lds + 1024; float* kv = lds + 1100;
    const float* mem = AIN(I_MEM); const float* wkv = AIN(I_MWKV);
    bf16_t* MK = (bf16_t*)(a.ws + WS_MK); bf16_t* MV = (bf16_t*)(a.ws + WS_MV);
    for (int r = blockIdx.x; r < NB * NMEM; r += gridDim.x) {
        __syncthreads();
        const float* xr = mem + (size_t)r * DM;
        const float v0 = xr[tid], v1 = xr[tid + 512];
        float ss = wave_sum(v0 * v0 + v1 * v1);
        if (lane == 0) red[wv] = ss;
        __syncthreads();
        float tot = 0.f;
#pragma unroll
        for (int i = 0; i < 8; ++i) tot += red[i];
        const float rstd = rsqrtf(tot * (1.f / DM) + EPS);
        hm[tid] = v0 * rstd * AIN(I_MKVN)[tid]; hm[tid + 512] = v1 * rstd * AIN(I_MKVN)[tid + 512];
        __syncthreads();
        float acc = 0.f;
        for (int d = 0; d < DM; ++d) acc += hm[d] * wkv[(size_t)d * 512 + tid];
        kv[tid] = acc;
        __syncthreads();
        const int b = r / NMEM, m = r % NMEM;
        if (tid < 4) {
            const float* src = kv + tid * 64; float s2 = 0.f;
            for (int d = 0; d < 64; ++d) s2 += src[d] * src[d];
            const float rs = rsqrtf(s2 * (1.f / 64.f) + EPS);
            bf16_t* dst = MK + ((size_t)(b * MH + tid) * NMEM + m) * DH;
            for (int d = 0; d < 64; ++d) dst[d] = f2bf(src[d] * rs * AIN(I_MKN)[d]);
        } else if (tid >= 64 && tid < 68) {
            const int h = tid - 64; const float* src = kv + 256 + h * 64;
            bf16_t* dst = MV + ((size_t)(b * MH + h) * NMEM + m) * DH;
            for (int d = 0; d < 64; ++d) dst[d] = f2bf(src[d]);
            bf16_t* dt = (bf16_t*)(a.ws + WS_MVT) + (size_t)(b * MH + h) * DH * NMEM + m;
            for (int d = 0; d < 64; ++d) dt[(size_t)d * NMEM] = f2bf(src[d]);
        }
    }
}

DI void phase_compress(const Ctx& a, float* lds) {
    const int tid = opaque_tid();
    float* blk = lds;
    float* part = lds + 2048;
    float* hid = lds + 2048 + 512;
    float* outv = hid + 128;
    const bf16_t* KV = (const bf16_t*)(a.ws + WS_KV);
    bf16_t* KCMP = (bf16_t*)(a.ws + WS_KCMP); bf16_t* VCMP = (bf16_t*)(a.ws + WS_VCMP);
    const int nunit = 2 * NB * NG * 128;
    for (int u = blockIdx.x; u < nunit; u += gridDim.x) {
        const int kvsel = u / (NB * NG * 128), rem = u % (NB * NG * 128), bg = rem / 128, c = rem % 128;
        bf16_t* dst = (kvsel == 0 ? KCMP : VCMP) + ((size_t)bg * 128 + c) * DH;
        if (c == 127) { if (tid < 64) dst[tid] = 0; continue; }
        __syncthreads();
        const bf16_t* src = KV + (size_t)kvsel * KV_STRIDE + ((size_t)bg * NS + 16 * c) * DH;
        const float* pos = AIN(kvsel == 0 ? I_POSK : I_POSV);
        const float* w1 = AIN(kvsel == 0 ? I_CKW1 : I_CVW1);
        const float* w2 = AIN(kvsel == 0 ? I_CKW2 : I_CVW2);
#pragma unroll
        for (int i = 0; i < 4; ++i) { const int f = tid + 512 * i; blk[f] = bf2f(src[f]) + pos[f]; }
        __syncthreads();
        { const int j = tid & 127, pt = tid >> 7; float acc = 0.f;
          for (int f = pt * 512; f < pt * 512 + 512; ++f) acc += blk[f] * w1[(size_t)f * 128 + j];
          part[tid] = acc; }
        __syncthreads();
        if (tid < 128) { const float h = part[tid] + part[tid + 128] + part[tid + 256] + part[tid + 384]; hid[tid] = siluf(h); }
        __syncthreads();
        if (tid < 64) { float acc = 0.f; for (int j = 0; j < 128; ++j) acc += hid[j] * w2[j * 64 + tid]; outv[tid] = acc; }
        __syncthreads();
        if (tid < 64) {
            float v = outv[tid];
            if (kvsel == 0) { float ss = 0.f; for (int d = 0; d < 64; ++d) ss += outv[d] * outv[d]; v = v * rsqrtf(ss * (1.f / 64.f) + EPS) * AIN(I_KCN)[tid]; }
            dst[tid] = f2bf(v);
        }
    }
}

DI void softmax_rows4(float* sc, int ld, int n, int wv, int lane) {
    if (wv < 4) {
        float* row = sc + wv * ld; float m = -1e30f;
        for (int i = lane; i < n; i += 64) m = fmaxf(m, row[i]);
        m = wave_max(m);
        float s = 0.f;
        for (int i = lane; i < n; i += 64) { const float v = row[i]; const float e = (v > -1e29f) ? __expf(v - m) : 0.f; row[i] = e; s += e; }
        s = wave_sum(s);
        const float inv = 1.f / fmaxf(s, 1e-30f);
        for (int i = lane; i < n; i += 64) row[i] *= inv;
    }
}
DI void phase_nsa(const Ctx& a, float* lds) {
    const int tid = opaque_tid(), lane = tid & 63, wv = tid >> 6;
    float* q = lds;
    float* sc = lds + 256;
    float* psum = sc + 2048;
    float* imp = psum + 128;
    float* oacc = imp + 32;
    int* sel = (int*)(oacc + 768);
    float* ofin = (float*)(sel + 8);
    const bf16_t* Q = (const bf16_t*)(a.ws + WS_Q); const bf16_t* KV = (const bf16_t*)(a.ws + WS_KV);
    const bf16_t* KCMP = (const bf16_t*)(a.ws + WS_KCMP); const bf16_t* VCMP = (const bf16_t*)(a.ws + WS_VCMP);
    const float* GATES = (const float*)(a.ws + WS_GATES);
    bf16_t* OA = (bf16_t*)(a.ws + WS_OA);
    for (int u = blockIdx.x; u < NT * NG; u += gridDim.x) {
        const int t = u >> 1, g = u & 1, b = t / NS, s = t % NS, bg = b * NG + g;
        __syncthreads();
        if (tid < 256) q[tid] = bf2f(Q[(size_t)t * 512 + g * 256 + tid]);
        __syncthreads();
        const int ncv = (s >= 31) ? min(NCMP, (s - 31) / 16 + 1) : 0;
        { const int r = tid >> 7, c = tid & 127; float v = -1e30f;
          if (c < ncv) { const bf16_t* kr = KCMP + ((size_t)bg * 128 + c) * DH; float d = 0.f; for (int i = 0; i < 64; ++i) d += q[r * 64 + i] * bf2f(kr[i]); v = d; }
          sc[r * 512 + c] = v; }
        __syncthreads();
        softmax_rows4(sc, 512, 128, wv, lane);
        __syncthreads();
        if (tid < 128) psum[tid] = sc[tid] + sc[512 + tid] + sc[1024 + tid] + sc[1536 + tid];
        if (tid >= 256) { const int r = (tid - 256) >> 6, d = tid & 63; float acc = 0.f;
            for (int c = 0; c < ncv; ++c) acc += sc[r * 512 + c] * bf2f(VCMP[((size_t)bg * 128 + c) * DH + d]);
            oacc[r * 64 + d] = acc; }
        __syncthreads();
        const int cur = s / 64;
        if (tid < 32) { const int j = tid; float v = 0.f;
            if (4 * j - 1 >= 0) v += 0.5f * psum[4 * j - 1];
            v += psum[4 * j] + psum[4 * j + 1] + psum[4 * j + 2];
            if (4 * j + 3 < NCMP) v += 0.5f * psum[4 * j + 3];
            if (j == 0 || j == cur || j == cur - 1) v = 1e9f; else if (j > cur) v = -1e30f;
            imp[j] = v; }
        __syncthreads();
        if (tid == 0) {
            unsigned used = 0u;
            for (int k = 0; k < TOPK; ++k) { int best = -1; float bv = 0.f;
                for (int j = 0; j < NSEL; ++j) if (!((used >> j) & 1u)) { if (best < 0 || imp[j] > bv) { best = j; bv = imp[j]; } }
                used |= 1u << best; sel[k] = best; }
        }
        __syncthreads();
        { const int kk = tid >> 6, i = tid & 63; const int kpos = sel[kk] * 64 + i;
          const bf16_t* kr = KV + 2 * KV_STRIDE + ((size_t)bg * NS + kpos) * DH;
          float d0 = 0.f, d1 = 0.f, d2 = 0.f, d3 = 0.f;
          if (kpos <= s) { for (int e = 0; e < 64; ++e) { const float kvv = bf2f(kr[e]); d0 += q[e] * kvv; d1 += q[64 + e] * kvv; d2 += q[128 + e] * kvv; d3 += q[192 + e] * kvv; } }
          else { d0 = d1 = d2 = d3 = -1e30f; }
          sc[tid] = d0; sc[512 + tid] = d1; sc[1024 + tid] = d2; sc[1536 + tid] = d3; }
        __syncthreads();
        softmax_rows4(sc, 512, 512, wv, lane);
        __syncthreads();
        if (tid < 256) { const int r = tid >> 6, d = tid & 63; float acc = 0.f;
            for (int k = 0; k < 512; ++k) { const float p = sc[r * 512 + k]; if (p != 0.f) { const int kpos = sel[k >> 6] * 64 + (k & 63); acc += p * bf2f(KV[3 * KV_STRIDE + ((size_t)bg * NS + kpos) * DH + d]); } }
            oacc[256 + r * 64 + d] = acc; }
        __syncthreads();
        { const int kpos = s - 511 + tid;
          const bf16_t* kr = KV + 4 * KV_STRIDE + ((size_t)bg * NS + kpos) * DH;
          float d0 = 0.f, d1 = 0.f, d2 = 0.f, d3 = 0.f;
          if (kpos >= 0) { for (int e = 0; e < 64; ++e) { const float kvv = bf2f(kr[e]); d0 += q[e] * kvv; d1 += q[64 + e] * kvv; d2 += q[128 + e] * kvv; d3 += q[192 + e] * kvv; } }
          else { d0 = d1 = d2 = d3 = -1e30f; }
          sc[tid] = d0; sc[512 + tid] = d1; sc[1024 + tid] = d2; sc[1536 + tid] = d3; }
        __syncthreads();
        softmax_rows4(sc, 512, 512, wv, lane);
        __syncthreads();
        if (tid < 256) { const int r = tid >> 6, d = tid & 63; float acc = 0.f;
            for (int k = 0; k < 512; ++k) { const float p = sc[r * 512 + k]; if (p != 0.f) { const int kpos = s - 511 + k; acc += p * bf2f(KV[5 * KV_STRIDE + ((size_t)bg * NS + kpos) * DH + d]); } }
            oacc[512 + r * 64 + d] = acc; }
        __syncthreads();
        if (tid < 256) { const int r = tid >> 6, d = tid & 63;
            const float* gt = GATES + (size_t)t * 24 + g * 12 + r * 3;
            ofin[tid] = sigmf(gt[0]) * oacc[tid] + sigmf(gt[1]) * oacc[256 + tid] + sigmf(gt[2]) * oacc[512 + tid]; }
        __syncthreads();
        if (tid < 256) { const int r = tid >> 6, d = tid & 63; float ss = 0.f;
            for (int e = 0; e < 64; ++e) ss += ofin[r * 64 + e] * ofin[r * 64 + e];
            const int h = g * 4 + r;
            OA[(size_t)t * 1024 + h * 64 + d] = f2bf(ofin[tid] * rsqrtf(ss * (1.f / 64.f) + EPS) * AIN(I_NSAON)[h * 64 + d]); }
    }
}

DI void phase_ret(const Ctx& a, float* lds) {
    const int tid = opaque_tid();
    float* qv = lds;
    float* wts = lds + 64;
    float* part = wts + 2048;
    float* yv = part + 512;
    const bf16_t* RET = (const bf16_t*)(a.ws + WS_RET);
    bf16_t* OA = (bf16_t*)(a.ws + WS_OA);
    for (int u = blockIdx.x; u < NB * NHR * NS; u += gridDim.x) {
        const int s = u % NS, bh = u / NS, h = bh % NHR, b = bh / NHR;
        const float l2g = log2f(1.f - exp2f(-5.f - (float)h));
        __syncthreads();
        if (tid < 64) qv[tid] = bf2f(RET[((size_t)bh * NS + s) * DH + tid]);
        __syncthreads();
        for (int j = tid; j <= s; j += 512) {
            const bf16_t* kr = RET + RET_STRIDE + ((size_t)bh * NS + j) * DH; float d = 0.f;
            for (int e = 0; e < 64; ++e) d += qv[e] * bf2f(kr[e]);
            wts[j] = d * exp2f((float)(s - j) * l2g);
        }
        __syncthreads();
        { const int d = tid & 63, pt = tid >> 6; float acc = 0.f;
          for (int j = pt; j <= s; j += 8) acc += wts[j] * bf2f(RET[2 * RET_STRIDE + ((size_t)bh * NS + j) * DH + d]);
          part[pt * 64 + d] = acc; }
        __syncthreads();
        if (tid < 64) { float y = 0.f; for (int p = 0; p < 8; ++p) y += part[p * 64 + tid]; yv[tid] = y; }
        __syncthreads();
        if (tid < 64) {
            float mu = 0.f; for (int e = 0; e < 64; ++e) mu += yv[e]; mu *= (1.f / 64.f);
            float var = 0.f; for (int e = 0; e < 64; ++e) { const float dd = yv[e] - mu; var += dd * dd; } var *= (1.f / 64.f);
            const float gr = bf2f(RET[3 * RET_STRIDE + ((size_t)bh * NS + s) * DH + tid]);
            const float y = (yv[tid] - mu) * rsqrtf(var + EPS) * AIN(I_RETON)[h * 64 + tid] * siluf(gr);
            OA[(size_t)(b * NS + s) * 1024 + 512 + h * 64 + tid] = f2bf(y);
        }
    }
}

DI void phase_tail(const Ctx& a, float* lds) {
    const int tid = opaque_tid(), lane = tid & 63, wv = tid >> 6;
    constexpr int TK = 4;
    float* oa = lds;
    float* x1 = oa + TK * 1024;
    float* qb = x1 + TK * 1024;
    float* ob = qb + TK * 256;
    float* scm = ob + TK * 256;
    float* tmp = scm + TK * 1024;
    float* hidb = tmp + TK * 512;
    float* lg = hidb + 256;
    float* rs = lg + TK * 36;
    int* eid = (int*)(rs + TK);
    float* ew = (float*)(eid + TK * 2);
    const float* x = AIN(I_X);
    const bf16_t* OA = (const bf16_t*)(a.ws + WS_OA);
    const bf16_t* MK = (const bf16_t*)(a.ws + WS_MK); const bf16_t* MV = (const bf16_t*)(a.ws + WS_MV);
    const float* w_out = AIN(I_WOUT); const float* wq = AIN(I_MWQ); const float* wo = AIN(I_MWO);
    for (int tg = blockIdx.x; tg < NT / TK; tg += gridDim.x) {
        const int t0 = tg * TK, b = t0 / NS;
        __syncthreads();
        for (int i = tid; i < TK * 1024; i += 512) oa[i] = bf2f(OA[(size_t)t0 * 1024 + i]);
        __syncthreads();
        { float acc[2][TK];
#pragma unroll
          for (int i = 0; i < 2; ++i)
#pragma unroll
              for (int k = 0; k < TK; ++k) acc[i][k] = 0.f;
#pragma unroll 4
          for (int j = 0; j < 1024; ++j) { const float w0 = w_out[(size_t)j * 1024 + tid], w1 = w_out[(size_t)j * 1024 + tid + 512];
#pragma unroll
              for (int k = 0; k < TK; ++k) { const float o = oa[k * 1024 + j]; acc[0][k] += o * w0; acc[1][k] += o * w1; } }
#pragma unroll
          for (int k = 0; k < TK; ++k) { x1[k * 1024 + tid] = x[(size_t)(t0 + k) * 1024 + tid] + acc[0][k]; x1[k * 1024 + tid + 512] = x[(size_t)(t0 + k) * 1024 + tid + 512] + acc[1][k]; } }
        __syncthreads();
        if (wv < TK) { float ss = 0.f; for (int i = lane; i < 1024; i += 64) ss += x1[wv * 1024 + i] * x1[wv * 1024 + i]; ss = wave_sum(ss); if (lane == 0) rs[wv] = rsqrtf(ss * (1.f / DM) + EPS); }
        __syncthreads();
        for (int i = tid; i < TK * 1024; i += 512) oa[i] = x1[i] * rs[i >> 10] * AIN(I_MXN)[i & 1023];
        __syncthreads();
        { const int j = tid & 255, hf = tid >> 8; float acc[TK];
#pragma unroll
          for (int k = 0; k < TK; ++k) acc[k] = 0.f;
#pragma unroll 4
          for (int d = hf * 512; d < hf * 512 + 512; ++d) { const float w = wq[(size_t)d * 256 + j];
#pragma unroll
              for (int k = 0; k < TK; ++k) acc[k] += oa[k * 1024 + d] * w; }
#pragma unroll
          for (int k = 0; k < TK; ++k) tmp[k * 512 + tid] = acc[k]; }
        __syncthreads();
        for (int i = tid; i < TK * 256; i += 512) { const int k = i >> 8, j = i & 255; qb[i] = tmp[k * 512 + j] + tmp[k * 512 + 256 + j]; }
        __syncthreads();
        if (tid < TK * 4) { float* src = qb + tid * 64; float ss = 0.f; for (int d = 0; d < 64; ++d) ss += src[d] * src[d];
            const float r = rsqrtf(ss * (1.f / 64.f) + EPS) * 0.125f; for (int d = 0; d < 64; ++d) src[d] = src[d] * r * AIN(I_MQN)[d]; }
        __syncthreads();
        { const int h = tid >> 7, m0 = (tid & 127) * 2;
#pragma unroll
          for (int mm = 0; mm < 2; ++mm) { const int m = m0 + mm; const bf16_t* kr = MK + ((size_t)(b * MH + h) * NMEM + m) * DH; float acc[TK];
#pragma unroll
              for (int k = 0; k < TK; ++k) acc[k] = 0.f;
#pragma unroll 8
              for (int d = 0; d < 64; ++d) { const float kv = bf2f(kr[d]);
#pragma unroll
                  for (int k = 0; k < TK; ++k) acc[k] += qb[k * 256 + h * 64 + d] * kv; }
#pragma unroll
              for (int k = 0; k < TK; ++k) scm[(k * 4 + h) * 256 + m] = acc[k]; } }
        __syncthreads();
        for (int row = wv; row < TK * 4; row += 8) { float* r = scm + row * 256; float m = -1e30f;
            for (int i = lane; i < 256; i += 64) m = fmaxf(m, r[i]); m = wave_max(m);
            float s = 0.f; for (int i = lane; i < 256; i += 64) { const float e = __expf(r[i] - m); r[i] = e; s += e; } s = wave_sum(s);
            const float inv = 1.f / s; for (int i = lane; i < 256; i += 64) r[i] *= inv; }
        __syncthreads();
        { const int hd = tid & 255, h = hd >> 6, d = hd & 63, k0 = (tid >> 8) * 2; float a0 = 0.f, a1 = 0.f;
#pragma unroll 4
          for (int m = 0; m < 256; ++m) { const float v = bf2f(MV[((size_t)(b * MH + h) * NMEM + m) * DH + d]); a0 += scm[((k0) * 4 + h) * 256 + m] * v; a1 += scm[((k0 + 1) * 4 + h) * 256 + m] * v; }
          ob[k0 * 256 + hd] = a0; ob[(k0 + 1) * 256 + hd] = a1; }
        __syncthreads();
        { float acc[2][TK];
#pragma unroll
          for (int i = 0; i < 2; ++i)
#pragma unroll
              for (int k = 0; k < TK; ++k) acc[i][k] = 0.f;
#pragma unroll 4
          for (int j = 0; j < 256; ++j) { const float w0 = wo[(size_t)j * 1024 + tid], w1 = wo[(size_t)j * 1024 + tid + 512];
#pragma unroll
              for (int k = 0; k < TK; ++k) { const float o = ob[k * 256 + j]; acc[0][k] += o * w0; acc[1][k] += o * w1; } }
          __syncthreads();
#pragma unroll
          for (int k = 0; k < TK; ++k) { x1[k * 1024 + tid] += acc[0][k]; x1[k * 1024 + tid + 512] += acc[1][k]; } }
        __syncthreads();
        if (wv < TK) { float ss = 0.f; for (int i = lane; i < 1024; i += 64) ss += x1[wv * 1024 + i] * x1[wv * 1024 + i]; ss = wave_sum(ss); if (lane == 0) rs[wv] = rsqrtf(ss * (1.f / DM) + EPS); }
        __syncthreads();
        for (int i = tid; i < TK * 1024; i += 512) oa[i] = x1[i] * rs[i >> 10] * AIN(I_FFN)[i & 1023];
        __syncthreads();
        for (int dd = wv; dd < TK * 36; dd += 8) { const int k = dd / 36, j = dd % 36; float acc = 0.f;
            if (j < 4) { for (int d = lane; d < 1024; d += 64) acc += oa[k * 1024 + d] * AIN(I_RGW)[d * 4 + j]; }
            else { const int gg = (j - 4) >> 3, e = (j - 4) & 7; for (int d = lane; d < 1024; d += 64) acc += oa[k * 1024 + d] * AIN(I_REW)[((size_t)gg * 1024 + d) * 8 + e]; }
            acc = wave_sum(acc);
            if (lane == 0) lg[dd] = acc + (j < 4 ? AIN(I_RGB)[j] : AIN(I_REB)[j - 4]); }
        __syncthreads();
        if (tid < TK) { const float* l = lg + tid * 36; int grp = 0; float gm = l[0];
            for (int j = 1; j < 4; ++j) if (l[j] > gm) { gm = l[j]; grp = j; }
            float gs = 0.f; for (int j = 0; j < 4; ++j) gs += __expf(l[j] - gm);
            const float gw = 1.f / gs;
            const float* el = l + 4 + grp * 8; int e0 = 0; float v0 = el[0];
            for (int j = 1; j < 8; ++j) if (el[j] > v0) { v0 = el[j]; e0 = j; }
            int e1 = -1; float v1 = 0.f;
            for (int j = 0; j < 8; ++j) if (j != e0) { if (e1 < 0 || el[j] > v1) { v1 = el[j]; e1 = j; } }
            const float p1 = __expf(v1 - v0); const float den = 1.f + p1;
            eid[tid * 2] = grp * 8 + e0; eid[tid * 2 + 1] = grp * 8 + e1; ew[tid * 2] = gw / den; ew[tid * 2 + 1] = gw * p1 / den; }
        __syncthreads();
        float yacc[2][TK];
#pragma unroll
        for (int i = 0; i < 2; ++i)
#pragma unroll
            for (int k = 0; k < TK; ++k) yacc[i][k] = 0.f;
#pragma unroll
        for (int k = 0; k < TK; ++k) {
            for (int kk = 0; kk < 2; ++kk) {
                const int e = eid[k * 2 + kk]; const float wgt = ew[k * 2 + kk];
                { const int f = tid & 255, hf = tid >> 8; const float* W = (hf == 0 ? AIN(I_EWG) : AIN(I_EWU)) + (size_t)e * 1024 * 256; float acc = 0.f;
#pragma unroll 8
                  for (int d = 0; d < 1024; ++d) acc += oa[k * 1024 + d] * W[(size_t)d * 256 + f];
                  tmp[tid] = acc; }
                __syncthreads();
                if (tid < 256) hidb[tid] = siluf(tmp[tid]) * tmp[256 + tid];
                __syncthreads();
                { const float* W = AIN(I_EWD) + (size_t)e * 256 * 1024; float a0 = 0.f, a1 = 0.f;
#pragma unroll 4
                  for (int f = 0; f < 256; ++f) { const float hv = hidb[f]; a0 += hv * W[(size_t)f * 1024 + tid]; a1 += hv * W[(size_t)f * 1024 + tid + 512]; }
                  yacc[0][k] += wgt * a0; yacc[1][k] += wgt * a1; }
                __syncthreads();
            }
        }
#pragma unroll
        for (int k = 0; k < TK; ++k) { a.out[(size_t)(t0 + k) * 1024 + tid] = x1[k * 1024 + tid] + yacc[0][k]; a.out[(size_t)(t0 + k) * 1024 + tid + 512] = x1[k * 1024 + tid + 512] + yacc[1][k]; }
    }
}


DI void phase_tail_b(const Ctx& a, float* lds) {
    const int tid = opaque_tid(), lane = tid & 63, wv = tid >> 6;
    constexpr int TK = 4;
    float* oa = lds;
    float* x1 = oa + TK * 1024;
    float* qb = x1 + TK * 1024;
    float* ob = qb + TK * 256;
    float* scm = ob + TK * 256;
    float* tmp = scm + TK * 1024;
    float* hidb = tmp + TK * 512;
    float* lg = hidb + 256;
    float* rs = lg + TK * 36;
    int* eid = (int*)(rs + TK);
    float* ew = (float*)(eid + TK * 2);
    const float* x = AIN(I_X);
    const bf16_t* OA = (const bf16_t*)(a.ws + WS_OA);
    const bf16_t* MK = (const bf16_t*)(a.ws + WS_MK); const bf16_t* MV = (const bf16_t*)(a.ws + WS_MV);
    const float* wq = AIN(I_MWQ); const float* wo = AIN(I_MWO);
    bf16_t* H3 = (bf16_t*)(a.ws + WS_H3); int* LIST = (int*)(a.ws + WS_LIST); float* LISTW = (float*)(a.ws + WS_LISTW); float* LISTR = (float*)(a.ws + WS_LISTR); unsigned* cntp = (unsigned*)(a.ws + WS_CTL) + CW_CNT;
    for (int tg = blockIdx.x; tg < NT / TK; tg += gridDim.x) {
        const int t0 = tg * TK, b = t0 / NS;
        __syncthreads();
        for (int i = tid; i < TK * 1024; i += 512) x1[i] = a.out[(size_t)t0 * 1024 + i];
        __syncthreads();
        if (wv < TK) { float ss = 0.f; for (int i = lane; i < 1024; i += 64) ss += x1[wv * 1024 + i] * x1[wv * 1024 + i]; ss = wave_sum(ss); if (lane == 0) rs[wv] = rsqrtf(ss * (1.f / DM) + EPS); }
        __syncthreads();
        for (int i = tid; i < TK * 1024; i += 512) oa[i] = x1[i] * rs[i >> 10] * AIN(I_MXN)[i & 1023];
        __syncthreads();
        { const int j = tid & 255, hf = tid >> 8; float acc[TK];
#pragma unroll
          for (int k = 0; k < TK; ++k) acc[k] = 0.f;
#pragma unroll 4
          for (int d = hf * 512; d < hf * 512 + 512; ++d) { const float w = wq[(size_t)d * 256 + j];
#pragma unroll
              for (int k = 0; k < TK; ++k) acc[k] += oa[k * 1024 + d] * w; }
#pragma unroll
          for (int k = 0; k < TK; ++k) tmp[k * 512 + tid] = acc[k]; }
        __syncthreads();
        for (int i = tid; i < TK * 256; i += 512) { const int k = i >> 8, j = i & 255; qb[i] = tmp[k * 512 + j] + tmp[k * 512 + 256 + j]; }
        __syncthreads();
        if (tid < TK * 4) { float* src = qb + tid * 64; float ss = 0.f; for (int d = 0; d < 64; ++d) ss += src[d] * src[d];
            const float r = rsqrtf(ss * (1.f / 64.f) + EPS) * 0.125f; for (int d = 0; d < 64; ++d) src[d] = src[d] * r * AIN(I_MQN)[d]; }
        __syncthreads();
        { const int h = tid >> 7, m0 = (tid & 127) * 2;
#pragma unroll
          for (int mm = 0; mm < 2; ++mm) { const int m = m0 + mm; const bf16_t* kr = MK + ((size_t)(b * MH + h) * NMEM + m) * DH; float acc[TK];
#pragma unroll
              for (int k = 0; k < TK; ++k) acc[k] = 0.f;
#pragma unroll 8
              for (int d = 0; d < 64; ++d) { const float kv = bf2f(kr[d]);
#pragma unroll
                  for (int k = 0; k < TK; ++k) acc[k] += qb[k * 256 + h * 64 + d] * kv; }
#pragma unroll
              for (int k = 0; k < TK; ++k) scm[(k * 4 + h) * 256 + m] = acc[k]; } }
        __syncthreads();
        for (int row = wv; row < TK * 4; row += 8) { float* r = scm + row * 256; float m = -1e30f;
            for (int i = lane; i < 256; i += 64) m = fmaxf(m, r[i]); m = wave_max(m);
            float s = 0.f; for (int i = lane; i < 256; i += 64) { const float e = __expf(r[i] - m); r[i] = e; s += e; } s = wave_sum(s);
            const float inv = 1.f / s; for (int i = lane; i < 256; i += 64) r[i] *= inv; }
        __syncthreads();
        { const int hd = tid & 255, h = hd >> 6, d = hd & 63, k0 = (tid >> 8) * 2; float a0 = 0.f, a1 = 0.f;
#pragma unroll 4
          for (int m = 0; m < 256; ++m) { const float v = bf2f(MV[((size_t)(b * MH + h) * NMEM + m) * DH + d]); a0 += scm[((k0) * 4 + h) * 256 + m] * v; a1 += scm[((k0 + 1) * 4 + h) * 256 + m] * v; }
          ob[k0 * 256 + hd] = a0; ob[(k0 + 1) * 256 + hd] = a1; }
        __syncthreads();
        { float acc[2][TK];
#pragma unroll
          for (int i = 0; i < 2; ++i)
#pragma unroll
              for (int k = 0; k < TK; ++k) acc[i][k] = 0.f;
#pragma unroll 4
          for (int j = 0; j < 256; ++j) { const float w0 = wo[(size_t)j * 1024 + tid], w1 = wo[(size_t)j * 1024 + tid + 512];
#pragma unroll
              for (int k = 0; k < TK; ++k) { const float o = ob[k * 256 + j]; acc[0][k] += o * w0; acc[1][k] += o * w1; } }
          __syncthreads();
#pragma unroll
          for (int k = 0; k < TK; ++k) { x1[k * 1024 + tid] += acc[0][k]; x1[k * 1024 + tid + 512] += acc[1][k]; } }
        __syncthreads();
        if (wv < TK) { float ss = 0.f; for (int i = lane; i < 1024; i += 64) ss += x1[wv * 1024 + i] * x1[wv * 1024 + i]; ss = wave_sum(ss); if (lane == 0) rs[wv] = rsqrtf(ss * (1.f / DM) + EPS); }
        __syncthreads();
        for (int i = tid; i < TK * 1024; i += 512) oa[i] = x1[i] * rs[i >> 10] * AIN(I_FFN)[i & 1023];
        __syncthreads();
        for (int dd = wv; dd < TK * 36; dd += 8) { const int k = dd / 36, j = dd % 36; float acc = 0.f;
            if (j < 4) { for (int d = lane; d < 1024; d += 64) acc += oa[k * 1024 + d] * AIN(I_RGW)[d * 4 + j]; }
            else { const int gg = (j - 4) >> 3, e = (j - 4) & 7; for (int d = lane; d < 1024; d += 64) acc += oa[k * 1024 + d] * AIN(I_REW)[((size_t)gg * 1024 + d) * 8 + e]; }
            acc = wave_sum(acc);
            if (lane == 0) lg[dd] = acc + (j < 4 ? AIN(I_RGB)[j] : AIN(I_REB)[j - 4]); }
        __syncthreads();
        if (tid < TK) { const float* l = lg + tid * 36; int grp = 0; float gm = l[0];
            for (int j = 1; j < 4; ++j) if (l[j] > gm) { gm = l[j]; grp = j; }
            float gs = 0.f; for (int j = 0; j < 4; ++j) gs += __expf(l[j] - gm);
            const float gw = 1.f / gs;
            const float* el = l + 4 + grp * 8; int e0 = 0; float v0 = el[0];
            for (int j = 1; j < 8; ++j) if (el[j] > v0) { v0 = el[j]; e0 = j; }
            int e1 = -1; float v1 = 0.f;
            for (int j = 0; j < 8; ++j) if (j != e0) { if (e1 < 0 || el[j] > v1) { v1 = el[j]; e1 = j; } }
            const float p1 = __expf(v1 - v0); const float den = 1.f + p1;
            eid[tid * 2] = grp * 8 + e0; eid[tid * 2 + 1] = grp * 8 + e1; ew[tid * 2] = gw / den; ew[tid * 2 + 1] = gw * p1 / den; }
        __syncthreads();
        for (int i = tid; i < TK * 1024; i += 512) { a.out[(size_t)t0 * 1024 + i] = x1[i]; H3[(size_t)t0 * 1024 + i] = f2bf(x1[i]); }
        if (tid < TK * 2) { const int e = eid[tid]; const unsigned slot = atomicAdd(cntp + e, 1u);
            LIST[(size_t)e * NT + slot] = (t0 + (tid >> 1)) * 2 + (tid & 1); LISTW[(size_t)e * NT + slot] = ew[tid]; LISTR[(size_t)e * NT + slot] = rs[tid >> 1]; }
    }
}


struct EpiOut {
    static constexpr bool PERM = true, AFTER_DRAIN = false;
    const float* x; float* out; bf16_t* x1b; float* rss;
    DI void operator()(const pg8::f32x4 (&acc)[2][2][4][2], const pg8::Unit& u, int wr, int wc, int fr, int fq) const {
#pragma unroll
        for (int ai = 0; ai < 2; ++ai)
#pragma unroll
            for (int m = 0; m < 4; ++m) {
                const size_t row = (size_t)u.pm * 256 + ai * 128 + wr * 64 + m * 16 + fr; float ss = 0.f;
#pragma unroll
                for (int bj = 0; bj < 2; ++bj) {
                    const size_t off = row * DM + u.pn * 256 + 128 * bj + 32 * wc + 8 * fq;
                    const f32x4v x0 = *(const f32x4v*)(x + off), x1 = *(const f32x4v*)(x + off + 4);
                    const pg8::f32x4 a0 = acc[ai][bj][m][0], a1 = acc[ai][bj][m][1];
                    const f32x4v o0 = (f32x4v){x0.x + a0[0], x0.y + a0[1], x0.z + a0[2], x0.w + a0[3]}, o1 = (f32x4v){x1.x + a1[0], x1.y + a1[1], x1.z + a1[2], x1.w + a1[3]};
                    *(f32x4v*)(out + off) = o0; *(f32x4v*)(out + off + 4) = o1;
                    ss += (o0.x * o0.x + o0.y * o0.y) + (o0.z * o0.z + o0.w * o0.w) + (o1.x * o1.x + o1.y * o1.y) + (o1.z * o1.z + o1.w * o1.w);
                    v4u w; w.x = cvtpk(o0.x, o0.y); w.y = cvtpk(o0.z, o0.w); w.z = cvtpk(o1.x, o1.y); w.w = cvtpk(o1.z, o1.w);
                    *(v4u*)(x1b + off) = w;
                }
                ss += __shfl_xor(ss, 16); ss += __shfl_xor(ss, 32);
                if (fq == 0) atomicAdd(rss + row, ss);
            }
    }
};
DI void phase_outproj_mfma(const Ctx& a, unsigned char* lds_raw) {
    pg8::Gemm g{(const bf16_t*)(a.ws + WS_OA), (const bf16_t*)(a.ws + WS_WOUT_T), NT, DM, DM};
    pg8::StaticOrder S; S.init(NT, DM, (int)gridDim.x, (int)blockIdx.x);
    EpiOut E{AIN(I_X), a.out, (bf16_t*)(a.ws + WS_X1B), (float*)(a.ws + WS_RSS1)};
    pg8::gemm_phase<EpiOut, pg8::StaticOrder, true, true>((PG8_LAS unsigned char*)lds_raw, g, S, E);
}

struct MoeSched {
    const LAS int* tstart; const LAS int* cnts; int G, c, lognpn, nunits, mode;
    const int* LIST; const char* Abase; const char* Bbase;
    DI bool next(int i, pg8::UnitG& u) const {
        const int L = i * G + c; if (L >= nunits) return false;
        const int gt = L >> lognpn, pn = L & ((1 << lognpn) - 1);
        int e = 0; while (tstart[e + 1] <= gt) ++e;
        const int rt = gt - tstart[e], cnt = cnts[e];
        u.pn = pn; u.e = e; u.rt = rt; u.cnt = cnt; u.row0 = gt * 256;
        const int tid = threadIdx.x;
        if (mode == 0) {
            u.A = Abase; u.B = Bbase + ((size_t)e * 512 + pn * 256) * 1024 * 2;
#pragma unroll
            for (int h = 0; h < 2; ++h)
#pragma unroll
                for (int k = 0; k < 2; ++k) { int R, C; pg8::stage_rc(tid * 16 + k * 8192, R, C); const int idx = rt * 256 + h * 128 + R;
                    const int tok = (idx < cnt) ? (LIST[(size_t)e * NT + idx] >> 1) : 0; u.ao[h][k] = (unsigned)(tok * 1024 + C) * 2u; }
        } else {
            u.A = Abase + (size_t)gt * 256 * 256 * 2; u.B = Bbase + ((size_t)e * 1024 + pn * 256) * 256 * 2;
#pragma unroll
            for (int h = 0; h < 2; ++h)
#pragma unroll
                for (int k = 0; k < 2; ++k) { int R, C; pg8::stage_rc(tid * 16 + k * 8192, R, C); u.ao[h][k] = (unsigned)((h * 128 + R) * 256 + C) * 2u; }
        }
        return true;
    }
};
struct EpiGU {
    static constexpr bool PERM = true;
    bf16_t* HID; const float* LISTR;
    DI void operator()(const pg8::f32x4 (&acc)[2][2][4][2], const pg8::UnitG& u, int wr, int wc, int fr, int fq) const {
#pragma unroll
        for (int ai = 0; ai < 2; ++ai)
#pragma unroll
            for (int m = 0; m < 4; ++m) {
                const int rl = ai * 128 + wr * 64 + m * 16 + fr; float h[8];
                const int idx = u.rt * 256 + rl; const float rsd = (idx < u.cnt) ? LISTR[(size_t)u.e * NT + idx] : 0.f;
#pragma unroll
                for (int n = 0; n < 2; ++n)
#pragma unroll
                    for (int i = 0; i < 4; ++i) h[4 * n + i] = siluf(acc[ai][0][m][n][i] * rsd) * (acc[ai][1][m][n][i] * rsd);
                v4u w; w.x = cvtpk(h[0], h[1]); w.y = cvtpk(h[2], h[3]); w.z = cvtpk(h[4], h[5]); w.w = cvtpk(h[6], h[7]);
                *(v4u*)(HID + (size_t)(u.row0 + rl) * 256 + 128 * u.pn + 32 * wc + 8 * fq) = w;
            }
    }
};
struct EpiDown {
    static constexpr bool PERM = true;
    bf16_t* Y; const int* LIST; const float* LISTW;
    DI void operator()(const pg8::f32x4 (&acc)[2][2][4][2], const pg8::UnitG& u, int wr, int wc, int fr, int fq) const {
#pragma unroll
        for (int ai = 0; ai < 2; ++ai)
#pragma unroll
            for (int m = 0; m < 4; ++m) {
                const int rl = ai * 128 + wr * 64 + m * 16 + fr, idx = u.rt * 256 + rl;
                if (idx < u.cnt) {
                    const int asg = LIST[(size_t)u.e * NT + idx]; const float wg = LISTW[(size_t)u.e * NT + idx];
#pragma unroll
                    for (int bj = 0; bj < 2; ++bj) { const pg8::f32x4 a0 = acc[ai][bj][m][0], a1 = acc[ai][bj][m][1];
                        v4u w; w.x = cvtpk(a0[0] * wg, a0[1] * wg); w.y = cvtpk(a0[2] * wg, a0[3] * wg); w.z = cvtpk(a1[0] * wg, a1[1] * wg); w.w = cvtpk(a1[2] * wg, a1[3] * wg);
                        *(v4u*)(Y + (size_t)asg * 1024 + 256 * u.pn + 128 * bj + 32 * wc + 8 * fq) = w; }
                }
                asm volatile("" ::: "memory");
            }
    }
};
DI int moe_setup(const Ctx& a, unsigned char* lds_raw) {
    LAS int* ts = (LAS int*)((LAS unsigned char*)lds_raw + 131072); LAS int* cn = ts + 40;
    const unsigned* cnt = (const unsigned*)(a.ws + WS_CTL) + CW_CNT;
    __syncthreads();
    if (threadIdx.x == 0) { int acc = 0; for (int e = 0; e < NEXP; ++e) { const int c = (int)__hip_atomic_load(cnt + e, __ATOMIC_RELAXED, __HIP_MEMORY_SCOPE_AGENT); ts[e] = acc; cn[e] = c; acc += (c + 255) >> 8; } ts[NEXP] = acc; ts[NEXP + 1] = 0x7fffffff; }
    __syncthreads();
    return ts[NEXP];
}
DI void phase_moe_gu(const Ctx& a, unsigned char* lds_raw) {
    const int ntil = moe_setup(a, lds_raw);
    LAS int* ts = (LAS int*)((LAS unsigned char*)lds_raw + 131072);
    MoeSched S{ts, ts + 40, (int)gridDim.x, (int)blockIdx.x, 1, ntil * 2, 0, (const int*)(a.ws + WS_LIST), (const char*)(a.ws + WS_H3), (const char*)(a.ws + WS_WGU_T)};
    EpiGU E{(bf16_t*)(a.ws + WS_HID), (const float*)(a.ws + WS_LISTR)};
    pg8::gemm_phase_g<EpiGU, MoeSched>((PG8_LAS unsigned char*)lds_raw, 1024, S, E);
}
DI void phase_moe_down(const Ctx& a, unsigned char* lds_raw) {
    const int ntil = moe_setup(a, lds_raw);
    LAS int* ts = (LAS int*)((LAS unsigned char*)lds_raw + 131072);
    MoeSched S{ts, ts + 40, (int)gridDim.x, (int)blockIdx.x, 2, ntil * 4, 1, (const int*)(a.ws + WS_LIST), (const char*)(a.ws + WS_HID), (const char*)(a.ws + WS_WD_T)};
    EpiDown E{(bf16_t*)(a.ws + WS_Y), (const int*)(a.ws + WS_LIST), (const float*)(a.ws + WS_LISTW)};
    int kk = 256; asm volatile("" : "+s"(kk));
    pg8::gemm_phase_g<EpiDown, MoeSched>((PG8_LAS unsigned char*)lds_raw, kk, S, E);
}
DI void phase_combine(const Ctx& a) {
    const int tid = opaque_tid(), lane = tid & 63, wv = tid >> 6;
    const bf16_t* Y = (const bf16_t*)(a.ws + WS_Y);
    for (int t = blockIdx.x * NWAVE + wv; t < NT; t += gridDim.x * NWAVE) {
        f32x4v* o = (f32x4v*)(a.out + (size_t)t * DM) + lane;
        const unsigned long long* y0 = (const unsigned long long*)(Y + (size_t)(2 * t) * DM) + lane; const unsigned long long* y1 = (const unsigned long long*)(Y + (size_t)(2 * t + 1) * DM) + lane;
#pragma unroll
        for (int j = 0; j < 4; ++j) { f32x4v v = o[64 * j]; const unsigned long long p = y0[64 * j], q = y1[64 * j];
            v.x += bf2f((unsigned short)(p & 0xffff)) + bf2f((unsigned short)(q & 0xffff)); v.y += bf2f((unsigned short)((p >> 16) & 0xffff)) + bf2f((unsigned short)((q >> 16) & 0xffff));
            v.z += bf2f((unsigned short)((p >> 32) & 0xffff)) + bf2f((unsigned short)((q >> 32) & 0xffff)); v.w += bf2f((unsigned short)(p >> 48)) + bf2f((unsigned short)(q >> 48));
            o[64 * j] = v; }
    }
}


typedef float f32x16 __attribute__((ext_vector_type(16)));
typedef short s16x8 __attribute__((ext_vector_type(8)));
typedef short s16x4 __attribute__((ext_vector_type(4)));
#define MFMA32(a, b, c) __builtin_amdgcn_mfma_f32_32x32x16_bf16((a), (b), (c), 0, 0, 0)
DI int crow(int reg, int h) { return (reg & 3) + 8 * (reg >> 2) + 4 * h; }
DI s16x8 pack8(const f32x16& x, int s) {
    v4u p; p.x = cvtpk(x[8 * s], x[8 * s + 1]); p.y = cvtpk(x[8 * s + 2], x[8 * s + 3]); p.z = cvtpk(x[8 * s + 4], x[8 * s + 5]); p.w = cvtpk(x[8 * s + 6], x[8 * s + 7]);
    return __builtin_bit_cast(s16x8, p);
}
constexpr int TSTR = 272;
DI void phase_ret_state(const Ctx& a, unsigned char* lds_raw) {
    const int tid = opaque_tid(), lane = tid & 63, wv = __builtin_amdgcn_readfirstlane(tid >> 6), r = lane & 31, hh = lane >> 5;
    unsigned char* Kt = lds_raw;
    unsigned char* Vt = lds_raw + 64 * TSTR;
    const bf16_t* RET = (const bf16_t*)(a.ws + WS_RET);
    float* STT = (float*)(a.ws + WS_STT);
    for (int bh = (int)((blockIdx.x + gridDim.x - 64u) % gridDim.x); bh < NB * NHR; bh += gridDim.x) {
        const int h = bh % NHR; const float l2g = log2f(1.f - exp2f(-5.f - (float)h)); const float gc = exp2f(128.f * l2g);
        const int et = wv & 1, dt = (wv >> 1) & 1;
        f32x16 acc;
#pragma unroll
        for (int i = 0; i < 16; ++i) acc[i] = 0.f;
        for (int n = 0; n < 16; ++n) {
            __syncthreads();
#pragma unroll
            for (int i = 0; i < 2; ++i) { const int idx = tid + 512 * i, j = idx >> 3, c = idx & 7;
                const size_t go = ((size_t)bh * NS + n * 128 + j) * DH + 8 * c;
                const v4u kv = *(const v4u*)(RET + RET_STRIDE + go), vv = *(const v4u*)(RET + 2 * RET_STRIDE + go);
                const float z = exp2f((float)(127 - j) * l2g);
                const unsigned kw[4] = {kv.x, kv.y, kv.z, kv.w}, vw[4] = {vv.x, vv.y, vv.z, vv.w};
#pragma unroll
                for (int k = 0; k < 4; ++k) {
                    *(bf16_t*)(Kt + (8 * c + 2 * k) * TSTR + 2 * j) = f2bf(bf2f((unsigned short)(kw[k] & 0xffff)) * z);
                    *(bf16_t*)(Kt + (8 * c + 2 * k + 1) * TSTR + 2 * j) = f2bf(bf2f((unsigned short)(kw[k] >> 16)) * z);
                    *(bf16_t*)(Vt + (8 * c + 2 * k) * TSTR + 2 * j) = (unsigned short)(vw[k] & 0xffff);
                    *(bf16_t*)(Vt + (8 * c + 2 * k + 1) * TSTR + 2 * j) = (unsigned short)(vw[k] >> 16); } }
            __syncthreads();
            if (wv < 4) {
                float* dst = STT + ((size_t)bh * 16 + n) * 4096;
#pragma unroll
                for (int i = 0; i < 16; ++i) dst[(32 * et + crow(i, hh)) * 64 + 32 * dt + r] = acc[i];
#pragma unroll
                for (int i = 0; i < 16; ++i) acc[i] *= gc;
#pragma unroll
                for (int s = 0; s < 8; ++s) {
                    const s16x8 af = *(const s16x8*)(Vt + (32 * et + r) * TSTR + (16 * s + 8 * hh) * 2);
                    const s16x8 bf = *(const s16x8*)(Kt + (32 * dt + r) * TSTR + (16 * s + 8 * hh) * 2);
                    acc = MFMA32(af, bf, acc);
                }
            }
        }
    }
}
DI void phase_ret_out(const Ctx& a, unsigned char* lds_raw) {
    const int tid = opaque_tid(), lane = tid & 63, wv = __builtin_amdgcn_readfirstlane(tid >> 6), r = lane & 31, hh = lane >> 5;
    unsigned char* Kl = lds_raw;
    unsigned char* Vt = lds_raw + 16384;
    float* Ol = (float*)(lds_raw + 16384 + 64 * TSTR + 256);
    const bf16_t* RET = (const bf16_t*)(a.ws + WS_RET);
    const float* STT = (const float*)(a.ws + WS_STT);
    bf16_t* OA = (bf16_t*)(a.ws + WS_OA);
    for (int u = blockIdx.x; u < NB * NHR * 16; u += gridDim.x) {
        const int bh = u >> 4, n = u & 15, h = bh % NHR, b = bh / NHR;
        const float l2g = log2f(1.f - exp2f(-5.f - (float)h));
        __syncthreads();
#pragma unroll
        for (int i = 0; i < 2; ++i) { const int idx = tid + 512 * i, j = idx >> 3, c = idx & 7;
            const size_t go = ((size_t)bh * NS + n * 128 + j) * DH + 8 * c;
            const v4u kv = *(const v4u*)(RET + RET_STRIDE + go), vv = *(const v4u*)(RET + 2 * RET_STRIDE + go);
            *(v4u*)(Kl + j * 128 + ((c ^ ((j >> 1) & 7)) * 16)) = kv;
            const unsigned vw[4] = {vv.x, vv.y, vv.z, vv.w};
#pragma unroll
            for (int k = 0; k < 4; ++k) { *(bf16_t*)(Vt + (8 * c + 2 * k) * TSTR + 2 * j) = (unsigned short)(vw[k] & 0xffff); *(bf16_t*)(Vt + (8 * c + 2 * k + 1) * TSTR + 2 * j) = (unsigned short)(vw[k] >> 16); } }
        const int it = wv & 3, eh = wv >> 2;
        s16x8 qf[4];
        { const bf16_t* qp = RET + ((size_t)bh * NS + n * 128 + 32 * it + r) * DH + 8 * hh;
#pragma unroll
          for (int s = 0; s < 4; ++s) qf[s] = *(const s16x8*)(qp + 16 * s); }
        __syncthreads();
        f32x16 oin, ocr;
#pragma unroll
        for (int i = 0; i < 16; ++i) { oin[i] = 0.f; ocr[i] = 0.f; }
        for (int jt = 0; jt <= it; ++jt) {
            f32x16 st;
#pragma unroll
            for (int i = 0; i < 16; ++i) st[i] = 0.f;
            const int row = 32 * jt + r;
#pragma unroll
            for (int s = 0; s < 4; ++s) { const s16x8 kf = *(const s16x8*)(Kl + row * 128 + (((2 * s + hh) ^ ((row >> 1) & 7)) * 16)); st = MFMA32(kf, qf[s], st); }
            const int iq = 32 * it + r;
#pragma unroll
            for (int i = 0; i < 16; ++i) { const int dl = iq - (32 * jt + crow(i, hh)); st[i] = (dl >= 0) ? st[i] * exp2f((float)dl * l2g) : 0.f; }
#pragma unroll
            for (int s2 = 0; s2 < 2; ++s2) {
                const s16x8 pa = pack8(st, s2);
                const unsigned char* vp = Vt + (32 * eh + r) * TSTR + (32 * jt + 16 * s2 + 4 * hh) * 2;
                const s16x4 lo = *(const s16x4*)vp, hi = *(const s16x4*)(vp + 16);
                const s16x8 vf = __builtin_shufflevector(lo, hi, 0, 1, 2, 3, 4, 5, 6, 7);
                oin = MFMA32(pa, vf, oin);
            }
        }
        { const float* sp = STT + ((size_t)bh * 16 + n) * 4096 + (size_t)(32 * eh + r) * 64 + 8 * hh;
#pragma unroll
          for (int s = 0; s < 4; ++s) { const f32x4v f0 = *(const f32x4v*)(sp + 16 * s), f1 = *(const f32x4v*)(sp + 16 * s + 4);
              v4u p; p.x = cvtpk(f0.x, f0.y); p.y = cvtpk(f0.z, f0.w); p.z = cvtpk(f1.x, f1.y); p.w = cvtpk(f1.z, f1.w);
              ocr = MFMA32(qf[s], __builtin_bit_cast(s16x8, p), ocr); } }
#pragma unroll
        for (int i = 0; i < 16; ++i) { const int iq = 32 * it + crow(i, hh); Ol[iq * 64 + 32 * eh + r] = oin[i] + exp2f((float)(iq + 1) * l2g) * ocr[i]; }
        __syncthreads();
        { const int row = tid >> 2, qd = tid & 3; const float* op = Ol + row * 64 + 16 * qd; float v[16]; float sm = 0.f;
#pragma unroll
          for (int k = 0; k < 16; ++k) { v[k] = op[k]; sm += v[k]; }
          sm += __shfl_xor(sm, 1); sm += __shfl_xor(sm, 2); const float mu = sm * (1.f / 64.f); float vr = 0.f;
#pragma unroll
          for (int k = 0; k < 16; ++k) { const float d = v[k] - mu; vr += d * d; }
          vr += __shfl_xor(vr, 1); vr += __shfl_xor(vr, 2); const float rs = rsqrtf(vr * (1.f / 64.f) + EPS);
          const size_t tok = (size_t)b * NS + n * 128 + row;
          const bf16_t* gp = RET + 3 * RET_STRIDE + ((size_t)bh * NS + n * 128 + row) * DH + 16 * qd;
          const v4u g0 = *(const v4u*)gp, g1 = *(const v4u*)(gp + 8); const unsigned gw[8] = {g0.x, g0.y, g0.z, g0.w, g1.x, g1.y, g1.z, g1.w};
          const float* nw = AIN(I_RETON) + h * 64 + 16 * qd; unsigned ow[8];
#pragma unroll
          for (int k = 0; k < 8; ++k) { const float ga = bf2f((unsigned short)(gw[k] & 0xffff)), gb = bf2f((unsigned short)(gw[k] >> 16));
              ow[k] = cvtpk((v[2 * k] - mu) * rs * nw[2 * k] * siluf(ga), (v[2 * k + 1] - mu) * rs * nw[2 * k + 1] * siluf(gb)); }
          bf16_t* dp = OA + tok * 1024 + 512 + h * 64 + 16 * qd;
          *(v4u*)dp = (v4u){ow[0], ow[1], ow[2], ow[3]}; *(v4u*)(dp + 8) = (v4u){ow[4], ow[5], ow[6], ow[7]}; }
    }
}


constexpr int VSTR = 136;
constexpr int KVBUF = 8192 + 64 * VSTR;
constexpr float LOG2E = 1.4426950408889634f;
DI void nsa_stage_load(const bf16_t* Kg, const bf16_t* Vg, int jb, int tid, v4u& kr, v4u& vr) {
    const size_t go = ((size_t)jb * 64 + (tid >> 3)) * DH + 8 * (tid & 7);
    kr = *(const v4u*)(Kg + go); vr = *(const v4u*)(Vg + go);
}
DI void nsa_stage_write(unsigned char* buf, int tid, const v4u& kr, const v4u& vr) {
    const int j = tid >> 3, c = tid & 7;
    *(v4u*)(buf + j * 128 + ((c ^ ((j >> 1) & 7)) * 16)) = kr;
    unsigned char* vs = buf + 8192; const unsigned vw[4] = {vr.x, vr.y, vr.z, vr.w};
#pragma unroll
    for (int k = 0; k < 4; ++k) { *(bf16_t*)(vs + (8 * c + 2 * k) * VSTR + 2 * j) = (unsigned short)(vw[k] & 0xffff); *(bf16_t*)(vs + (8 * c + 2 * k + 1) * VSTR + 2 * j) = (unsigned short)(vw[k] >> 16); }
}
template <int MODE>
DI void nsa_branch(const bf16_t* Kg, const bf16_t* Vg, int jlo, int jhi, int cur, int tq, unsigned selmask, float negsh, const s16x8 (&qf)[4],
                   f32x16 (&O)[2], float& lsum, unsigned char* kvb, int tid, int r, int hh) {
    v4u kr, vr;
    nsa_stage_load(Kg, Vg, jlo, tid, kr, vr);
    __syncthreads();
    nsa_stage_write(kvb, tid, kr, vr);
    __syncthreads();
    for (int j = jlo; j <= jhi; ++j) {
        unsigned char* buf = kvb + ((j - jlo) & 1) * KVBUF;
        asm volatile("" : "+v"(r), "+v"(hh), "+v"(tid));
        if (j < jhi) nsa_stage_load(Kg, Vg, j + 1, tid, kr, vr);
        float ns = negsh;
        if (MODE == 0) ns = ((selmask >> j) & 1u) ? negsh : -1e30f;
#pragma unroll
        for (int kt = 0; kt < 2; ++kt) {
            f32x16 st;
#pragma unroll
            for (int i = 0; i < 16; ++i) st[i] = 0.f;
            const int row = 32 * kt + r;
#pragma unroll
            for (int s = 0; s < 4; ++s) { const s16x8 kf = *(const s16x8*)(buf + row * 128 + (((2 * s + hh) ^ ((row >> 1) & 7)) * 16)); st = MFMA32(kf, qf[s], st); }
            const int kbase = 64 * j + 32 * kt;
            if (j == cur) {
#pragma unroll
                for (int i = 0; i < 16; ++i) { const int key = kbase + crow(i, hh); st[i] = (key <= tq) ? __builtin_amdgcn_exp2f(st[i] * LOG2E + ns) : 0.f; }
            } else if (MODE == 1 && j == cur - 8) {
#pragma unroll
                for (int i = 0; i < 16; ++i) { const int key = kbase + crow(i, hh); st[i] = (key >= tq - 511) ? __builtin_amdgcn_exp2f(st[i] * LOG2E + ns) : 0.f; }
            } else {
#pragma unroll
                for (int i = 0; i < 16; ++i) st[i] = __builtin_amdgcn_exp2f(st[i] * LOG2E + ns);
            }
            float sm = 0.f;
#pragma unroll
            for (int i = 0; i < 16; ++i) sm += st[i];
            lsum += sm;
#pragma unroll
            for (int s2 = 0; s2 < 2; ++s2) {
                const s16x8 pa = pack8(st, s2);
#pragma unroll
                for (int et = 0; et < 2; ++et) {
                    const unsigned char* vp = buf + 8192 + (32 * et + r) * VSTR + (32 * kt + 16 * s2 + 4 * hh) * 2;
                    const s16x4 lo = *(const s16x4*)vp, hi = *(const s16x4*)(vp + 16);
                    O[et] = MFMA32(pa, __builtin_shufflevector(lo, hi, 0, 1, 2, 3, 4, 5, 6, 7), O[et]);
                }
            }
        }
        if (j < jhi) nsa_stage_write(kvb + ((j + 1 - jlo) & 1) * KVBUF, tid, kr, vr);
        __syncthreads();
    }
}
DI void phase_nsa_mfma(const Ctx& a, unsigned char* lds_raw) {
    int tid = opaque_tid(), lane = tid & 63; const int wv = __builtin_amdgcn_readfirstlane(tid >> 6); int r = lane & 31, hh = lane >> 5;
    unsigned char* Kc = lds_raw;
    unsigned char* Vc = lds_raw + 16384;
    unsigned char* kvb = lds_raw + 33792;
    float* coefl = (float*)(lds_raw + 67584) + wv * 32;
    float* bnd = (float*)(lds_raw + 67584 + 1024);
    float* Ol = (float*)(lds_raw + 69632) + wv * 2048;
    const bf16_t* Q = (const bf16_t*)(a.ws + WS_Q); const bf16_t* KV = (const bf16_t*)(a.ws + WS_KV);
    const bf16_t* KCMP = (const bf16_t*)(a.ws + WS_KCMP); const bf16_t* VCMP = (const bf16_t*)(a.ws + WS_VCMP);
    const float* GATES = (const float*)(a.ws + WS_GATES);
    bf16_t* OA = (bf16_t*)(a.ws + WS_OA);
    __syncthreads();
    if (wv < 3) { const float* gk = AIN(wv == 0 ? I_KCN : (wv == 1 ? I_KSN : I_KWN));
        const float mq = wave_max(fabsf(AIN(I_QN)[lane])), mk = wave_max(fabsf(gk[lane]));
        if (lane == 0) bnd[wv] = 8.f * mq * mk * LOG2E; }
    __syncthreads();
    const float nsh_c = -bnd[0], nsh_s = -bnd[1], nsh_w = -bnd[2];
    for (int it2 = blockIdx.x; it2 < 512; it2 += gridDim.x) {
        const int wi = it2 & 255, pass = it2 >> 8;
        const int bg = wi & 15, k = wi >> 4, qt = pass == 0 ? (31 - k) : k, cur = qt;
        const int b = bg >> 1, g = bg & 1, t0 = qt * 64;
        asm volatile("" : "+v"(r), "+v"(hh), "+v"(tid), "+v"(lane));
        const int q = r, head = q >> 3, tokl = 8 * wv + (q & 7), tq = t0 + tokl;
        const size_t tglob = (size_t)b * NS + tq;
        __syncthreads();
#pragma unroll
        for (int i = 0; i < 2; ++i) { const int idx = tid + 512 * i, j = idx >> 3, c = idx & 7;
            const size_t go = ((size_t)bg * 128 + j) * DH + 8 * c;
            const v4u kv = *(const v4u*)(KCMP + go), vv = *(const v4u*)(VCMP + go);
            *(v4u*)(Kc + j * 128 + ((c ^ ((j >> 1) & 7)) * 16)) = kv;
            const unsigned vw[4] = {vv.x, vv.y, vv.z, vv.w};
#pragma unroll
            for (int kk = 0; kk < 4; ++kk) { *(bf16_t*)(Vc + (8 * c + 2 * kk) * TSTR + 2 * j) = (unsigned short)(vw[kk] & 0xffff); *(bf16_t*)(Vc + (8 * c + 2 * kk + 1) * TSTR + 2 * j) = (unsigned short)(vw[kk] >> 16); } }
        s16x8 qf[4];
        { const bf16_t* qp = Q + tglob * 512 + (g * 4 + head) * 64 + 8 * hh;
#pragma unroll
          for (int s = 0; s < 4; ++s) qf[s] = *(const s16x8*)(qp + 16 * s); }
        const float* gt = GATES + tglob * 24 + g * 12 + head * 3;
        const float g0 = sigmf(gt[0]), g1 = sigmf(gt[1]), g2 = sigmf(gt[2]);
        __syncthreads();
        f32x16 Ot[2], Ob[2];
#pragma unroll
        for (int i = 0; i < 16; ++i) { Ot[0][i] = 0.f; Ot[1][i] = 0.f; Ob[0][i] = 0.f; Ob[1][i] = 0.f; }
        const int nkt = (4 * qt + 3 + 31) >> 5;
        const int cmax = (tq >= 31) ? ((tq - 31) >> 4) : -1;
        float impv[16]; float lc = 0.f, carry = 0.f;
#pragma unroll
        for (int kt = 0; kt < 4; ++kt) {
            f32x16 st;
#pragma unroll
            for (int i = 0; i < 16; ++i) st[i] = 0.f;
            if (kt < nkt) {
                const int row = 32 * kt + r;
#pragma unroll
                for (int s = 0; s < 4; ++s) { const s16x8 kf = *(const s16x8*)(Kc + row * 128 + (((2 * s + hh) ^ ((row >> 1) & 7)) * 16)); st = MFMA32(kf, qf[s], st); }
#pragma unroll
                for (int i = 0; i < 16; ++i) { const int c = 32 * kt + crow(i, hh); st[i] = (c <= cmax) ? __builtin_amdgcn_exp2f(st[i] * LOG2E + nsh_c) : 0.f; lc += st[i]; }
#pragma unroll
                for (int s2 = 0; s2 < 2; ++s2) {
                    const s16x8 pa = pack8(st, s2);
#pragma unroll
                    for (int et = 0; et < 2; ++et) {
                        const unsigned char* vp = Vc + (32 * et + r) * TSTR + (32 * kt + 16 * s2 + 4 * hh) * 2;
                        const s16x4 lo = *(const s16x4*)vp, hi = *(const s16x4*)(vp + 16);
                        Ob[et] = MFMA32(pa, __builtin_shufflevector(lo, hi, 0, 1, 2, 3, 4, 5, 6, 7), Ob[et]);
                    }
                }
            }
#pragma unroll
            for (int aa = 0; aa < 4; ++aa) { const float sp = 0.5f * st[4 * aa + 3]; const float osp = __shfl_xor(sp, 32);
                impv[kt * 4 + aa] = st[4 * aa] + st[4 * aa + 1] + st[4 * aa + 2] + sp + (hh ? osp : carry); carry = osp; }
            asm volatile("" ::: "memory");
        }
        const float ltc = lc + __shfl_xor(lc, 32);
        const float invc = (ltc > 0.f) ? 1.f / ltc : 0.f;
        unsigned selmask;
        {
#pragma unroll
            for (int x = 0; x < 16; ++x) { impv[x] *= invc; impv[x] += __shfl_xor(impv[x], 8); impv[x] += __shfl_xor(impv[x], 16); }
            if (cur < 8) selmask = (2u << cur) - 1u;
            else {
                selmask = 1u | (1u << cur) | (1u << (cur - 1));
#pragma unroll
                for (int x = 0; x < 16; ++x) { const int j = 2 * x + hh; if (j < 1 || j > cur - 2) impv[x] = -1e30f; }
                for (int rd = 0; rd < 5; ++rd) {
                    float best = -2e30f; int bj = 99;
#pragma unroll
                    for (int x = 0; x < 16; ++x) if (impv[x] > best) { best = impv[x]; bj = 2 * x + hh; }
                    const float ob = __shfl_xor(best, 32); const int oj = __shfl_xor(bj, 32);
                    const bool take = (ob > best) || (ob == best && oj < bj);
                    const int wj = take ? oj : bj;
                    selmask |= 1u << wj;
#pragma unroll
                    for (int x = 0; x < 16; ++x) if (2 * x + hh == wj) impv[x] = -2e30f;
                }
            }
        }
#define NSA_FOLD(coefv) do { asm volatile("" ::: "memory"); if (hh == 0) coefl[q] = (coefv); asm volatile("s_waitcnt lgkmcnt(0)" ::: "memory"); \
        _Pragma("unroll") for (int i = 0; i < 16; ++i) { const float cf = coefl[crow(i, hh)]; Ot[0][i] += cf * Ob[0][i]; Ot[1][i] += cf * Ob[1][i]; Ob[0][i] = 0.f; Ob[1][i] = 0.f; } \
        asm volatile("s_waitcnt lgkmcnt(0)" ::: "memory"); } while (0)
        NSA_FOLD(g0 * invc);
        { float ls = 0.f;
          nsa_branch<0>(KV + 2 * KV_STRIDE + (size_t)bg * NS * DH, KV + 3 * KV_STRIDE + (size_t)bg * NS * DH, 0, cur, cur, tq, selmask, nsh_s, qf, Ob, ls, kvb, tid, r, hh);
          const float lt = ls + __shfl_xor(ls, 32);
          NSA_FOLD(g1 / lt); }
        { float lw = 0.f;
          nsa_branch<1>(KV + 4 * KV_STRIDE + (size_t)bg * NS * DH, KV + 5 * KV_STRIDE + (size_t)bg * NS * DH, cur >= 8 ? cur - 8 : 0, cur, cur, tq, 0u, nsh_w, qf, Ob, lw, kvb, tid, r, hh);
          const float lt = lw + __shfl_xor(lw, 32);
          NSA_FOLD(g2 / lt); }
#pragma unroll
        for (int i = 0; i < 16; ++i) { Ol[crow(i, hh) * 64 + r] = Ot[0][i]; Ol[crow(i, hh) * 64 + 32 + r] = Ot[1][i]; }
        asm volatile("s_waitcnt lgkmcnt(0)" ::: "memory");
        { const int rq = lane >> 1, hf = lane & 1; const float* op = Ol + rq * 64 + 32 * hf; float ss = 0.f;
#pragma unroll
          for (int c4 = 0; c4 < 8; ++c4) { const f32x4v t4 = *(const f32x4v*)(op + 4 * c4); ss += (t4.x * t4.x + t4.y * t4.y) + (t4.z * t4.z + t4.w * t4.w); }
          ss += __shfl_xor(ss, 1);
          const float rs = rsqrtf(ss * (1.f / 64.f) + EPS);
          const int hd = g * 4 + (rq >> 3); const float* nw = AIN(I_NSAON) + hd * 64 + 32 * hf;
          bf16_t* dp = OA + ((size_t)b * NS + t0 + 8 * wv + (rq & 7)) * 1024 + hd * 64 + 32 * hf;
#pragma unroll
          for (int c4 = 0; c4 < 4; ++c4) { const f32x4v va = *(const f32x4v*)(op + 8 * c4), vb = *(const f32x4v*)(op + 8 * c4 + 4); const f32x4v na = *(const f32x4v*)(nw + 8 * c4), nb = *(const f32x4v*)(nw + 8 * c4 + 4); v4u w;
              w.x = cvtpk(va.x * rs * na.x, va.y * rs * na.y); w.y = cvtpk(va.z * rs * na.z, va.w * rs * na.w);
              w.z = cvtpk(vb.x * rs * nb.x, vb.y * rs * nb.y); w.w = cvtpk(vb.z * rs * nb.z, vb.w * rs * nb.w);
              *(v4u*)(dp + 8 * c4) = w; asm volatile("" ::: "memory"); } }
        asm volatile("s_waitcnt lgkmcnt(0)" ::: "memory");
    }
#undef NSA_FOLD
}


#define MFMA16(a, b, c) __builtin_amdgcn_mfma_f32_16x16x32_bf16((a), (b), (c), 0, 0, 0)
DI int perm32i(int rho) { const int n = rho >> 4, i = rho & 15; return 8 * (i >> 2) + 4 * n + (i & 3); }
DI void p5_loadB(const bf16_t* Bt, int K, int kt, int tid, v4u (&br)[4]) {
#pragma unroll
    for (int i = 0; i < 4; ++i) { const int p = tid + 512 * i, rho = p >> 3, c = p & 7; const int n = (rho & ~31) + perm32i(rho & 31); br[i] = *(const v4u*)(Bt + (size_t)n * K + kt * 64 + 8 * c); }
}
DI void p5_writeB(unsigned char* Bl, int tid, const v4u (&br)[4]) {
#pragma unroll
    for (int i = 0; i < 4; ++i) { const int p = tid + 512 * i, rho = p >> 3, c = p & 7; *(v4u*)(Bl + rho * 128 + ((c ^ (rho & 7)) * 16)) = br[i]; }
}
DI void phase_memattn_mfma(const Ctx& a, unsigned char* lds_raw) {
    int tid = opaque_tid(); const int lane = tid & 63, wv = __builtin_amdgcn_readfirstlane(tid >> 6);
    int fr = lane & 15, fq = lane >> 4, r = lane & 31, hh = lane >> 5;
    const int wm = wv >> 2, wn = wv & 3;
    unsigned char* Al = lds_raw; unsigned char* Bl = lds_raw + 16384; unsigned char* QOl = lds_raw + 81920;
    float* rstd1 = (float*)(lds_raw + 114688); float* rss2 = rstd1 + 64; float* coefl = rstd1 + 128 + wv * 32; float* lgs = rstd1 + 384; float* bndp = lgs + 6144;
    const bf16_t* X1b = (const bf16_t*)(a.ws + WS_X1B); const bf16_t* WqT = (const bf16_t*)(a.ws + WS_WQ_T); const bf16_t* WoT = (const bf16_t*)(a.ws + WS_WO_T);
    const bf16_t* MK = (const bf16_t*)(a.ws + WS_MK); const bf16_t* MVT = (const bf16_t*)(a.ws + WS_MVT);
    const bf16_t* WRH = (const bf16_t*)(a.ws + WS_WR_HI); const bf16_t* WRL = (const bf16_t*)(a.ws + WS_WR_LO);
    const float* RSS1 = (const float*)(a.ws + WS_RSS1);
    bf16_t* X2b = (bf16_t*)(a.ws + WS_H3); int* LIST = (int*)(a.ws + WS_LIST); float* LISTW = (float*)(a.ws + WS_LISTW); float* LISTR = (float*)(a.ws + WS_LISTR);
    unsigned* cntp = (unsigned*)(a.ws + WS_CTL) + CW_CNT;
    __syncthreads();
    if (wv == 0) { const float mq = wave_max(fabsf(AIN(I_MQN)[lane])), mk = wave_max(fabsf(AIN(I_MKN)[lane])); if (lane == 0) bndp[0] = 8.f * mq * mk * LOG2E; }
    __syncthreads();
    const float nsh = -bndp[0];
    for (int it = blockIdx.x; it < NT / 64; it += gridDim.x) {
        const int t0 = it * 64, b = t0 / NS;
        asm volatile("" : "+v"(tid), "+v"(fr), "+v"(fq), "+v"(r), "+v"(hh));
        __syncthreads();
        if (tid < 64) { rstd1[tid] = rsqrtf(RSS1[t0 + tid] * (1.f / DM) + EPS); rss2[tid] = 0.f; }
        pg8::f32x4 acc[2][4];
#pragma unroll
        for (int m = 0; m < 2; ++m)
#pragma unroll
            for (int n = 0; n < 4; ++n) acc[m][n] = (pg8::f32x4){0.f, 0.f, 0.f, 0.f};
        {
            v4u ar, br[4];
            const bf16_t* Ap = X1b + (size_t)(t0 + (tid >> 3)) * DM + 8 * (tid & 7);
            ar = *(const v4u*)Ap; p5_loadB(WqT, 1024, 0, tid, br);
            *(v4u*)(Al + (tid >> 3) * 128 + (((tid & 7) ^ ((tid >> 3) & 7)) * 16)) = ar; p5_writeB(Bl, tid, br);
            __syncthreads();
            for (int kt = 0; kt < 16; ++kt) {
                asm volatile("" : "+v"(tid), "+v"(fr), "+v"(fq));
                if (kt + 1 < 16) { ar = *(const v4u*)(Ap + (kt + 1) * 64); p5_loadB(WqT, 1024, kt + 1, tid, br); }
                const unsigned char* Ac = Al + (kt & 1) * 8192; const unsigned char* Bc = Bl + (kt & 1) * 32768;
#pragma unroll
                for (int kk = 0; kk < 2; ++kk) {
                    pg8::bf16x8 af[2], bfr[4];
#pragma unroll
                    for (int m = 0; m < 2; ++m) af[m] = *(const pg8::bf16x8*)(Ac + (32 * wm + 16 * m + fr) * 128 + (((4 * kk + fq) ^ (fr & 7)) * 16));
#pragma unroll
                    for (int n = 0; n < 4; ++n) bfr[n] = *(const pg8::bf16x8*)(Bc + (64 * wn + 16 * n + fr) * 128 + (((4 * kk + fq) ^ (fr & 7)) * 16));
#pragma unroll
                    for (int m = 0; m < 2; ++m)
#pragma unroll
                        for (int n = 0; n < 4; ++n) acc[m][n] = MFMA16(bfr[n], af[m], acc[m][n]);
                }
                if (kt + 1 < 16) { *(v4u*)(Al + ((kt + 1) & 1) * 8192 + (tid >> 3) * 128 + (((tid & 7) ^ ((tid >> 3) & 7)) * 16)) = ar; p5_writeB(Bl + ((kt + 1) & 1) * 32768, tid, br); }
                __syncthreads();
            }
        }
        { const float* mqn = AIN(I_MQN);
#pragma unroll
          for (int m = 0; m < 2; ++m) { const int row = 32 * wm + 16 * m + fr; const float rs1 = rstd1[row]; float v[16]; float ss = 0.f;
#pragma unroll
              for (int n = 0; n < 4; ++n)
#pragma unroll
                  for (int i = 0; i < 4; ++i) { v[4 * n + i] = acc[m][n][i] * rs1; ss += v[4 * n + i] * v[4 * n + i]; }
              ss += __shfl_xor(ss, 16); ss += __shfl_xor(ss, 32);
              const float rn = rsqrtf(ss * (1.f / 64.f) + EPS) * 0.125f;
#pragma unroll
              for (int gp = 0; gp < 2; ++gp) { const float* gq = mqn + 32 * gp + 8 * fq; v4u w;
                  w.x = cvtpk(v[8 * gp] * rn * gq[0], v[8 * gp + 1] * rn * gq[1]); w.y = cvtpk(v[8 * gp + 2] * rn * gq[2], v[8 * gp + 3] * rn * gq[3]);
                  w.z = cvtpk(v[8 * gp + 4] * rn * gq[4], v[8 * gp + 5] * rn * gq[5]); w.w = cvtpk(v[8 * gp + 6] * rn * gq[6], v[8 * gp + 7] * rn * gq[7]);
                  *(v4u*)(QOl + row * 512 + (((8 * wn + 4 * gp + fq) ^ (row & 15)) * 16)) = w; } } }
        __syncthreads();
        { const int head = wv >> 1, th = wv & 1; const int row = 32 * th + r;
          s16x8 qf[4];
#pragma unroll
          for (int s2 = 0; s2 < 4; ++s2) qf[s2] = *(const s16x8*)(QOl + row * 512 + (((8 * head + 2 * s2 + hh) ^ (row & 15)) * 16));
          const bf16_t* Kp = MK + (size_t)(b * MH + head) * NMEM * DH; const bf16_t* Vp = MVT + (size_t)(b * MH + head) * DH * NMEM;
          f32x16 O[2];
#pragma unroll
          for (int i = 0; i < 16; ++i) { O[0][i] = 0.f; O[1][i] = 0.f; }
          float lsum = 0.f;
          for (int kt = 0; kt < 8; ++kt) {
              asm volatile("" : "+v"(r), "+v"(hh));
              f32x16 st;
#pragma unroll
              for (int i = 0; i < 16; ++i) st[i] = 0.f;
#pragma unroll
              for (int s2 = 0; s2 < 4; ++s2) { const s16x8 kf = *(const s16x8*)(Kp + (size_t)(32 * kt + r) * DH + 16 * s2 + 8 * hh); st = MFMA32(kf, qf[s2], st); }
#pragma unroll
              for (int i = 0; i < 16; ++i) { st[i] = __builtin_amdgcn_exp2f(st[i] * LOG2E + nsh); lsum += st[i]; }
#pragma unroll
              for (int s2 = 0; s2 < 2; ++s2) { const s16x8 pa = pack8(st, s2);
#pragma unroll
                  for (int et = 0; et < 2; ++et) { const bf16_t* vp = Vp + (size_t)(32 * et + r) * NMEM + 32 * kt + 16 * s2 + 4 * hh;
                      const s16x4 lo = *(const s16x4*)vp, hi = *(const s16x4*)(vp + 8);
                      O[et] = MFMA32(pa, __builtin_shufflevector(lo, hi, 0, 1, 2, 3, 4, 5, 6, 7), O[et]); } }
          }
          const float lt = lsum + __shfl_xor(lsum, 32);
          asm volatile("" ::: "memory"); if (hh == 0) coefl[r] = 1.f / lt; asm volatile("s_waitcnt lgkmcnt(0)" ::: "memory");
#pragma unroll
          for (int i = 0; i < 16; ++i) { const float cf = coefl[crow(i, hh)]; const int orow = 32 * th + crow(i, hh);
#pragma unroll
              for (int et = 0; et < 2; ++et) { const int chunk = 8 * head + 4 * et + (r >> 3);
                  *(bf16_t*)(QOl + orow * 512 + ((chunk ^ (orow & 15)) * 16) + (r & 7) * 2) = f2bf(O[et][i] * cf); } }
        }
        __syncthreads();
        for (int nc = 0; nc < 4; ++nc) {
#pragma unroll
            for (int m = 0; m < 2; ++m)
#pragma unroll
                for (int n = 0; n < 4; ++n) acc[m][n] = (pg8::f32x4){0.f, 0.f, 0.f, 0.f};
            v4u br[4];
            const bf16_t* Bt = WoT + (size_t)nc * 256 * 256;
            p5_loadB(Bt, 256, 0, tid, br); p5_writeB(Bl, tid, br);
            __syncthreads();
            for (int kt = 0; kt < 4; ++kt) {
                asm volatile("" : "+v"(tid), "+v"(fr), "+v"(fq));
                if (kt + 1 < 4) p5_loadB(Bt, 256, kt + 1, tid, br);
                const unsigned char* Bc = Bl + (kt & 1) * 32768;
#pragma unroll
                for (int kk = 0; kk < 2; ++kk) {
                    pg8::bf16x8 af[2], bfr[4];
#pragma unroll
                    for (int m = 0; m < 2; ++m) af[m] = *(const pg8::bf16x8*)(QOl + (32 * wm + 16 * m + fr) * 512 + (((8 * kt + 4 * kk + fq) ^ fr) * 16));
#pragma unroll
                    for (int n = 0; n < 4; ++n) bfr[n] = *(const pg8::bf16x8*)(Bc + (64 * wn + 16 * n + fr) * 128 + (((4 * kk + fq) ^ (fr & 7)) * 16));
#pragma unroll
                    for (int m = 0; m < 2; ++m)
#pragma unroll
                        for (int n = 0; n < 4; ++n) acc[m][n] = MFMA16(bfr[n], af[m], acc[m][n]);
                }
                if (kt + 1 < 4) p5_writeB(Bl + ((kt + 1) & 1) * 32768, tid, br);
                __syncthreads();
            }
#pragma unroll
            for (int m = 0; m < 2; ++m) { const int row = 32 * wm + 16 * m + fr; float ss = 0.f;
#pragma unroll
                for (int gp = 0; gp < 2; ++gp) { const size_t off = (size_t)(t0 + row) * DM + 256 * nc + 64 * wn + 32 * gp + 8 * fq;
                    const f32x4v x0 = *(const f32x4v*)(a.out + off), x1 = *(const f32x4v*)(a.out + off + 4);
                    const pg8::f32x4 a0 = acc[m][2 * gp], a1 = acc[m][2 * gp + 1];
                    const f32x4v o0 = (f32x4v){x0.x + a0[0], x0.y + a0[1], x0.z + a0[2], x0.w + a0[3]}, o1 = (f32x4v){x1.x + a1[0], x1.y + a1[1], x1.z + a1[2], x1.w + a1[3]};
                    *(f32x4v*)(a.out + off) = o0; *(f32x4v*)(a.out + off + 4) = o1;
                    ss += (o0.x * o0.x + o0.y * o0.y) + (o0.z * o0.z + o0.w * o0.w) + (o1.x * o1.x + o1.y * o1.y) + (o1.z * o1.z + o1.w * o1.w);
                    v4u w; w.x = cvtpk(o0.x, o0.y); w.y = cvtpk(o0.z, o0.w); w.z = cvtpk(o1.x, o1.y); w.w = cvtpk(o1.z, o1.w);
                    *(v4u*)(X2b + off) = w; }
                ss += __shfl_xor(ss, 16); ss += __shfl_xor(ss, 32);
                if (fq == 0) atomicAdd(rss2 + row, ss); }
        }
        asm volatile("s_waitcnt vmcnt(0)" ::: "memory");
        __syncthreads();
        { const int mt = wv & 3, kh = wv >> 2;
          pg8::f32x4 a3[3];
#pragma unroll
          for (int n = 0; n < 3; ++n) a3[n] = (pg8::f32x4){0.f, 0.f, 0.f, 0.f};
          const float* xp = a.out + (size_t)(t0 + 16 * mt + fr) * DM + 512 * kh + 8 * fq;
          const bf16_t* whp = WRH + (size_t)fr * DM + 512 * kh + 8 * fq; const bf16_t* wlp = WRL + (size_t)fr * DM + 512 * kh + 8 * fq;
          for (int ks = 0; ks < 16; ++ks) {
              const f32x4v f0 = *(const f32x4v*)(xp + 32 * ks), f1 = *(const f32x4v*)(xp + 32 * ks + 4);
              const float xv[8] = {f0.x, f0.y, f0.z, f0.w, f1.x, f1.y, f1.z, f1.w}; float xh[8], xl[8];
#pragma unroll
              for (int j = 0; j < 8; ++j) { xh[j] = bf2f(f2bf(xv[j])); xl[j] = xv[j] - xh[j]; }
              v4u ph, pl; ph.x = cvtpk(xh[0], xh[1]); ph.y = cvtpk(xh[2], xh[3]); ph.z = cvtpk(xh[4], xh[5]); ph.w = cvtpk(xh[6], xh[7]);
              pl.x = cvtpk(xl[0], xl[1]); pl.y = cvtpk(xl[2], xl[3]); pl.z = cvtpk(xl[4], xl[5]); pl.w = cvtpk(xl[6], xl[7]);
              const pg8::bf16x8 xhf = __builtin_bit_cast(pg8::bf16x8, ph), xlf = __builtin_bit_cast(pg8::bf16x8, pl);
#pragma unroll
              for (int n = 0; n < 3; ++n) { const pg8::bf16x8 wh = *(const pg8::bf16x8*)(whp + (size_t)16 * n * DM + 32 * ks), wl = *(const pg8::bf16x8*)(wlp + (size_t)16 * n * DM + 32 * ks);
                  a3[n] = MFMA16(xhf, wh, a3[n]); a3[n] = MFMA16(xhf, wl, a3[n]); a3[n] = MFMA16(xlf, wh, a3[n]); }
          }
#pragma unroll
          for (int n = 0; n < 3; ++n)
#pragma unroll
              for (int i = 0; i < 4; ++i) lgs[kh * 3072 + (16 * mt + 4 * fq + i) * 48 + 16 * n + fr] = a3[n][i];
        }
        __syncthreads();
        if (tid < 64) { const float rs2 = rsqrtf(rss2[tid] * (1.f / DM) + EPS); float* l = lgs + tid * 48;
            for (int n = 0; n < 36; ++n) l[n] = (l[n] + l[3072 + n]) * rs2 + (n < 4 ? AIN(I_RGB)[n] : AIN(I_REB)[n - 4]);
            int grp = 0; float gm = l[0];
            for (int j = 1; j < 4; ++j) if (l[j] > gm) { gm = l[j]; grp = j; }
            float gs = 0.f; for (int j = 0; j < 4; ++j) gs += __expf(l[j] - gm);
            const float gw = 1.f / gs;
            const float* el = l + 4 + grp * 8; int e0 = 0; float v0 = el[0];
            for (int j = 1; j < 8; ++j) if (el[j] > v0) { v0 = el[j]; e0 = j; }
            int e1 = -1; float v1 = 0.f;
            for (int j = 0; j < 8; ++j) if (j != e0) { if (e1 < 0 || el[j] > v1) { v1 = el[j]; e1 = j; } }
            const float p1 = __expf(v1 - v0); const float den = 1.f + p1;
            const int ea = grp * 8 + e0, eb = grp * 8 + e1; const int tok = t0 + tid;
            const unsigned sa = atomicAdd(cntp + ea, 1u); LIST[(size_t)ea * NT + sa] = tok * 2; LISTW[(size_t)ea * NT + sa] = gw / den; LISTR[(size_t)ea * NT + sa] = rs2;
            const unsigned sb = atomicAdd(cntp + eb, 1u); LIST[(size_t)eb * NT + sb] = tok * 2 + 1; LISTW[(size_t)eb * NT + sb] = gw * p1 / den; LISTR[(size_t)eb * NT + sb] = rs2; }
    }
}


struct MemKvOrder {
    int c, first;
    DI bool next(int i, pg8::Unit& u) const { const int k = c - first; if (i != 0 || k < 0 || k >= 16) return false; u.pm = k >> 1; u.pn = k & 1; return true; }
    DI void a_ready(const pg8::Unit&) const {}
    DI void done(const pg8::Unit&) const {}
};
struct EpiMemKV {
    static constexpr bool PERM = true, AFTER_DRAIN = false;
    bf16_t* MK; bf16_t* MVT; const float* kn;
    DI void operator()(const pg8::f32x4 (&acc)[2][2][4][2], const pg8::Unit& u, int wr, int wc, int fr, int fq) const {
        const int b = u.pm;
        float g[2][8];
#pragma unroll
        for (int bj = 0; bj < 2; ++bj)
#pragma unroll
            for (int j = 0; j < 8; ++j) g[bj][j] = kn[32 * bj + 8 * fq + j];
#pragma unroll
        for (int ai = 0; ai < 2; ++ai)
#pragma unroll
            for (int m = 0; m < 4; ++m) {
                const int rl = ai * 128 + wr * 64 + m * 16 + fr;
                float v[2][8];
#pragma unroll
                for (int bj = 0; bj < 2; ++bj)
#pragma unroll
                    for (int n = 0; n < 2; ++n)
#pragma unroll
                        for (int i = 0; i < 4; ++i) v[bj][4 * n + i] = acc[ai][bj][m][n][i];
                if (u.pn == 0) {
                    float ss = 0.f;
#pragma unroll
                    for (int bj = 0; bj < 2; ++bj)
#pragma unroll
                        for (int j = 0; j < 8; ++j) ss += v[bj][j] * v[bj][j];
                    ss += __shfl_xor(ss, 16); ss += __shfl_xor(ss, 32);
                    const float rn = rsqrtf(ss * (1.f / 64.f) + EPS);
                    bf16_t* rp = MK + ((size_t)(b * MH + wc) * NMEM + rl) * DH + 8 * fq;
#pragma unroll
                    for (int bj = 0; bj < 2; ++bj) { v4u w; w.x = cvtpk(v[bj][0] * rn * g[bj][0], v[bj][1] * rn * g[bj][1]); w.y = cvtpk(v[bj][2] * rn * g[bj][2], v[bj][3] * rn * g[bj][3]);
                        w.z = cvtpk(v[bj][4] * rn * g[bj][4], v[bj][5] * rn * g[bj][5]); w.w = cvtpk(v[bj][6] * rn * g[bj][6], v[bj][7] * rn * g[bj][7]); *(v4u*)(rp + 32 * bj) = w; }
                } else {
                    bf16_t* tp = MVT + (size_t)(b * MH + wc) * DH * NMEM + rl;
#pragma unroll
                    for (int bj = 0; bj < 2; ++bj)
#pragma unroll
                        for (int j = 0; j < 8; ++j) tp[(size_t)(32 * bj + 8 * fq + j) * NMEM] = f2bf(v[bj][j]);
                }
            }
    }
};
DI void phase_memkv_mfma(const Ctx& a, unsigned char* lds_raw) {
    pg8::Gemm g{(const bf16_t*)(a.ws + WS_HM), (const bf16_t*)(a.ws + WS_WKV_T), NB * NMEM, 512, DM};
    MemKvOrder S{(int)blockIdx.x, (int)gridDim.x >= 144 ? 128 : 0};
    EpiMemKV E{(bf16_t*)(a.ws + WS_MK), (bf16_t*)(a.ws + WS_MVT), AIN(I_MKN)};
    pg8::gemm_phase<EpiMemKV, MemKvOrder, true, true>((PG8_LAS unsigned char*)lds_raw, g, S, E);
}

DI void phase_compress_mfma(const Ctx& a, unsigned char* lds_raw) {
    int tid = opaque_tid(); const int lane = tid & 63, wv = __builtin_amdgcn_readfirstlane(tid >> 6);
    int fr = lane & 15, fq = lane >> 4;
    const int wm = wv >> 2, wn = wv & 3;
    unsigned char* Al = lds_raw; unsigned char* Bl = lds_raw + 16384; unsigned char* Hl = lds_raw + 49152; unsigned char* W2l = lds_raw + 65536; float* Ol = (float*)(lds_raw + 81920);
    const bf16_t* KV = (const bf16_t*)(a.ws + WS_KV);
    for (int u = blockIdx.x; u < 64; u += gridDim.x) {
        const int kv = u >> 5, bg = (u >> 1) & 15, half = u & 1;
        const bf16_t* Ab = KV + (size_t)kv * KV_STRIDE + ((size_t)bg * NS + 16 * 64 * half) * DH;
        const bf16_t* W1T = (const bf16_t*)(a.ws + WS_W1K_T) + (size_t)kv * 128 * 2048; const bf16_t* W2T = (const bf16_t*)(a.ws + WS_W2K_T) + (size_t)kv * 64 * 128;
        const float* PB = (const float*)(a.ws + WS_PB) + kv * 128;
        asm volatile("" : "+v"(tid), "+v"(fr), "+v"(fq));
        __syncthreads();
#pragma unroll
        for (int i = 0; i < 2; ++i) { const int p = tid + 512 * i, row = p >> 4, c = p & 15; *(v4u*)(W2l + row * 256 + ((c ^ (row & 15)) * 16)) = *(const v4u*)(W2T + row * 128 + 8 * c); }
        pg8::f32x4 acc[2][2];
#pragma unroll
        for (int m = 0; m < 2; ++m)
#pragma unroll
            for (int n = 0; n < 2; ++n) acc[m][n] = (pg8::f32x4){0.f, 0.f, 0.f, 0.f};
        {
            v4u ar, br[2];
            const bf16_t* Ap = Ab + (size_t)(tid >> 3) * 1024 + 8 * (tid & 7);
            ar = *(const v4u*)Ap;
#pragma unroll
            for (int i = 0; i < 2; ++i) { const int p = tid + 512 * i; br[i] = *(const v4u*)(W1T + (size_t)(p >> 3) * 2048 + 8 * (p & 7)); }
            *(v4u*)(Al + (tid >> 3) * 128 + (((tid & 7) ^ ((tid >> 3) & 7)) * 16)) = ar;
#pragma unroll
            for (int i = 0; i < 2; ++i) { const int p = tid + 512 * i, rho = p >> 3, c = p & 7; *(v4u*)(Bl + rho * 128 + ((c ^ (rho & 7)) * 16)) = br[i]; }
            __syncthreads();
            for (int kt = 0; kt < 32; ++kt) {
                asm volatile("" : "+v"(tid), "+v"(fr), "+v"(fq));
                if (kt + 1 < 32) { ar = *(const v4u*)(Ap + (kt + 1) * 64);
#pragma unroll
                    for (int i = 0; i < 2; ++i) { const int p = tid + 512 * i; br[i] = *(const v4u*)(W1T + (size_t)(p >> 3) * 2048 + (kt + 1) * 64 + 8 * (p & 7)); } }
                const unsigned char* Ac = Al + (kt & 1) * 8192; const unsigned char* Bc = Bl + (kt & 1) * 16384;
#pragma unroll
                for (int kk = 0; kk < 2; ++kk) {
                    pg8::bf16x8 af[2], bfr[2];
#pragma unroll
                    for (int m = 0; m < 2; ++m) af[m] = *(const pg8::bf16x8*)(Ac + (32 * wm + 16 * m + fr) * 128 + (((4 * kk + fq) ^ (fr & 7)) * 16));
#pragma unroll
                    for (int n = 0; n < 2; ++n) bfr[n] = *(const pg8::bf16x8*)(Bc + (32 * wn + 16 * n + fr) * 128 + (((4 * kk + fq) ^ (fr & 7)) * 16));
#pragma unroll
                    for (int m = 0; m < 2; ++m)
#pragma unroll
                        for (int n = 0; n < 2; ++n) acc[m][n] = MFMA16(bfr[n], af[m], acc[m][n]);
                }
                if (kt + 1 < 32) { *(v4u*)(Al + ((kt + 1) & 1) * 8192 + (tid >> 3) * 128 + (((tid & 7) ^ ((tid >> 3) & 7)) * 16)) = ar;
#pragma unroll
                    for (int i = 0; i < 2; ++i) { const int p = tid + 512 * i, rho = p >> 3, c = p & 7; *(v4u*)(Bl + ((kt + 1) & 1) * 16384 + rho * 128 + ((c ^ (rho & 7)) * 16)) = br[i]; } }
                __syncthreads();
            }
        }
#pragma unroll
        for (int m = 0; m < 2; ++m)
#pragma unroll
            for (int n = 0; n < 2; ++n) { const int row = 32 * wm + 16 * m + fr, col = 32 * wn + 16 * n + 4 * fq; const f32x4v pb = *(const f32x4v*)(PB + col);
                unsigned long long w = (unsigned long long)cvtpk(siluf(acc[m][n][0] + pb.x), siluf(acc[m][n][1] + pb.y)) | ((unsigned long long)cvtpk(siluf(acc[m][n][2] + pb.z), siluf(acc[m][n][3] + pb.w)) << 32);
                *(unsigned long long*)(Hl + row * 256 + (((col >> 3) ^ (row & 15)) * 16) + (fq & 1) * 8) = w; }
        __syncthreads();
        { pg8::f32x4 a2[2] = {(pg8::f32x4){0.f, 0.f, 0.f, 0.f}, (pg8::f32x4){0.f, 0.f, 0.f, 0.f}};
#pragma unroll
          for (int kk = 0; kk < 4; ++kk) { const pg8::bf16x8 bfr = *(const pg8::bf16x8*)(W2l + (16 * wn + fr) * 256 + (((4 * kk + fq) ^ fr) * 16));
#pragma unroll
              for (int m = 0; m < 2; ++m) { const pg8::bf16x8 af = *(const pg8::bf16x8*)(Hl + (32 * wm + 16 * m + fr) * 256 + (((4 * kk + fq) ^ fr) * 16)); a2[m] = MFMA16(bfr, af, a2[m]); } }
#pragma unroll
          for (int m = 0; m < 2; ++m) *(f32x4v*)(Ol + (32 * wm + 16 * m + fr) * 64 + 16 * wn + 4 * fq) = (f32x4v){a2[m][0], a2[m][1], a2[m][2], a2[m][3]}; }
        __syncthreads();
        { const int row = tid >> 3, part = tid & 7; const float* op = Ol + row * 64 + 8 * part; const f32x4v o0 = *(const f32x4v*)op, o1 = *(const f32x4v*)(op + 4);
          float v[8] = {o0.x, o0.y, o0.z, o0.w, o1.x, o1.y, o1.z, o1.w};
          if (kv == 0) { float ss = 0.f;
#pragma unroll
              for (int j = 0; j < 8; ++j) ss += v[j] * v[j];
              ss += __shfl_xor(ss, 1); ss += __shfl_xor(ss, 2); ss += __shfl_xor(ss, 4);
              const float rn = rsqrtf(ss * (1.f / 64.f) + EPS); const float* gk = AIN(I_KCN) + 8 * part;
#pragma unroll
              for (int j = 0; j < 8; ++j) v[j] = v[j] * rn * gk[j]; }
          const int c = 64 * half + row;
          v4u w; w.x = cvtpk(v[0], v[1]); w.y = cvtpk(v[2], v[3]); w.z = cvtpk(v[4], v[5]); w.w = cvtpk(v[6], v[7]);
          if (c == 127) w = (v4u){0u, 0u, 0u, 0u};
          *(v4u*)((bf16_t*)(a.ws + (kv ? WS_VCMP : WS_KCMP)) + ((size_t)bg * 128 + c) * DH + 8 * part) = w; }
    }
}

__global__ void __launch_bounds__(NTHR, 2) fwd_kernel(Args ka) {
    extern __shared__ __attribute__((aligned(16))) unsigned char lds_raw[];
    float* lds = (float*)lds_raw;
    volatile LAS unsigned* misc = (volatile LAS unsigned*)((LAS unsigned char*)lds_raw + LDS_MISC);
    if (threadIdx.x < 64) misc[threadIdx.x] = 0u;
    LAS unsigned long long* ptab = (LAS unsigned long long*)((LAS unsigned char*)lds_raw + LDS_PTAB);
    if (threadIdx.x < 32) ptab[threadIdx.x] = (unsigned long long)ka.in[threadIdx.x];
    __syncthreads();
    Ctx a; a.tab = ptab; a.out = ka.out; a.ws = ka.ws;
    XcdBarrier bar = xcd_barrier_post((unsigned*)(a.ws + WS_CTL), misc + 8);

#ifndef PHMASK
#define PHMASK 0xffff
#endif
#define PH(k) ((PHMASK >> (k)) & 1)
    if (PH(0)) phase_prologue(a, lds_raw);
    xcd_barrier(bar);
    if (PH(1)) phase_proj_mfma(a, lds_raw);
    if (PH(2)) phase_memkv_mfma(a, lds_raw);
    xcd_barrier(bar);
    if (PH(3)) phase_compress_mfma(a, lds_raw);
    if (PH(11)) phase_ret_state(a, lds_raw);
    xcd_barrier(bar);
    if (PH(4)) phase_nsa_mfma(a, lds_raw);
    if (PH(5)) phase_ret_out(a, lds_raw);
    xcd_barrier(bar);
    if (PH(6)) phase_outproj_mfma(a, lds_raw);
    xcd_barrier(bar);
#if OPT_MEMATTN
    if (PH(7)) phase_memattn_mfma(a, lds_raw);
#else
    if (PH(7)) phase_tail_b(a, lds);
#endif
    xcd_barrier(bar);
    if (PH(8)) phase_moe_gu(a, lds_raw);
    xcd_barrier(bar);
    if (PH(9)) phase_moe_down(a, lds_raw);
    xcd_barrier(bar);
    if (PH(10)) phase_combine(a);
}

extern "C" void kernel_launch(void* const* d_in, const int* in_sizes, int n_in, void* d_out, int out_size, void* d_ws, size_t ws_size, hipStream_t stream) {
    static int grid = 0;
    if (grid == 0) {
        if (n_in != 32 || ws_size < WS_END) { fprintf(stderr, "kernel_launch: unexpected n_in %d / ws %zu\n", n_in, ws_size); grid = -1; return; }
        int dev = 0, cus = 0, per_cu = 0;
        if (hipGetDevice(&dev) != hipSuccess || hipDeviceGetAttribute(&cus, hipDeviceAttributeMultiprocessorCount, dev) != hipSuccess) { grid = -1; return; }
        if (hipFuncSetAttribute((const void*)fwd_kernel, hipFuncAttributeMaxDynamicSharedMemorySize, LDS_BYTES) != hipSuccess) { fprintf(stderr, "kernel_launch: hipFuncSetAttribute failed\n"); grid = -1; return; }
        if (hipOccupancyMaxActiveBlocksPerMultiprocessor(&per_cu, (const void*)fwd_kernel, NTHR, LDS_BYTES) != hipSuccess || per_cu < 1) { fprintf(stderr, "kernel_launch: occupancy query says %d blocks per CU\n", per_cu); (void)hipGetLastError(); grid = -1; return; }
        grid = cus;
    }
    if (grid < 0) return;
    (void)hipMemsetAsync((char*)d_ws + WS_CTL, 0, CTL_ZERO_BYTES, stream);
    Args a{};
    for (int i = 0; i < 32; ++i) a.in[i] = (const float*)d_in[i];
    a.out = (float*)d_out; a.ws = (unsigned char*)d_ws;
    hipLaunchKernelGGL(fwd_kernel, dim3(grid), dim3(NTHR), LDS_BYTES, stream, a);
}
```

```cpp
#include <hip/hip_runtime.h>
#include <cstdint>
#include <cstdio>

#define DI __device__ __forceinline__
#define LAS __attribute__((address_space(3)))
#define GAS __attribute__((address_space(1)))

constexpr int NB = 8, NS = 2048, DM = 1024, NT = NB * NS;
constexpr int NG = 2, NR = 4, DH = 64, NHA = 8, NHR = 8;
constexpr int PROJ = 3352;
constexpr int NCMP = 127, NSEL = 32, TOPK = 8, WIN = 512;
constexpr int NMEM = 256, MH = 4, MW = 256;
constexpr int NGRP = 4, EPG = 8, NEXP = 32, EFF = 256;
constexpr float EPS = 1e-6f;
constexpr int NTHR = 512, NWAVE = 8;

typedef unsigned short bf16_t;

DI int opaque_tid() { int t = threadIdx.x; asm volatile("" : "+v"(t)); return t; }
DI unsigned short f2bf(float f) { unsigned u = __float_as_uint(f); u += 0x7fffu + ((u >> 16) & 1u); return (unsigned short)(u >> 16); }
DI float bf2f(unsigned short h) { return __uint_as_float(((unsigned)h) << 16); }
DI float wave_sum(float v) {
#pragma unroll
    for (int o = 1; o < 64; o <<= 1) v += __shfl_xor(v, o);
    return v;
}
DI float wave_max(float v) {
#pragma unroll
    for (int o = 1; o < 64; o <<= 1) v = fmaxf(v, __shfl_xor(v, o));
    return v;
}
DI float siluf(float x) { return x / (1.f + __expf(-x)); }
DI float sigmf(float x) { return 1.f / (1.f + __expf(-x)); }

constexpr size_t MiB = 1u << 20;
constexpr size_t WS_CTL = 0, CTL_ZERO_BYTES = 64 * 1024;
constexpr size_t WS_GATES = 1 * MiB;
constexpr size_t WS_MK = 3 * MiB;
constexpr size_t WS_MV = 4 * MiB;
constexpr size_t WS_KCMP = 5 * MiB;
constexpr size_t WS_VCMP = 5 * MiB + 512 * 1024;
constexpr size_t WS_ROUTE = 7 * MiB;
constexpr size_t WS_LIST = 8 * MiB;
constexpr size_t WS_LISTW = 10 * MiB;
constexpr size_t WS_LISTR = 12 * MiB;
constexpr size_t WS_MVT = 14 * MiB;
constexpr size_t WS_RSS1 = 15 * MiB;
constexpr size_t WS_WQ_T = 25 * MiB;
constexpr size_t WS_WO_T = 25 * MiB + 512 * 1024;
constexpr size_t WS_WR_HI = 26 * MiB;
constexpr size_t WS_WR_LO = 26 * MiB + 128 * 1024;
constexpr size_t WS_X1B = 144 * MiB;
constexpr size_t WS_WKV_T = 27 * MiB;
constexpr size_t WS_W1K_T = 76 * MiB;
constexpr size_t WS_W2K_T = 77 * MiB;
constexpr size_t WS_PB = 77 * MiB + 64 * 1024;
constexpr size_t WS_HM = 152 * MiB;
constexpr size_t WS_WOUT_T = 23 * MiB;
constexpr size_t WS_WGU_T = 28 * MiB;
constexpr size_t WS_WD_T = 60 * MiB;
constexpr size_t WS_H3 = 112 * MiB;
constexpr size_t WS_Y = 172 * MiB;
constexpr size_t WS_HID = 236 * MiB;
constexpr int CW_CNT = 8192;
constexpr size_t WS_ROPE = 6 * MiB;
constexpr size_t WS_WIN_T = 16 * MiB;
constexpr size_t WS_XN = 80 * MiB;
constexpr size_t WS_OA = 80 * MiB;
constexpr size_t WS_Q = 112 * MiB;
constexpr size_t WS_KV = 128 * MiB;
constexpr size_t WS_STT = 156 * MiB;
constexpr size_t WS_RET = 172 * MiB;
constexpr size_t WS_END = 256 * MiB;
constexpr size_t KV_STRIDE = (size_t)NB * NG * NS * DH;
constexpr size_t RET_STRIDE = (size_t)NB * NHR * NS * DH;

#define XB_TMO      128
#define XB_XCNT(j)  (256  + 64 * (j))
#define XB_XSUB(j)  (1280 + 64 * (j))
#define XB_XGEN(j)  (2304 + 64 * (j))
#define XB_TOP      3328
#define XB_TOPGEN   3392
#define XCD_BAR_WORDS 3456
#define XB_SPIN_CAP (1u << 22)
DI unsigned xb_ld(unsigned* p)              { return __hip_atomic_load(p, __ATOMIC_RELAXED, __HIP_MEMORY_SCOPE_AGENT); }
DI unsigned xb_add(unsigned* p, unsigned v) { return __hip_atomic_fetch_add(p, v, __ATOMIC_RELAXED, __HIP_MEMORY_SCOPE_AGENT); }
DI unsigned xb_xcc_id() { return (unsigned)__builtin_amdgcn_s_getreg((3 << 11) | 20) & 0xFu; }
#define XB_SPIN(cond, bar) do { unsigned _sp = 0; while (cond) { __builtin_amdgcn_s_sleep(1); \
    if ((++_sp & 255u) == 0u) { if (xb_ld(&(bar)[XB_TMO])) break; if (_sp > XB_SPIN_CAP) { atomicAdd(&(bar)[XB_TMO], 1u); break; } } } } while (0)
struct XcdBarrier { unsigned* bar; unsigned x; volatile LAS unsigned* st; };
DI XcdBarrier xcd_barrier_post(unsigned* bar, volatile LAS unsigned* st) {
    XcdBarrier b; b.bar = bar; b.x = xb_xcc_id(); b.st = st;
    if (threadIdx.x == 0) (void)xb_add(&bar[XB_XCNT(b.x)], 1u);
    return b;
}
DI void xcd_barrier_complete(unsigned* bar, unsigned x, unsigned& nloc, unsigned& nx) {
    const unsigned G = gridDim.x * gridDim.y * gridDim.z;
    unsigned sum, cnt, mine, sp = 0u;
    for (;;) {
        sum = 0u; cnt = 0u; mine = 0u;
#pragma unroll
        for (unsigned j = 0; j < 16; ++j) { const unsigned c = xb_ld(&bar[XB_XCNT(j)]); sum += c; cnt += (c > 0u) ? 1u : 0u; mine = (j == x) ? c : mine; }
        if (sum == G) break;
        __builtin_amdgcn_s_sleep(1);
        if ((++sp & 255u) == 0u) { if (xb_ld(&bar[XB_TMO])) break; if (sp > XB_SPIN_CAP) { atomicAdd(&bar[XB_TMO], 1u); break; } }
    }
    nloc = mine > 0u ? mine : 1u; nx = cnt > 0u ? cnt : 1u;
}
DI void xcd_barrier(const XcdBarrier& b) {
    asm volatile("s_waitcnt vmcnt(0)" ::: "memory");
    __syncthreads();
    if (threadIdx.x == 0) {
        unsigned* bar = b.bar;
        __builtin_amdgcn_s_waitcnt(0);
        unsigned nloc = b.st[0], nx = b.st[1];
        if (nloc == 0u) { xcd_barrier_complete(bar, b.x, nloc, nx); b.st[0] = nloc; b.st[1] = nx; }
        const unsigned old = xb_add(&bar[XB_XSUB(b.x)], 1u);
        const unsigned gen = old / nloc;
        if (old + 1u == (gen + 1u) * nloc) {
            __builtin_amdgcn_fence(__ATOMIC_RELEASE, "agent");
            asm volatile("s_waitcnt vmcnt(0)" ::: "memory");
            const unsigned og = xb_add(&bar[XB_TOP], 1u);
            const unsigned tg = og / nx;
            if (og + 1u == (tg + 1u) * nx) xb_add(&bar[XB_TOPGEN], 1u);
            else XB_SPIN(xb_ld(&bar[XB_TOPGEN]) == tg, bar);
            __builtin_amdgcn_fence(__ATOMIC_ACQUIRE, "agent");
            xb_add(&bar[XB_XGEN(b.x)], 1u);
            asm volatile("s_waitcnt vmcnt(0)" ::: "memory");
        } else {
            XB_SPIN(xb_ld(&bar[XB_XGEN(b.x)]) == gen, bar);
            __builtin_amdgcn_fence(__ATOMIC_ACQUIRE, "agent");
            asm volatile("s_waitcnt vmcnt(0)" ::: "memory");
        }
    }
    __syncthreads();
}

namespace pg8 {
#define PG8_LAS __attribute__((address_space(3)))
typedef unsigned short bf16_t;
typedef short bf16x8 __attribute__((ext_vector_type(8)));
typedef float f32x4 __attribute__((ext_vector_type(4)));
typedef unsigned u32x4 __attribute__((ext_vector_type(4)));
constexpr int BM = 256, BK = 64, HALF = 128, HTB = HALF * BK * 2  , STAGE_BYTES = 8 * HTB, NXCD = 8, WGM = 8;

__host__ __device__ __forceinline__ int lds_byte(int r, int c) { const int st = (r >> 4) * 2 + (c >> 5), rr = r & 15, cc = c & 31, ob = rr * 64 + cc * 2; return st * 1024 + (ob ^ (((ob >> 9) & 1) << 5)); }
__host__ __device__ __forceinline__ void stage_rc(int b, int& R, int& C) { const int st = b / 1024, sb = b % 1024, swz = sb ^ (((sb >> 9) & 1) << 5); R = (st >> 1) * 16 + swz / 64; C = (st & 1) * 32 + (swz % 64) / 2; }
__host__ __device__ __forceinline__ int perm32(int rho) { const int n = rho >> 4, i = rho & 15; return 8 * (i >> 2) + 4 * n + (i & 3); }

struct Unit { int pm, pn; };
struct Gemm { const bf16_t* A; const bf16_t* Bt; int M, N, K; };

struct StaticOrder {
    int nM, nN, nwg, G, c;
    __host__ __device__ void init(int M, int N, int G_, int c_) { nM = M / BM; nN = N / BM; nwg = nM * nN; G = G_; c = c_; }
    __host__ __device__ bool next(int i, Unit& u) const {
        const long L = (long)i * G + c; if (L >= nwg) return false;
        int wgid = (int)L; { const int q = nwg / NXCD, r = nwg % NXCD, xcd = wgid % NXCD, off = wgid / NXCD; wgid = (xcd < r ? xcd * (q + 1) : r * (q + 1) + (xcd - r) * q) + off; }
        const int nig = WGM * nN, gid = wgid / nig, fm = gid * WGM, gsz = (nM - fm) < WGM ? (nM - fm) : WGM;
        u.pm = fm + ((wgid % nig) % gsz); u.pn = (wgid % nig) / gsz; return true;
    }
    __device__ __forceinline__ void a_ready(const Unit&) const {}
    __device__ __forceinline__ void done(const Unit&) const {}
};


template <class Epi, class Sched, bool ALIGN_EPI = false, bool SP2 = false>
__device__ __forceinline__ void gemm_phase(PG8_LAS unsigned char* lds, const Gemm g, const Sched& S, const Epi& E) {
    const int tid = opaque_tid(), wid = __builtin_amdgcn_readfirstlane(tid >> 6), lane = tid & 63, wr = wid >> 2, wc = wid & 3, fr = lane & 15, fq = lane >> 4;
    const int K = g.K, nt = K / BK;
    unsigned voffA[2], voffB[2];
#pragma unroll
    for (int i = 0; i < 2; ++i) { int R, C; stage_rc(tid * 16 + i * 8192, R, C); const int Rb = Epi::PERM ? ((R & ~31) + perm32(R & 31)) : R;
        voffA[i] = (unsigned)(R * K + C) * 2u; voffB[i] = (unsigned)(Rb * K + C) * 2u; }
    const size_t kstep = (size_t)(BK * 2);
    const size_t hstep = (size_t)HALF * K * 2;
    const size_t tstep = 2 * hstep;
    const unsigned ldsw = (unsigned)wid * 1024u;
    const int aoff = lds_byte(wr * 64 + fr, fq * 8), boff = lds_byte(wc * 32 + fr, fq * 8);
#define PG8_SA(b, h) (((b) * 2 + (h)) * HTB)
#define PG8_SB(b, h) ((4 + (b) * 2 + (h)) * HTB)
#define PG8_STAGE(bufoff, gbase, voff) do { _Pragma("unroll") for (int _i = 0; _i < 2; ++_i) \
        __builtin_amdgcn_global_load_lds((const unsigned*)((const char*)(gbase) + (voff)[_i]), (PG8_LAS unsigned*)(lds + (bufoff) + ldsw + _i * 8192), 16, 0, 0); } while (0)
#define PG8_LDA(dst, b, h) do { _Pragma("unroll") for (int m = 0; m < 4; ++m) _Pragma("unroll") for (int k = 0; k < 2; ++k) dst[m][k] = *(const PG8_LAS bf16x8*)(lds + PG8_SA(b, h) + aoff + m * 2048 + k * 1024); } while (0)
#define PG8_LDB(dst, b, h) do { _Pragma("unroll") for (int n = 0; n < 2; ++n) _Pragma("unroll") for (int k = 0; k < 2; ++k) dst[n][k] = *(const PG8_LAS bf16x8*)(lds + PG8_SB(b, h) + boff + n * 2048 + k * 1024); } while (0)
#define PG8_MMA(ai, bj, At, Bt) do { __builtin_amdgcn_s_setprio(1); _Pragma("unroll") for (int m = 0; m < 4; ++m) _Pragma("unroll") for (int n = 0; n < 2; ++n) _Pragma("unroll") for (int k = 0; k < 2; ++k) \
        acc[ai][bj][m][n] = __builtin_amdgcn_mfma_f32_16x16x32_bf16(Bt[n][k], At[m][k], acc[ai][bj][m][n], 0, 0, 0); __builtin_amdgcn_s_setprio(0); } while (0)
#define PG8_WAIT_V(n) asm volatile("s_waitcnt vmcnt(" #n ")" ::: "memory")
#define PG8_WAIT_L(n) asm volatile("s_waitcnt lgkmcnt(" #n ")" ::: "memory")
#define PG8_BAR __builtin_amdgcn_s_barrier()
#define PG8_SCHED __builtin_amdgcn_sched_barrier(0)
    Unit cur, nxt; int ui = 0;
    if (!S.next(0, cur)) return;
    f32x4 acc[2][2][4][2];
#pragma unroll
    for (int a = 0; a < 2; ++a)
#pragma unroll
        for (int b = 0; b < 2; ++b)
#pragma unroll
            for (int m = 0; m < 4; ++m)
#pragma unroll
                for (int n = 0; n < 2; ++n) acc[a][b][m][n] = (f32x4){0.f, 0.f, 0.f, 0.f};
    bf16x8 At[4][2], B0[2][2], B1[2][2];
    const char* cA = (const char*)g.A + (size_t)cur.pm * tstep; const char* cB = (const char*)g.Bt + (size_t)cur.pn * tstep;
    S.a_ready(cur);
    if constexpr (SP2) {
        PG8_STAGE(PG8_SB(0, 0), cB, voffB); PG8_STAGE(PG8_SB(0, 1), cB + hstep, voffB); PG8_STAGE(PG8_SA(0, 0), cA, voffA); PG8_STAGE(PG8_SA(0, 1), cA + hstep, voffA);
        if (wr == 1) PG8_BAR;
        PG8_WAIT_V(2); PG8_BAR;
        PG8_STAGE(PG8_SB(1, 0), cB + kstep, voffB); PG8_STAGE(PG8_SA(1, 0), cA + kstep, voffA); PG8_STAGE(PG8_SB(1, 1), cB + hstep + kstep, voffB);
        PG8_WAIT_V(6); PG8_BAR;
    } else {
        PG8_STAGE(PG8_SB(0, 0), cB, voffB); PG8_STAGE(PG8_SA(0, 0), cA, voffA); PG8_STAGE(PG8_SB(0, 1), cB + hstep, voffB); PG8_STAGE(PG8_SA(0, 1), cA + hstep, voffA);
        if (wr == 1) PG8_BAR;
        PG8_WAIT_V(4); PG8_BAR;
        PG8_STAGE(PG8_SB(1, 0), cB + kstep, voffB); PG8_STAGE(PG8_SA(1, 0), cA + kstep, voffA); PG8_STAGE(PG8_SB(1, 1), cB + hstep + kstep, voffB);
        PG8_WAIT_V(6); PG8_BAR;
    }
    for (;;) {
        const bool has_next = S.next(ui + 1, nxt);
        const char* nA = has_next ? (const char*)g.A + (size_t)nxt.pm * tstep : cA; const char* nB = has_next ? (const char*)g.Bt + (size_t)nxt.pn * tstep : cB;
        for (int t = 0; t < nt; t += 2) {
            const bool last = (t == nt - 2);
            const char* a1 = cA + (size_t)(t + 1) * kstep;
            const char* a2 = last ? nA : cA + (size_t)(t + 2) * kstep; const char* b2 = last ? nB : cB + (size_t)(t + 2) * kstep;
            const char* a3 = a2 + kstep; const char* b3 = b2 + kstep;
            if (last && has_next) S.a_ready(nxt);
            if constexpr (SP2) {
            PG8_LDB(B0, 0, 0); PG8_LDB(B1, 0, 1); PG8_SCHED; PG8_LDA(At, 0, 0); PG8_STAGE(PG8_SA(1, 1), a1 + hstep, voffA);
            PG8_WAIT_V(8); PG8_WAIT_L(0); PG8_BAR; PG8_MMA(0, 0, At, B0); PG8_MMA(0, 1, At, B1); PG8_BAR; PG8_SCHED;
            PG8_LDA(At, 0, 1); PG8_STAGE(PG8_SB(0, 0), b2, voffB); PG8_STAGE(PG8_SB(0, 1), b2 + hstep, voffB); PG8_STAGE(PG8_SA(0, 0), a2, voffA);
            PG8_WAIT_V(8); PG8_WAIT_L(0); PG8_BAR; PG8_MMA(1, 0, At, B0); PG8_MMA(1, 1, At, B1); PG8_BAR; PG8_SCHED;
            PG8_LDB(B0, 1, 0); PG8_LDB(B1, 1, 1); PG8_SCHED; PG8_LDA(At, 1, 0); PG8_STAGE(PG8_SA(0, 1), a2 + hstep, voffA);
            PG8_WAIT_V(8); PG8_WAIT_L(0); PG8_BAR; PG8_MMA(0, 0, At, B0); PG8_MMA(0, 1, At, B1); PG8_BAR; PG8_SCHED;
            PG8_LDA(At, 1, 1); PG8_STAGE(PG8_SB(1, 0), b3, voffB); PG8_STAGE(PG8_SB(1, 1), b3 + hstep, voffB); PG8_STAGE(PG8_SA(1, 0), a3, voffA);
            PG8_WAIT_V(8); PG8_WAIT_L(0); PG8_BAR; PG8_MMA(1, 0, At, B0); PG8_MMA(1, 1, At, B1); PG8_BAR; PG8_SCHED;
            } else {
            PG8_LDB(B0, 0, 0); PG8_SCHED; PG8_LDA(At, 0, 0); PG8_STAGE(PG8_SA(1, 1), a1 + hstep, voffA);
            PG8_WAIT_L(8); PG8_BAR; PG8_WAIT_L(0); PG8_MMA(0, 0, At, B0); PG8_BAR; PG8_SCHED;
            PG8_LDB(B1, 0, 1); PG8_STAGE(PG8_SB(0, 0), b2, voffB);
            PG8_BAR; PG8_WAIT_L(0); PG8_MMA(0, 1, At, B1); PG8_BAR;
            PG8_LDA(At, 0, 1); PG8_STAGE(PG8_SA(0, 0), a2, voffA);
            PG8_BAR; PG8_WAIT_L(0); PG8_MMA(1, 0, At, B0); PG8_BAR; PG8_SCHED;
            PG8_STAGE(PG8_SB(0, 1), b2 + hstep, voffB);
            PG8_WAIT_V(6); PG8_BAR; PG8_MMA(1, 1, At, B1); PG8_BAR;
            PG8_LDB(B0, 1, 0); PG8_SCHED; PG8_LDA(At, 1, 0); PG8_STAGE(PG8_SA(0, 1), a2 + hstep, voffA);
            PG8_WAIT_L(8); PG8_BAR; PG8_WAIT_L(0); PG8_MMA(0, 0, At, B0); PG8_BAR; PG8_SCHED;
            PG8_LDB(B1, 1, 1); PG8_STAGE(PG8_SB(1, 0), b3, voffB);
            PG8_BAR; PG8_WAIT_L(0); PG8_MMA(0, 1, At, B1); PG8_BAR;
            PG8_LDA(At, 1, 1); PG8_STAGE(PG8_SA(1, 0), a3, voffA);
            PG8_BAR; PG8_WAIT_L(0); PG8_MMA(1, 0, At, B0); PG8_BAR; PG8_SCHED;
            PG8_STAGE(PG8_SB(1, 1), b3 + hstep, voffB);
            PG8_WAIT_V(6); PG8_BAR; PG8_MMA(1, 1, At, B1); PG8_BAR;
            }
        }
        if constexpr (ALIGN_EPI) { if (wr == 0) PG8_BAR; }
        if constexpr (!Epi::AFTER_DRAIN) { E(acc, cur, wr, wc, fr, fq); S.done(cur); }
        if (!has_next) break;
#pragma unroll
        for (int a = 0; a < 2; ++a)
#pragma unroll
            for (int b = 0; b < 2; ++b)
#pragma unroll
                for (int m = 0; m < 4; ++m)
#pragma unroll
                    for (int n = 0; n < 2; ++n) acc[a][b][m][n] = (f32x4){0.f, 0.f, 0.f, 0.f};
        cur = nxt; cA = nA; cB = nB; ++ui;
        if constexpr (ALIGN_EPI) { if (wr == 1) PG8_BAR; }
    }
    PG8_WAIT_V(0);
    if constexpr (!ALIGN_EPI) { if (wr == 0) PG8_BAR; }
    PG8_BAR;
    if constexpr (Epi::AFTER_DRAIN) { E.fused(acc, cur, wr, wc, fr, fq, lds, wid, lane); S.done(cur); }
#undef PG8_SA
#undef PG8_SB
#undef PG8_STAGE
#undef PG8_LDA
#undef PG8_LDB
#undef PG8_MMA
#undef PG8_WAIT_V
#undef PG8_WAIT_L
#undef PG8_BAR
#undef PG8_SCHED
}

struct UnitG { const char* A; const char* B; unsigned ao[2][2]; int pn, e, rt, cnt, row0; };
template <class Epi, class Sched>
__device__ __forceinline__ void gemm_phase_g(PG8_LAS unsigned char* lds, const int K, const Sched& S, const Epi& E) {
    const int tid = opaque_tid(), wid = __builtin_amdgcn_readfirstlane(tid >> 6), lane = tid & 63, wr = wid >> 2, wc = wid & 3, fr = lane & 15, fq = lane >> 4;
    const int nt = K / BK;
    unsigned voffB[2];
#pragma unroll
    for (int i = 0; i < 2; ++i) { int R, C; stage_rc(tid * 16 + i * 8192, R, C); const int Rb = Epi::PERM ? ((R & ~31) + perm32(R & 31)) : R; voffB[i] = (unsigned)(Rb * K + C) * 2u; }
    const size_t kstep = (size_t)(BK * 2);
    const size_t hstepB = (size_t)HALF * K * 2;
    const unsigned ldsw = (unsigned)wid * 1024u;
    const int aoff = lds_byte(wr * 64 + fr, fq * 8), boff = lds_byte(wc * 32 + fr, fq * 8);
#define PG8_SA(b, h) (((b) * 2 + (h)) * HTB)
#define PG8_SB(b, h) ((4 + (b) * 2 + (h)) * HTB)
#define PG8_STAGE(bufoff, gbase, voff) do { _Pragma("unroll") for (int _i = 0; _i < 2; ++_i) \
        __builtin_amdgcn_global_load_lds((const unsigned*)((const char*)(gbase) + (voff)[_i]), (PG8_LAS unsigned*)(lds + (bufoff) + ldsw + _i * 8192), 16, 0, 0); } while (0)
#define PG8_LDA(dst, b, h) do { _Pragma("unroll") for (int m = 0; m < 4; ++m) _Pragma("unroll") for (int k = 0; k < 2; ++k) dst[m][k] = *(const PG8_LAS bf16x8*)(lds + PG8_SA(b, h) + aoff + m * 2048 + k * 1024); } while (0)
#define PG8_LDB(dst, b, h) do { _Pragma("unroll") for (int n = 0; n < 2; ++n) _Pragma("unroll") for (int k = 0; k < 2; ++k) dst[n][k] = *(const PG8_LAS bf16x8*)(lds + PG8_SB(b, h) + boff + n * 2048 + k * 1024); } while (0)
#define PG8_MMA(ai, bj, At, Bt) do { __builtin_amdgcn_s_setprio(1); _Pragma("unroll") for (int m = 0; m < 4; ++m) _Pragma("unroll") for (int n = 0; n < 2; ++n) _Pragma("unroll") for (int k = 0; k < 2; ++k) \
        acc[ai][bj][m][n] = __builtin_amdgcn_mfma_f32_16x16x32_bf16(Bt[n][k], At[m][k], acc[ai][bj][m][n], 0, 0, 0); __builtin_amdgcn_s_setprio(0); } while (0)
#define PG8_WAIT_V(n) asm volatile("s_waitcnt vmcnt(" #n ")" ::: "memory")
#define PG8_WAIT_L(n) asm volatile("s_waitcnt lgkmcnt(" #n ")" ::: "memory")
#define PG8_BAR __builtin_amdgcn_s_barrier()
#define PG8_SCHED __builtin_amdgcn_sched_barrier(0)
    UnitG cur, nxt; int ui = 0;
    if (!S.next(0, cur)) return;
    f32x4 acc[2][2][4][2];
#pragma unroll
    for (int a = 0; a < 2; ++a)
#pragma unroll
        for (int b = 0; b < 2; ++b)
#pragma unroll
            for (int m = 0; m < 4; ++m)
#pragma unroll
                for (int n = 0; n < 2; ++n) acc[a][b][m][n] = (f32x4){0.f, 0.f, 0.f, 0.f};
    bf16x8 At[4][2], B0[2][2], B1[2][2];
    const char* cA = cur.A; const char* cB = cur.B;
    PG8_STAGE(PG8_SB(0, 0), cB, voffB); PG8_STAGE(PG8_SB(0, 1), cB + hstepB, voffB); PG8_STAGE(PG8_SA(0, 0), cA, cur.ao[0]); PG8_STAGE(PG8_SA(0, 1), cA, cur.ao[1]);
    if (wr == 1) PG8_BAR;
    PG8_WAIT_V(2); PG8_BAR;
    PG8_STAGE(PG8_SB(1, 0), cB + kstep, voffB); PG8_STAGE(PG8_SA(1, 0), cA + kstep, cur.ao[0]); PG8_STAGE(PG8_SB(1, 1), cB + hstepB + kstep, voffB);
    PG8_WAIT_V(6); PG8_BAR;
    for (;;) {
        const bool has_next = S.next(ui + 1, nxt);
        if (!has_next) nxt = cur;
        const char* nA = nxt.A; const char* nB = nxt.B;
        for (int t = 0; t < nt; t += 2) {
            const bool last = (t == nt - 2);
            const char* a1 = cA + (size_t)(t + 1) * kstep;
            const char* a2 = last ? nA : cA + (size_t)(t + 2) * kstep; const char* b2 = last ? nB : cB + (size_t)(t + 2) * kstep;
            const char* a3 = a2 + kstep; const char* b3 = b2 + kstep;
            unsigned x0[2], x1[2];
#pragma unroll
            for (int i = 0; i < 2; ++i) { x0[i] = last ? nxt.ao[0][i] : cur.ao[0][i]; x1[i] = last ? nxt.ao[1][i] : cur.ao[1][i]; }
            PG8_LDB(B0, 0, 0); PG8_LDB(B1, 0, 1); PG8_SCHED; PG8_LDA(At, 0, 0); PG8_STAGE(PG8_SA(1, 1), a1, cur.ao[1]);
            PG8_WAIT_V(8); PG8_WAIT_L(0); PG8_BAR; PG8_MMA(0, 0, At, B0); PG8_MMA(0, 1, At, B1); PG8_BAR; PG8_SCHED;
            PG8_LDA(At, 0, 1); PG8_STAGE(PG8_SB(0, 0), b2, voffB); PG8_STAGE(PG8_SB(0, 1), b2 + hstepB, voffB); PG8_STAGE(PG8_SA(0, 0), a2, x0);
            PG8_WAIT_V(8); PG8_WAIT_L(0); PG8_BAR; PG8_MMA(1, 0, At, B0); PG8_MMA(1, 1, At, B1); PG8_BAR; PG8_SCHED;
            PG8_LDB(B0, 1, 0); PG8_LDB(B1, 1, 1); PG8_SCHED; PG8_LDA(At, 1, 0); PG8_STAGE(PG8_SA(0, 1), a2, x1);
            PG8_WAIT_V(8); PG8_WAIT_L(0); PG8_BAR; PG8_MMA(0, 0, At, B0); PG8_MMA(0, 1, At, B1); PG8_BAR; PG8_SCHED;
            PG8_LDA(At, 1, 1); PG8_STAGE(PG8_SB(1, 0), b3, voffB); PG8_STAGE(PG8_SB(1, 1), b3 + hstepB, voffB); PG8_STAGE(PG8_SA(1, 0), a3, x0);
            PG8_WAIT_V(8); PG8_WAIT_L(0); PG8_BAR; PG8_MMA(1, 0, At, B0); PG8_MMA(1, 1, At, B1); PG8_BAR; PG8_SCHED;
        }
        if (wr == 0) PG8_BAR;
        E(acc, cur, wr, wc, fr, fq);
        if (!has_next) break;
#pragma unroll
        for (int a = 0; a < 2; ++a)
#pragma unroll
            for (int b = 0; b < 2; ++b)
#pragma unroll
                for (int m = 0; m < 4; ++m)
#pragma unroll
                    for (int n = 0; n < 2; ++n) acc[a][b][m][n] = (f32x4){0.f, 0.f, 0.f, 0.f};
        cur = nxt; cA = nA; cB = nB; ++ui;
        if (wr == 1) PG8_BAR;
    }
    PG8_WAIT_V(0);
    PG8_BAR;
#undef PG8_SA
#undef PG8_SB
#undef PG8_STAGE
#undef PG8_LDA
#undef PG8_LDB
#undef PG8_MMA
#undef PG8_WAIT_V
#undef PG8_WAIT_L
#undef PG8_BAR
#undef PG8_SCHED
}
}


struct Args {
    const float* in[32];
    float* out;
    unsigned char* ws;
};
struct Ctx { const LAS unsigned long long* tab; float* out; unsigned char* ws; };
DI const float* inptr(const LAS unsigned long long* tab, int i) {
    const unsigned long long v = tab[i];
    const unsigned lo = __builtin_amdgcn_readfirstlane((unsigned)v), hi = __builtin_amdgcn_readfirstlane((unsigned)(v >> 32));
    return (const float*)(((unsigned long long)hi << 32) | lo);
}
#define AIN(i) inptr(a.tab, (i))
enum {
    I_X = 0, I_MEM, I_MIXN, I_WIN, I_QN, I_KCN, I_KSN, I_KWN, I_POSK, I_POSV, I_CKW1, I_CKW2, I_CVW1, I_CVW2,
    I_NSAON, I_RETON, I_WOUT, I_MXN, I_MKVN, I_MWQ, I_MWKV, I_MQN, I_MKN, I_MWO, I_FFN, I_RGW, I_RGB, I_REW, I_REB,
    I_EWG, I_EWU, I_EWD
};

#ifndef OPT_PROJ
#define OPT_PROJ 1
#endif
#ifndef OPT_MEMATTN
#define OPT_MEMATTN 1
#endif
#ifndef OPT_TAIL
#define OPT_TAIL 1
#endif
constexpr int LDS_BYTES = 147456;
constexpr int LDS_MISC = 147456 - 256;
constexpr int LDS_PTAB = 147456 - 1024;


typedef unsigned v4u __attribute__((ext_vector_type(4)));
typedef float f32x4v __attribute__((ext_vector_type(4)));
DI unsigned pk2(float lo, float hi) { return (unsigned)f2bf(lo) | ((unsigned)f2bf(hi) << 16); }
constexpr int NPROJ = 3584;
DI void transpose_item(const float* W, int ldw, int k0, int srcc0, int nvalid, bf16_t* WT, int K, int row0, LAS float* scr, int lane, const float* ksc = nullptr) {
    const int n = lane & 31;
#pragma unroll 8
    for (int i = 0; i < 32; ++i) { const int kk = 2 * i + (lane >> 5); float v = (n < nvalid) ? W[(size_t)(k0 + kk) * ldw + srcc0 + n] : 0.f; if (ksc) v *= ksc[k0 + kk]; scr[kk * 33 + n] = v; }
    asm volatile("s_waitcnt lgkmcnt(0)" ::: "memory");
    const int c = lane & 7;
#pragma unroll
    for (int j = 0; j < 4; ++j) { const int nn = (lane >> 3) + 8 * j; const LAS float* sp = scr + (8 * c) * 33 + nn;
        v4u o; o.x = pk2(sp[0 * 33], sp[1 * 33]); o.y = pk2(sp[2 * 33], sp[3 * 33]); o.z = pk2(sp[4 * 33], sp[5 * 33]); o.w = pk2(sp[6 * 33], sp[7 * 33]);
        *(v4u*)(WT + (size_t)(row0 + nn) * K + k0 + 8 * c) = o; }
    asm volatile("s_waitcnt lgkmcnt(0)" ::: "memory");
}
DI int proj_src(int vh, int d0, int& srcc0) {
    if (vh < 8) { srcc0 = vh * 64 + d0; return 32; }
    if (vh < 20) { srcc0 = 512 + (vh - 8) * 64 + d0; return 32; }
    if (vh < 52) { srcc0 = 1304 + (vh - 20) * 64 + d0; return 32; }
    if (vh == 52 && d0 == 0) { srcc0 = 1280; return 24; }
    srcc0 = 0; return 0;
}
typedef float f32x2t __attribute__((ext_vector_type(2))); typedef __bf16 bf16x2t __attribute__((ext_vector_type(2)));
DI unsigned cvtpk(float lo, float hi) { f32x2t v = {lo, hi}; bf16x2t b = __builtin_convertvector(v, bf16x2t); return __builtin_bit_cast(unsigned, b); }
template <class RowMap>
DI void conv_tile(const float* W, int ldw, int k0, int c0, int nvalid, bf16_t* WT, int K, const RowMap& rm, const float* ksc, int lane) {
    const int nq = lane & 15, kg = lane >> 4;
    f32x4v v[2][8];
    const bool ok = 4 * nq < nvalid;
#pragma unroll
    for (int h = 0; h < 2; ++h)
#pragma unroll
        for (int j = 0; j < 8; ++j) v[h][j] = ok ? *(const f32x4v*)(W + (size_t)(k0 + 32 * h + 8 * kg + j) * ldw + c0 + 4 * nq) : (f32x4v){0.f, 0.f, 0.f, 0.f};
    if (ksc) {
#pragma unroll
        for (int h = 0; h < 2; ++h) { const f32x4v s0 = *(const f32x4v*)(ksc + k0 + 32 * h + 8 * kg), s1 = *(const f32x4v*)(ksc + k0 + 32 * h + 8 * kg + 4);
            v[h][0] *= s0.x; v[h][1] *= s0.y; v[h][2] *= s0.z; v[h][3] *= s0.w; v[h][4] *= s1.x; v[h][5] *= s1.y; v[h][6] *= s1.z; v[h][7] *= s1.w; }
    }
    if (ok) {
#pragma unroll
        for (int i = 0; i < 4; ++i) { const int row = rm(c0 + 4 * nq + i);
#pragma unroll
            for (int h = 0; h < 2; ++h) { v4u w; w.x = cvtpk(v[h][0][i], v[h][1][i]); w.y = cvtpk(v[h][2][i], v[h][3][i]); w.z = cvtpk(v[h][4][i], v[h][5][i]); w.w = cvtpk(v[h][6][i], v[h][7][i]);
                *(v4u*)(WT + (size_t)row * K + k0 + 32 * h + 8 * kg) = w; } }
    }
}
struct RmId { DI int operator()(int c) const { return c; } };
struct RmWin {
    DI int operator()(int c) const { int vh, d;
        if (c < 1280) { vh = c >> 6; d = c & 63; } else if (c < 1304) { vh = 52; d = c - 1280; } else { vh = 20 + ((c - 1304) >> 6); d = (c - 1304) & 63; }
        return 256 * (vh >> 2) + 128 * (d >> 5) + 32 * (vh & 3) + (d & 31); }
};
struct RmKv { DI int operator()(int c) const { const int d = c & 63; return 256 * (c >> 8) + 128 * (d >> 5) + 32 * ((c >> 6) & 3) + (d & 31); } };
struct RmGu { int mat; DI int operator()(int c) const { return 256 * (c >> 7) + 128 * mat + (c & 127); } };
typedef __bf16 bf16x2t_ __attribute__((ext_vector_type(2)));
DI void phase_prologue(const Ctx& a, unsigned char* lds_raw) {
    const int tid = opaque_tid(), lane = tid & 63, wv = __builtin_amdgcn_readfirstlane(tid >> 6);
    const int gw = blockIdx.x * NWAVE + wv, NGW = gridDim.x * NWAVE;
    const float* ffn = AIN(I_FFN);
    constexpr int N_GU = NEXP * 2 * 16 * 4, N_D = NEXP * 4 * 16, N_IN = 16 * 53, N_OUT = 16 * 16, N_Q = 16 * 4, N_O = 4 * 16, N_KV = 16 * 8, N_C1 = 2 * 32 * 2, N_C2 = 2 * 2;
    constexpr int N_ALL = N_GU + N_D + N_IN + N_OUT + N_Q + N_O + N_KV + N_C1 + N_C2;
    for (int it0 = gw; it0 < N_ALL; it0 += NGW) {
        int it = it0;
        if (it < N_GU) { const int e = it >> 7, mat = (it >> 6) & 1, kb = (it >> 2) & 15, ct = it & 3;
            conv_tile(AIN(mat ? I_EWU : I_EWG) + (size_t)e * 1024 * 256, 256, kb * 64, ct * 64, 64, (bf16_t*)(a.ws + WS_WGU_T) + (size_t)e * 512 * 1024, 1024, RmGu{mat}, ffn, lane); continue; }
        it -= N_GU;
        if (it < N_D) { const int e = it >> 6, kb = (it >> 4) & 3, ct = it & 15;
            conv_tile(AIN(I_EWD) + (size_t)e * 256 * 1024, 1024, kb * 64, ct * 64, 64, (bf16_t*)(a.ws + WS_WD_T) + (size_t)e * 1024 * 256, 256, RmId{}, nullptr, lane); continue; }
        it -= N_D;
        if (it < N_IN) { const int kb = it / 53, ct = it % 53; const int c0 = ct < 20 ? ct * 64 : (ct == 20 ? 1280 : 1304 + (ct - 21) * 64);
            conv_tile(AIN(I_WIN), PROJ, kb * 64, c0, ct == 20 ? 24 : 64, (bf16_t*)(a.ws + WS_WIN_T), 1024, RmWin{}, nullptr, lane); continue; }
        it -= N_IN;
        if (it < N_OUT) { conv_tile(AIN(I_WOUT), 1024, (it >> 4) * 64, (it & 15) * 64, 64, (bf16_t*)(a.ws + WS_WOUT_T), 1024, RmId{}, nullptr, lane); continue; }
        it -= N_OUT;
        if (it < N_Q) { conv_tile(AIN(I_MWQ), 256, (it >> 2) * 64, (it & 3) * 64, 64, (bf16_t*)(a.ws + WS_WQ_T), 1024, RmId{}, AIN(I_MXN), lane); continue; }
        it -= N_Q;
        if (it < N_O) { conv_tile(AIN(I_MWO), 1024, (it >> 4) * 64, (it & 15) * 64, 64, (bf16_t*)(a.ws + WS_WO_T), 256, RmId{}, nullptr, lane); continue; }
        it -= N_O;
        if (it < N_KV) { conv_tile(AIN(I_MWKV), 512, (it >> 3) * 64, (it & 7) * 64, 64, (bf16_t*)(a.ws + WS_WKV_T), 1024, RmKv{}, nullptr, lane); continue; }
        it -= N_KV;
        if (it < N_C1) { const int kv = it >> 6, kb = (it >> 1) & 31, ct = it & 1;
            conv_tile(AIN(kv ? I_CVW1 : I_CKW1), 128, kb * 64, ct * 64, 64, (bf16_t*)(a.ws + WS_W1K_T) + (size_t)kv * 128 * 2048, 2048, RmId{}, nullptr, lane); continue; }
        it -= N_C1;
        { const int kv = it >> 1, kb = it & 1; conv_tile(AIN(kv ? I_CVW2 : I_CKW2), 64, kb * 64, 0, 64, (bf16_t*)(a.ws + WS_W2K_T) + (size_t)kv * 64 * 128, 128, RmId{}, nullptr, lane); }
    }
    for (int j = gw; j < 256; j += NGW) { const int kv = j >> 7, jj = j & 127; const float* w1 = AIN(kv ? I_CVW1 : I_CKW1); const float* pos = AIN(kv ? I_POSV : I_POSK);
        float acc = 0.f; for (int f = lane; f < 2048; f += 64) acc += pos[f] * w1[(size_t)f * 128 + jj]; acc = wave_sum(acc); if (lane == 0) ((float*)(a.ws + WS_PB))[j] = acc; }
    { bf16_t* WH = (bf16_t*)(a.ws + WS_WR_HI); bf16_t* WL = (bf16_t*)(a.ws + WS_WR_LO); const float* rgw = AIN(I_RGW); const float* rew = AIN(I_REW);
      for (int i = blockIdx.x * NTHR + tid; i < 48 * 1024; i += gridDim.x * NTHR) { const int n = i >> 10, d = i & 1023; float v = 0.f;
          if (n < 4) v = rgw[d * 4 + n]; else if (n < 36) v = rew[((size_t)((n - 4) >> 3) * 1024 + d) * 8 + ((n - 4) & 7)];
          v *= ffn[d]; const unsigned short hi = f2bf(v); WH[i] = hi; WL[i] = f2bf(v - bf2f(hi)); } }
    { float* rope = (float*)(a.ws + WS_ROPE);
      for (int i = blockIdx.x * NTHR + tid; i < NS * 32; i += gridDim.x * NTHR) {
        const int s = i >> 5, k = i & 31; const float inv = exp2f(-(float)k * (13.287712379549449f / 32.f));
        float sn, cs; sincosf((float)s * inv, &sn, &cs); rope[i] = cs; rope[NS * 32 + i] = sn; } }
    for (int m0 = 2 * gw; m0 < NT + NB * NMEM; m0 += 2 * NGW) {
        const bool isx = m0 < NT; const int m = isx ? m0 : m0 - NT;
        const float* src = isx ? AIN(I_X) : AIN(I_MEM); const f32x4v* gr = (const f32x4v*)(isx ? AIN(I_MIXN) : AIN(I_MKVN)) + lane;
        bf16_t* dst = (bf16_t*)(a.ws + (isx ? WS_XN : WS_HM));
        f32x4v v[2][4]; float ss[2] = {0.f, 0.f};
#pragma unroll
        for (int q = 0; q < 2; ++q)
#pragma unroll
            for (int j = 0; j < 4; ++j) v[q][j] = ((const f32x4v*)(src + (size_t)(m + q) * DM) + lane)[64 * j];
#pragma unroll
        for (int q = 0; q < 2; ++q)
#pragma unroll
            for (int j = 0; j < 4; ++j) ss[q] += (v[q][j].x * v[q][j].x + v[q][j].y * v[q][j].y) + (v[q][j].z * v[q][j].z + v[q][j].w * v[q][j].w);
#pragma unroll
        for (int q = 0; q < 2; ++q) { const float rstd = rsqrtf(wave_sum(ss[q]) * (1.f / DM) + EPS);
            unsigned long long* o8 = (unsigned long long*)(dst + (size_t)(m + q) * DM) + lane;
#pragma unroll
            for (int j = 0; j < 4; ++j) { const f32x4v g = gr[64 * j]; o8[64 * j] = (unsigned long long)cvtpk(v[q][j].x * rstd * g.x, v[q][j].y * rstd * g.y) | ((unsigned long long)cvtpk(v[q][j].z * rstd * g.z, v[q][j].w * rstd * g.w) << 32); } }
    }
}

struct EpiProj {
    static constexpr bool PERM = true, AFTER_DRAIN = false;
    bf16_t* Q; bf16_t* KV; bf16_t* RET; float* GATES; const float* qn; const float* ksn; const float* kwn; const float* rope;
    DI void operator()(const pg8::f32x4 (&acc)[2][2][4][2], const pg8::Unit& u, int wr, int wc, int fr, int fq) const {
        const int vh = u.pn * 4 + wc;
        if (vh > 52) return;
        const int b = u.pm >> 3, s0 = (u.pm & 7) * 256;
        int kind = 0; const float* gain = nullptr; float scale = 1.f; bf16_t* hb = nullptr; int rstride = 64;
        if (vh < 8) { kind = 1; gain = qn; scale = 0.125f; hb = Q + (size_t)(u.pm * 256) * 512 + vh * 64; rstride = 512; }
        else if (vh < 20) { const int i = (vh - 8) >> 1, g = (vh - 8) & 1; hb = KV + (size_t)i * KV_STRIDE + ((size_t)(b * NG + g) * NS + s0) * DH;
            if (i == 2) { kind = 1; gain = ksn; } else if (i == 4) { kind = 1; gain = kwn; } }
        else if (vh < 52) { const int rr = (vh - 20) >> 3, h = (vh - 20) & 7; hb = RET + (size_t)rr * RET_STRIDE + ((size_t)(b * NHR + h) * NS + s0) * DH;
            if (rr < 2) { kind = 2; scale = (rr == 1) ? 0.125f : 1.f; } }
        else kind = 3;
        float g[2][8];
#pragma unroll
        for (int bj = 0; bj < 2; ++bj)
#pragma unroll
            for (int j = 0; j < 8; ++j) g[bj][j] = (kind == 1) ? gain[32 * bj + 8 * fq + j] : 1.f;
#pragma unroll
        for (int ai = 0; ai < 2; ++ai)
#pragma unroll
            for (int m = 0; m < 4; ++m) {
                const int rl = ai * 128 + wr * 64 + m * 16 + fr;
                float v[2][8];
#pragma unroll
                for (int bj = 0; bj < 2; ++bj)
#pragma unroll
                    for (int n = 0; n < 2; ++n)
#pragma unroll
                        for (int i = 0; i < 4; ++i) v[bj][4 * n + i] = acc[ai][bj][m][n][i];
                if (kind == 1) {
                    float ss = 0.f;
#pragma unroll
                    for (int bj = 0; bj < 2; ++bj)
#pragma unroll
                        for (int j = 0; j < 8; ++j) ss += v[bj][j] * v[bj][j];
                    ss += __shfl_xor(ss, 16); ss += __shfl_xor(ss, 32);
                    const float r = rsqrtf(ss * (1.f / 64.f) + EPS) * scale;
#pragma unroll
                    for (int bj = 0; bj < 2; ++bj)
#pragma unroll
                        for (int j = 0; j < 8; ++j) v[bj][j] = v[bj][j] * r * g[bj][j];
                } else if (kind == 2) {
                    const f32x4v* cp = (const f32x4v*)(rope + (size_t)(s0 + rl) * 32 + 8 * fq); const f32x4v* sp = (const f32x4v*)(rope + NS * 32 + (size_t)(s0 + rl) * 32 + 8 * fq);
                    const f32x4v c0 = cp[0], c1 = cp[1], n0 = sp[0], n1 = sp[1];
                    const float cs[8] = {c0.x, c0.y, c0.z, c0.w, c1.x, c1.y, c1.z, c1.w}; const float sn[8] = {n0.x, n0.y, n0.z, n0.w, n1.x, n1.y, n1.z, n1.w};
#pragma unroll
                    for (int j = 0; j < 8; ++j) { const float x1 = v[0][j], x2 = v[1][j]; v[0][j] = (x1 * cs[j] - x2 * sn[j]) * scale; v[1][j] = (x1 * sn[j] + x2 * cs[j]) * scale; }
                }
                if (kind == 3) {
                    if (fq < 3) { float* gp = GATES + (size_t)(u.pm * 256 + rl) * 24 + 8 * fq;
                        *(f32x4v*)gp = (f32x4v){v[0][0], v[0][1], v[0][2], v[0][3]}; *(f32x4v*)(gp + 4) = (f32x4v){v[0][4], v[0][5], v[0][6], v[0][7]}; }
                } else {
                    bf16_t* rp = hb + (size_t)rl * rstride + 8 * fq;
#pragma unroll
                    for (int bj = 0; bj < 2; ++bj) { v4u w; w.x = cvtpk(v[bj][0], v[bj][1]); w.y = cvtpk(v[bj][2], v[bj][3]); w.z = cvtpk(v[bj][4], v[bj][5]); w.w = cvtpk(v[bj][6], v[bj][7]);
                        *(v4u*)(rp + 32 * bj) = w; }
                }
            }
    }
};
DI void phase_proj_mfma(const Ctx& a, unsigned char* lds_raw) {
    pg8::Gemm g{(const bf16_t*)(a.ws + WS_XN), (const bf16_t*)(a.ws + WS_WIN_T), NT, NPROJ, DM};
    pg8::StaticOrder S; S.init(NT, NPROJ, (int)gridDim.x, (int)blockIdx.x);
    EpiProj E{(bf16_t*)(a.ws + WS_Q), (bf16_t*)(a.ws + WS_KV), (bf16_t*)(a.ws + WS_RET), (float*)(a.ws + WS_GATES), AIN(I_QN), AIN(I_KSN), AIN(I_KWN), (const float*)(a.ws + WS_ROPE)};
    pg8::gemm_phase<EpiProj, pg8::StaticOrder, true, true>((PG8_LAS unsigned char*)lds_raw, g, S, E);
}

DI void phase_proj(const Ctx& a, float* lds) {
    const int tid = opaque_tid(), lane = tid & 63, wv = tid >> 6;
    float* xs = lds;
    float* pr = lds + 4 * 1024;
    const float* x = AIN(I_X); const float* w_in = AIN(I_WIN); const float* mixn = AIN(I_MIXN);
    bf16_t* Q = (bf16_t*)(a.ws + WS_Q); bf16_t* KV = (bf16_t*)(a.ws + WS_KV); bf16_t* RET = (bf16_t*)(a.ws + WS_RET);
    float* GATES = (float*)(a.ws + WS_GATES);
    for (int tg = blockIdx.x; tg < NT / 4; tg += gridDim.x) {
        __syncthreads();
        if (wv < 4) {
            const float* xr = x + (size_t)(tg * 4 + wv) * DM;
            float v[16]; float ss = 0.f;
#pragma unroll
            for (int i = 0; i < 16; ++i) { v[i] = xr[lane + 64 * i]; ss += v[i] * v[i]; }
            ss = wave_sum(ss);
            const float rstd = rsqrtf(ss * (1.f / DM) + EPS);
#pragma unroll
            for (int i = 0; i < 16; ++i) xs[wv * 1024 + lane + 64 * i] = v[i] * rstd * mixn[lane + 64 * i];
        }
        __syncthreads();
        float acc[7][4];
#pragma unroll
        for (int i = 0; i < 7; ++i)
#pragma unroll
            for (int k = 0; k < 4; ++k) acc[i][k] = 0.f;
        for (int d = 0; d < DM; d += 2) {
            float w0[7], w1[7];
#pragma unroll
            for (int i = 0; i < 7; ++i) { const int c = tid + 512 * i; w0[i] = (c < PROJ) ? w_in[(size_t)d * PROJ + c] : 0.f; w1[i] = (c < PROJ) ? w_in[(size_t)(d + 1) * PROJ + c] : 0.f; }
            float xa[4], xb[4];
#pragma unroll
            for (int k = 0; k < 4; ++k) { xa[k] = xs[k * 1024 + d]; xb[k] = xs[k * 1024 + d + 1]; }
#pragma unroll
            for (int i = 0; i < 7; ++i)
#pragma unroll
                for (int k = 0; k < 4; ++k) { acc[i][k] += xa[k] * w0[i]; acc[i][k] += xb[k] * w1[i]; }
        }
#pragma unroll
        for (int i = 0; i < 7; ++i) { const int c = tid + 512 * i; if (c < PROJ) {
#pragma unroll
            for (int k = 0; k < 4; ++k) pr[k * PROJ + c] = acc[i][k]; } }
        __syncthreads();
        if (tid < 208) {
            const int k = tid / 52, v = tid % 52; const int t = tg * 4 + k, b = t / NS, s = t % NS;
            const float* p = pr + k * PROJ;
            if (v < 8) {
                const float* src = p + v * 64; float ss = 0.f;
                for (int d = 0; d < 64; ++d) ss += src[d] * src[d];
                const float rstd = rsqrtf(ss * (1.f / 64.f) + EPS) * 0.125f;
                bf16_t* dst = Q + (size_t)t * 512 + v * 64;
                for (int d = 0; d < 64; ++d) dst[d] = f2bf(src[d] * rstd * AIN(I_QN)[d]);
            } else if (v < 20) {
                const int i = (v - 8) >> 1, g = (v - 8) & 1;
                const float* src = p + 512 + i * 128 + g * 64;
                bf16_t* dst = KV + (size_t)i * KV_STRIDE + ((size_t)(b * NG + g) * NS + s) * DH;
                if (i == 2 || i == 4) {
                    const float* gn = (i == 2) ? AIN(I_KSN) : AIN(I_KWN); float ss = 0.f;
                    for (int d = 0; d < 64; ++d) ss += src[d] * src[d];
                    const float rstd = rsqrtf(ss * (1.f / 64.f) + EPS);
                    for (int d = 0; d < 64; ++d) dst[d] = f2bf(src[d] * rstd * gn[d]);
                } else {
                    for (int d = 0; d < 64; ++d) dst[d] = f2bf(src[d]);
                }
            } else {
                const int rr = (v - 20) >> 3, h = (v - 20) & 7;
                const float* src = p + 1304 + rr * 512 + h * 64;
                bf16_t* dst = RET + (size_t)rr * RET_STRIDE + ((size_t)(b * NHR + h) * NS + s) * DH;
                if (rr < 2) {
                    const float sc = (rr == 1) ? 0.125f : 1.f;
                    for (int i2 = 0; i2 < 32; ++i2) {
                        const float inv = exp2f(-(float)i2 * (13.287712379549449f / 32.f));
                        float sn, cs; sincosf((float)s * inv, &sn, &cs);
                        const float x1 = src[i2], x2 = src[i2 + 32];
                        dst[i2] = f2bf((x1 * cs - x2 * sn) * sc); dst[i2 + 32] = f2bf((x1 * sn + x2 * cs) * sc);
                    }
                } else {
                    for (int d = 0; d < 64; ++d) dst[d] = f2bf(src[d]);
                }
            }
        } else if (tid >= 256 && tid < 256 + 96) {
            const int k = (tid - 256) / 24, j = (tid - 256) % 24; const int t = tg * 4 + k;
            GATES[(size_t)t * 24 + j] = pr[k * PROJ + 1280 + j];
        }
    }
}

DI void phase_memkv(const Ctx& a, float* lds) {
    const int tid = opaque_tid(), lane = tid & 63, wv = tid >> 6;
    float* hm = lds; float* red = lds + 1024; float* kv = lds + 1100;
    const float* mem = AIN(I_MEM); const float* wkv = AIN(I_MWKV);
    bf16_t* MK = (bf16_t*)(a.ws + WS_MK); bf16_t* MV = (bf16_t*)(a.ws + WS_MV);
    for (int r = blockIdx.x; r < NB * NMEM; r += gridDim.x) {
        __syncthreads();
        const float* xr = mem + (size_t)r * DM;
        const float v0 = xr[tid], v1 = xr[tid + 512];
        float ss = wave_sum(v0 * v0 + v1 * v1);
        if (lane == 0) red[wv] = ss;
        __syncthreads();
        float tot = 0.f;
#pragma unroll
        for (int i = 0; i < 8; ++i) tot += red[i];
        const float rstd = rsqrtf(tot * (1.f / DM) + EPS);
        hm[tid] = v0 * rstd * AIN(I_MKVN)[tid]; hm[tid + 512] = v1 * rstd * AIN(I_MKVN)[tid + 512];
        __syncthreads();
        float acc = 0.f;
        for (int d = 0; d < DM; ++d) acc += hm[d] * wkv[(size_t)d * 512 + tid];
        kv[tid] = acc;
        __syncthreads();
        const int b = r / NMEM, m = r % NMEM;
        if (tid < 4) {
            const float* src = kv + tid * 64; float s2 = 0.f;
            for (int d = 0; d < 64; ++d) s2 += src[d] * src[d];
            const float rs = rsqrtf(s2 * (1.f / 64.f) + EPS);
            bf16_t* dst = MK + ((size_t)(b * MH + tid) * NMEM + m) * DH;
            for (int d = 0; d < 64; ++d) dst[d] = f2bf(src[d] * rs * AIN(I_MKN)[d]);
        } else if (tid >= 64 && tid < 68) {
            const int h = tid - 64; const float* src = kv + 256 + h * 64;
            bf16_t* dst = MV + ((size_t)(b * MH + h) * NMEM + m) * DH;
            for (int d = 0; d < 64; ++d) dst[d] = f2bf(src[d]);
            bf16_t* dt = (bf16_t*)(a.ws + WS_MVT) + (size_t)(b * MH + h) * DH * NMEM + m;
            for (int d = 0; d < 64; ++d) dt[(size_t)d * NMEM] = f2bf(src[d]);
        }
    }
}

DI void phase_compress(const Ctx& a, float* lds) {
    const int tid = opaque_tid();
    float* blk = lds;
    float* part = lds + 2048;
    float* hid = lds + 2048 + 512;
    float* outv = hid + 128;
    const bf16_t* KV = (const bf16_t*)(a.ws + WS_KV);
    bf16_t* KCMP = (bf16_t*)(a.ws + WS_KCMP); bf16_t* VCMP = (bf16_t*)(a.ws + WS_VCMP);
    const int nunit = 2 * NB * NG * 128;
    for (int u = blockIdx.x; u < nunit; u += gridDim.x) {
        const int kvsel = u / (NB * NG * 128), rem = u % (NB * NG * 128), bg = rem / 128, c = rem % 128;
        bf16_t* dst = (kvsel == 0 ? KCMP : VCMP) + ((size_t)bg * 128 + c) * DH;
        if (c == 127) { if (tid < 64) dst[tid] = 0; continue; }
        __syncthreads();
        const bf16_t* src = KV + (size_t)kvsel * KV_STRIDE + ((size_t)bg * NS + 16 * c) * DH;
        const float* pos = AIN(kvsel == 0 ? I_POSK : I_POSV);
        const float* w1 = AIN(kvsel == 0 ? I_CKW1 : I_CVW1);
        const float* w2 = AIN(kvsel == 0 ? I_CKW2 : I_CVW2);
#pragma unroll
        for (int i = 0; i < 4; ++i) { const int f = tid + 512 * i; blk[f] = bf2f(src[f]) + pos[f]; }
        __syncthreads();
        { const int j = tid & 127, pt = tid >> 7; float acc = 0.f;
          for (int f = pt * 512; f < pt * 512 + 512; ++f) acc += blk[f] * w1[(size_t)f * 128 + j];
          part[tid] = acc; }
        __syncthreads();
        if (tid < 128) { const float h = part[tid] + part[tid + 128] + part[tid + 256] + part[tid + 384]; hid[tid] = siluf(h); }
        __syncthreads();
        if (tid < 64) { float acc = 0.f; for (int j = 0; j < 128; ++j) acc += hid[j] * w2[j * 64 + tid]; outv[tid] = acc; }
        __syncthreads();
        if (tid < 64) {
            float v = outv[tid];
            if (kvsel == 0) { float ss = 0.f; for (int d = 0; d < 64; ++d) ss += outv[d] * outv[d]; v = v * rsqrtf(ss * (1.f / 64.f) + EPS) * AIN(I_KCN)[tid]; }
            dst[tid] = f2bf(v);
        }
    }
}

DI void softmax_rows4(float* sc, int ld, int n, int wv, int lane) {
    if (wv < 4) {
        float* row = sc + wv * ld; float m = -1e30f;
        for (int i = lane; i < n; i += 64) m = fmaxf(m, row[i]);
        m = wave_max(m);
        float s = 0.f;
        for (int i = lane; i < n; i += 64) { const float v = row[i]; const float e = (v > -1e29f) ? __expf(v - m) : 0.f; row[i] = e; s += e; }
        s = wave_sum(s);
        const float inv = 1.f / fmaxf(s, 1e-30f);
        for (int i = lane; i < n; i += 64) row[i] *= inv;
    }
}
DI void phase_nsa(const Ctx& a, float* lds) {
    const int tid = opaque_tid(), lane = tid & 63, wv = tid >> 6;
    float* q = lds;
    float* sc = lds + 256;
    float* psum = sc + 2048;
    float* imp = psum + 128;
    float* oacc = imp + 32;
    int* sel = (int*)(oacc + 768);
    float* ofin = (float*)(sel + 8);
    const bf16_t* Q = (const bf16_t*)(a.ws + WS_Q); const bf16_t* KV = (const bf16_t*)(a.ws + WS_KV);
    const bf16_t* KCMP = (const bf16_t*)(a.ws + WS_KCMP); const bf16_t* VCMP = (const bf16_t*)(a.ws + WS_VCMP);
    const float* GATES = (const float*)(a.ws + WS_GATES);
    bf16_t* OA = (bf16_t*)(a.ws + WS_OA);
    for (int u = blockIdx.x; u < NT * NG; u += gridDim.x) {
        const int t = u >> 1, g = u & 1, b = t / NS, s = t % NS, bg = b * NG + g;
        __syncthreads();
        if (tid < 256) q[tid] = bf2f(Q[(size_t)t * 512 + g * 256 + tid]);
        __syncthreads();
        const int ncv = (s >= 31) ? min(NCMP, (s - 31) / 16 + 1) : 0;
        { const int r = tid >> 7, c = tid & 127; float v = -1e30f;
          if (c < ncv) { const bf16_t* kr = KCMP + ((size_t)bg * 128 + c) * DH; float d = 0.f; for (int i = 0; i < 64; ++i) d += q[r * 64 + i] * bf2f(kr[i]); v = d; }
          sc[r * 512 + c] = v; }
        __syncthreads();
        softmax_rows4(sc, 512, 128, wv, lane);
        __syncthreads();
        if (tid < 128) psum[tid] = sc[tid] + sc[512 + tid] + sc[1024 + tid] + sc[1536 + tid];
        if (tid >= 256) { const int r = (tid - 256) >> 6, d = tid & 63; float acc = 0.f;
            for (int c = 0; c < ncv; ++c) acc += sc[r * 512 + c] * bf2f(VCMP[((size_t)bg * 128 + c) * DH + d]);
            oacc[r * 64 + d] = acc; }
        __syncthreads();
        const int cur = s / 64;
        if (tid < 32) { const int j = tid; float v = 0.f;
            if (4 * j - 1 >= 0) v += 0.5f * psum[4 * j - 1];
            v += psum[4 * j] + psum[4 * j + 1] + psum[4 * j + 2];
            if (4 * j + 3 < NCMP) v += 0.5f * psum[4 * j + 3];
            if (j == 0 || j == cur || j == cur - 1) v = 1e9f; else if (j > cur) v = -1e30f;
            imp[j] = v; }
        __syncthreads();
        if (tid == 0) {
            unsigned used = 0u;
            for (int k = 0; k < TOPK; ++k) { int best = -1; float bv = 0.f;
                for (int j = 0; j < NSEL; ++j) if (!((used >> j) & 1u)) { if (best < 0 || imp[j] > bv) { best = j; bv = imp[j]; } }
                used |= 1u << best; sel[k] = best; }
        }
        __syncthreads();
        { const int kk = tid >> 6, i = tid & 63; const int kpos = sel[kk] * 64 + i;
          const bf16_t* kr = KV + 2 * KV_STRIDE + ((size_t)bg * NS + kpos) * DH;
          float d0 = 0.f, d1 = 0.f, d2 = 0.f, d3 = 0.f;
          if (kpos <= s) { for (int e = 0; e < 64; ++e) { const float kvv = bf2f(kr[e]); d0 += q[e] * kvv; d1 += q[64 + e] * kvv; d2 += q[128 + e] * kvv; d3 += q[192 + e] * kvv; } }
          else { d0 = d1 = d2 = d3 = -1e30f; }
          sc[tid] = d0; sc[512 + tid] = d1; sc[1024 + tid] = d2; sc[1536 + tid] = d3; }
        __syncthreads();
        softmax_rows4(sc, 512, 512, wv, lane);
        __syncthreads();
        if (tid < 256) { const int r = tid >> 6, d = tid & 63; float acc = 0.f;
            for (int k = 0; k < 512; ++k) { const float p = sc[r * 512 + k]; if (p != 0.f) { const int kpos = sel[k >> 6] * 64 + (k & 63); acc += p * bf2f(KV[3 * KV_STRIDE + ((size_t)bg * NS + kpos) * DH + d]); } }
            oacc[256 + r * 64 + d] = acc; }
        __syncthreads();
        { const int kpos = s - 511 + tid;
          const bf16_t* kr = KV + 4 * KV_STRIDE + ((size_t)bg * NS + kpos) * DH;
          float d0 = 0.f, d1 = 0.f, d2 = 0.f, d3 = 0.f;
          if (kpos >= 0) { for (int e = 0; e < 64; ++e) { const float kvv = bf2f(kr[e]); d0 += q[e] * kvv; d1 += q[64 + e] * kvv; d2 += q[128 + e] * kvv; d3 += q[192 + e] * kvv; } }
          else { d0 = d1 = d2 = d3 = -1e30f; }
          sc[tid] = d0; sc[512 + tid] = d1; sc[1024 + tid] = d2; sc[1536 + tid] = d3; }
        __syncthreads();
        softmax_rows4(sc, 512, 512, wv, lane);
        __syncthreads();
        if (tid < 256) { const int r = tid >> 6, d = tid & 63; float acc = 0.f;
            for (int k = 0; k < 512; ++k) { const float p = sc[r * 512 + k]; if (p != 0.f) { const int kpos = s - 511 + k; acc += p * bf2f(KV[5 * KV_STRIDE + ((size_t)bg * NS + kpos) * DH + d]); } }
            oacc[512 + r * 64 + d] = acc; }
        __syncthreads();
        if (tid < 256) { const int r = tid >> 6, d = tid & 63;
            const float* gt = GATES + (size_t)t * 24 + g * 12 + r * 3;
            ofin[tid] = sigmf(gt[0]) * oacc[tid] + sigmf(gt[1]) * oacc[256 + tid] + sigmf(gt[2]) * oacc[512 + tid]; }
        __syncthreads();
        if (tid < 256) { const int r = tid >> 6, d = tid & 63; float ss = 0.f;
            for (int e = 0; e < 64; ++e) ss += ofin[r * 64 + e] * ofin[r * 64 + e];
            const int h = g * 4 + r;
            OA[(size_t)t * 1024 + h * 64 + d] = f2bf(ofin[tid] * rsqrtf(ss * (1.f / 64.f) + EPS) * AIN(I_NSAON)[h * 64 + d]); }
    }
}

DI void phase_ret(const Ctx& a, float* lds) {
    const int tid = opaque_tid();
    float* qv = lds;
    float* wts = lds + 64;
    float* part = wts + 2048;
    float* yv = part + 512;
    const bf16_t* RET = (const bf16_t*)(a.ws + WS_RET);
    bf16_t* OA = (bf16_t*)(a.ws + WS_OA);
    for (int u = blockIdx.x; u < NB * NHR * NS; u += gridDim.x) {
        const int s = u % NS, bh = u / NS, h = bh % NHR, b = bh / NHR;
        const float l2g = log2f(1.f - exp2f(-5.f - (float)h));
        __syncthreads();
        if (tid < 64) qv[tid] = bf2f(RET[((size_t)bh * NS + s) * DH + tid]);
        __syncthreads();
        for (int j = tid; j <= s; j += 512) {
            const bf16_t* kr = RET + RET_STRIDE + ((size_t)bh * NS + j) * DH; float d = 0.f;
            for (int e = 0; e < 64; ++e) d += qv[e] * bf2f(kr[e]);
            wts[j] = d * exp2f((float)(s - j) * l2g);
        }
        __syncthreads();
        { const int d = tid & 63, pt = tid >> 6; float acc = 0.f;
          for (int j = pt; j <= s; j += 8) acc += wts[j] * bf2f(RET[2 * RET_STRIDE + ((size_t)bh * NS + j) * DH + d]);
          part[pt * 64 + d] = acc; }
        __syncthreads();
        if (tid < 64) { float y = 0.f; for (int p = 0; p < 8; ++p) y += part[p * 64 + tid]; yv[tid] = y; }
        __syncthreads();
        if (tid < 64) {
            float mu = 0.f; for (int e = 0; e < 64; ++e) mu += yv[e]; mu *= (1.f / 64.f);
            float var = 0.f; for (int e = 0; e < 64; ++e) { const float dd = yv[e] - mu; var += dd * dd; } var *= (1.f / 64.f);
            const float gr = bf2f(RET[3 * RET_STRIDE + ((size_t)bh * NS + s) * DH + tid]);
            const float y = (yv[tid] - mu) * rsqrtf(var + EPS) * AIN(I_RETON)[h * 64 + tid] * siluf(gr);
            OA[(size_t)(b * NS + s) * 1024 + 512 + h * 64 + tid] = f2bf(y);
        }
    }
}

DI void phase_tail(const Ctx& a, float* lds) {
    const int tid = opaque_tid(), lane = tid & 63, wv = tid >> 6;
    constexpr int TK = 4;
    float* oa = lds;
    float* x1 = oa + TK * 1024;
    float* qb = x1 + TK * 1024;
    float* ob = qb + TK * 256;
    float* scm = ob + TK * 256;
    float* tmp = scm + TK * 1024;
    float* hidb = tmp + TK * 512;
    float* lg = hidb + 256;
    float* rs = lg + TK * 36;
    int* eid = (int*)(rs + TK);
    float* ew = (float*)(eid + TK * 2);
    const float* x = AIN(I_X);
    const bf16_t* OA = (const bf16_t*)(a.ws + WS_OA);
    const bf16_t* MK = (const bf16_t*)(a.ws + WS_MK); const bf16_t* MV = (const bf16_t*)(a.ws + WS_MV);
    const float* w_out = AIN(I_WOUT); const float* wq = AIN(I_MWQ); const float* wo = AIN(I_MWO);
    for (int tg = blockIdx.x; tg < NT / TK; tg += gridDim.x) {
        const int t0 = tg * TK, b = t0 / NS;
        __syncthreads();
        for (int i = tid; i < TK * 1024; i += 512) oa[i] = bf2f(OA[(size_t)t0 * 1024 + i]);
        __syncthreads();
        { float acc[2][TK];
#pragma unroll
          for (int i = 0; i < 2; ++i)
#pragma unroll
              for (int k = 0; k < TK; ++k) acc[i][k] = 0.f;
#pragma unroll 4
          for (int j = 0; j < 1024; ++j) { const float w0 = w_out[(size_t)j * 1024 + tid], w1 = w_out[(size_t)j * 1024 + tid + 512];
#pragma unroll
              for (int k = 0; k < TK; ++k) { const float o = oa[k * 1024 + j]; acc[0][k] += o * w0; acc[1][k] += o * w1; } }
#pragma unroll
          for (int k = 0; k < TK; ++k) { x1[k * 1024 + tid] = x[(size_t)(t0 + k) * 1024 + tid] + acc[0][k]; x1[k * 1024 + tid + 512] = x[(size_t)(t0 + k) * 1024 + tid + 512] + acc[1][k]; } }
        __syncthreads();
        if (wv < TK) { float ss = 0.f; for (int i = lane; i < 1024; i += 64) ss += x1[wv * 1024 + i] * x1[wv * 1024 + i]; ss = wave_sum(ss); if (lane == 0) rs[wv] = rsqrtf(ss * (1.f / DM) + EPS); }
        __syncthreads();
        for (int i = tid; i < TK * 1024; i += 512) oa[i] = x1[i] * rs[i >> 10] * AIN(I_MXN)[i & 1023];
        __syncthreads();
        { const int j = tid & 255, hf = tid >> 8; float acc[TK];
#pragma unroll
          for (int k = 0; k < TK; ++k) acc[k] = 0.f;
#pragma unroll 4
          for (int d = hf * 512; d < hf * 512 + 512; ++d) { const float w = wq[(size_t)d * 256 + j];
#pragma unroll
              for (int k = 0; k < TK; ++k) acc[k] += oa[k * 1024 + d] * w; }
#pragma unroll
          for (int k = 0; k < TK; ++k) tmp[k * 512 + tid] = acc[k]; }
        __syncthreads();
        for (int i = tid; i < TK * 256; i += 512) { const int k = i >> 8, j = i & 255; qb[i] = tmp[k * 512 + j] + tmp[k * 512 + 256 + j]; }
        __syncthreads();
        if (tid < TK * 4) { float* src = qb + tid * 64; float ss = 0.f; for (int d = 0; d < 64; ++d) ss += src[d] * src[d];
            const float r = rsqrtf(ss * (1.f / 64.f) + EPS) * 0.125f; for (int d = 0; d < 64; ++d) src[d] = src[d] * r * AIN(I_MQN)[d]; }
        __syncthreads();
        { const int h = tid >> 7, m0 = (tid & 127) * 2;
#pragma unroll
          for (int mm = 0; mm < 2; ++mm) { const int m = m0 + mm; const bf16_t* kr = MK + ((size_t)(b * MH + h) * NMEM + m) * DH; float acc[TK];
#pragma unroll
              for (int k = 0; k < TK; ++k) acc[k] = 0.f;
#pragma unroll 8
              for (int d = 0; d < 64; ++d) { const float kv = bf2f(kr[d]);
#pragma unroll
                  for (int k = 0; k < TK; ++k) acc[k] += qb[k * 256 + h * 64 + d] * kv; }
#pragma unroll
              for (int k = 0; k < TK; ++k) scm[(k * 4 + h) * 256 + m] = acc[k]; } }
        __syncthreads();
        for (int row = wv; row < TK * 4; row += 8) { float* r = scm + row * 256; float m = -1e30f;
            for (int i = lane; i < 256; i += 64) m = fmaxf(m, r[i]); m = wave_max(m);
            float s = 0.f; for (int i = lane; i < 256; i += 64) { const float e = __expf(r[i] - m); r[i] = e; s += e; } s = wave_sum(s);
            const float inv = 1.f / s; for (int i = lane; i < 256; i += 64) r[i] *= inv; }
        __syncthreads();
        { const int hd = tid & 255, h = hd >> 6, d = hd & 63, k0 = (tid >> 8) * 2; float a0 = 0.f, a1 = 0.f;
#pragma unroll 4
          for (int m = 0; m < 256; ++m) { const float v = bf2f(MV[((size_t)(b * MH + h) * NMEM + m) * DH + d]); a0 += scm[((k0) * 4 + h) * 256 + m] * v; a1 += scm[((k0 + 1) * 4 + h) * 256 + m] * v; }
          ob[k0 * 256 + hd] = a0; ob[(k0 + 1) * 256 + hd] = a1; }
        __syncthreads();
        { float acc[2][TK];
#pragma unroll
          for (int i = 0; i < 2; ++i)
#pragma unroll
              for (int k = 0; k < TK; ++k) acc[i][k] = 0.f;
#pragma unroll 4
          for (int j = 0; j < 256; ++j) { const float w0 = wo[(size_t)j * 1024 + tid], w1 = wo[(size_t)j * 1024 + tid + 512];
#pragma unroll
              for (int k = 0; k < TK; ++k) { const float o = ob[k * 256 + j]; acc[0][k] += o * w0; acc[1][k] += o * w1; } }
          __syncthreads();
#pragma unroll
          for (int k = 0; k < TK; ++k) { x1[k * 1024 + tid] += acc[0][k]; x1[k * 1024 + tid + 512] += acc[1][k]; } }
        __syncthreads();
        if (wv < TK) { float ss = 0.f; for (int i = lane; i < 1024; i += 64) ss += x1[wv * 1024 + i] * x1[wv * 1024 + i]; ss = wave_sum(ss); if (lane == 0) rs[wv] = rsqrtf(ss * (1.f / DM) + EPS); }
        __syncthreads();
        for (int i = tid; i < TK * 1024; i += 512) oa[i] = x1[i] * rs[i >> 10] * AIN(I_FFN)[i & 1023];
        __syncthreads();
        for (int dd = wv; dd < TK * 36; dd += 8) { const int k = dd / 36, j = dd % 36; float acc = 0.f;
            if (j < 4) { for (int d = lane; d < 1024; d += 64) acc += oa[k * 1024 + d] * AIN(I_RGW)[d * 4 + j]; }
            else { const int gg = (j - 4) >> 3, e = (j - 4) & 7; for (int d = lane; d < 1024; d += 64) acc += oa[k * 1024 + d] * AIN(I_REW)[((size_t)gg * 1024 + d) * 8 + e]; }
            acc = wave_sum(acc);
            if (lane == 0) lg[dd] = acc + (j < 4 ? AIN(I_RGB)[j] : AIN(I_REB)[j - 4]); }
        __syncthreads();
        if (tid < TK) { const float* l = lg + tid * 36; int grp = 0; float gm = l[0];
            for (int j = 1; j < 4; ++j) if (l[j] > gm) { gm = l[j]; grp = j; }
            float gs = 0.f; for (int j = 0; j < 4; ++j) gs += __expf(l[j] - gm);
            const float gw = 1.f / gs;
            const float* el = l + 4 + grp * 8; int e0 = 0; float v0 = el[0];
            for (int j = 1; j < 8; ++j) if (el[j] > v0) { v0 = el[j]; e0 = j; }
            int e1 = -1; float v1 = 0.f;
            for (int j = 0; j < 8; ++j) if (j != e0) { if (e1 < 0 || el[j] > v1) { v1 = el[j]; e1 = j; } }
            const float p1 = __expf(v1 - v0); const float den = 1.f + p1;
            eid[tid * 2] = grp * 8 + e0; eid[tid * 2 + 1] = grp * 8 + e1; ew[tid * 2] = gw / den; ew[tid * 2 + 1] = gw * p1 / den; }
        __syncthreads();
        float yacc[2][TK];
#pragma unroll
        for (int i = 0; i < 2; ++i)
#pragma unroll
            for (int k = 0; k < TK; ++k) yacc[i][k] = 0.f;
#pragma unroll
        for (int k = 0; k < TK; ++k) {
            for (int kk = 0; kk < 2; ++kk) {
                const int e = eid[k * 2 + kk]; const float wgt = ew[k * 2 + kk];
                { const int f = tid & 255, hf = tid >> 8; const float* W = (hf == 0 ? AIN(I_EWG) : AIN(I_EWU)) + (size_t)e * 1024 * 256; float acc = 0.f;
#pragma unroll 8
                  for (int d = 0; d < 1024; ++d) acc += oa[k * 1024 + d] * W[(size_t)d * 256 + f];
                  tmp[tid] = acc; }
                __syncthreads();
                if (tid < 256) hidb[tid] = siluf(tmp[tid]) * tmp[256 + tid];
                __syncthreads();
                { const float* W = AIN(I_EWD) + (size_t)e * 256 * 1024; float a0 = 0.f, a1 = 0.f;
#pragma unroll 4
                  for (int f = 0; f < 256; ++f) { const float hv = hidb[f]; a0 += hv * W[(size_t)f * 1024 + tid]; a1 += hv * W[(size_t)f * 1024 + tid + 512]; }
                  yacc[0][k] += wgt * a0; yacc[1][k] += wgt * a1; }
                __syncthreads();
            }
        }
#pragma unroll
        for (int k = 0; k < TK; ++k) { a.out[(size_t)(t0 + k) * 1024 + tid] = x1[k * 1024 + tid] + yacc[0][k]; a.out[(size_t)(t0 + k) * 1024 + tid + 512] = x1[k * 1024 + tid + 512] + yacc[1][k]; }
    }
}


DI void phase_tail_b(const Ctx& a, float* lds) {
    const int tid = opaque_tid(), lane = tid & 63, wv = tid >> 6;
    constexpr int TK = 4;
    float* oa = lds;
    float* x1 = oa + TK * 1024;
    float* qb = x1 + TK * 1024;
    float* ob = qb + TK * 256;
    float* scm = ob + TK * 256;
    float* tmp = scm + TK * 1024;
    float* hidb = tmp + TK * 512;
    float* lg = hidb + 256;
    float* rs = lg + TK * 36;
    int* eid = (int*)(rs + TK);
    float* ew = (float*)(eid + TK * 2);
    const float* x = AIN(I_X);
    const bf16_t* OA = (const bf16_t*)(a.ws + WS_OA);
    const bf16_t* MK = (const bf16_t*)(a.ws + WS_MK); const bf16_t* MV = (const bf16_t*)(a.ws + WS_MV);
    const float* wq = AIN(I_MWQ); const float* wo = AIN(I_MWO);
    bf16_t* H3 = (bf16_t*)(a.ws + WS_H3); int* LIST = (int*)(a.ws + WS_LIST); float* LISTW = (float*)(a.ws + WS_LISTW); float* LISTR = (float*)(a.ws + WS_LISTR); unsigned* cntp = (unsigned*)(a.ws + WS_CTL) + CW_CNT;
    for (int tg = blockIdx.x; tg < NT / TK; tg += gridDim.x) {
        const int t0 = tg * TK, b = t0 / NS;
        __syncthreads();
        for (int i = tid; i < TK * 1024; i += 512) x1[i] = a.out[(size_t)t0 * 1024 + i];
        __syncthreads();
        if (wv < TK) { float ss = 0.f; for (int i = lane; i < 1024; i += 64) ss += x1[wv * 1024 + i] * x1[wv * 1024 + i]; ss = wave_sum(ss); if (lane == 0) rs[wv] = rsqrtf(ss * (1.f / DM) + EPS); }
        __syncthreads();
        for (int i = tid; i < TK * 1024; i += 512) oa[i] = x1[i] * rs[i >> 10] * AIN(I_MXN)[i & 1023];
        __syncthreads();
        { const int j = tid & 255, hf = tid >> 8; float acc[TK];
#pragma unroll
          for (int k = 0; k < TK; ++k) acc[k] = 0.f;
#pragma unroll 4
          for (int d = hf * 512; d < hf * 512 + 512; ++d) { const float w = wq[(size_t)d * 256 + j];
#pragma unroll
              for (int k = 0; k < TK; ++k) acc[k] += oa[k * 1024 + d] * w; }
#pragma unroll
          for (int k = 0; k < TK; ++k) tmp[k * 512 + tid] = acc[k]; }
        __syncthreads();
        for (int i = tid; i < TK * 256; i += 512) { const int k = i >> 8, j = i & 255; qb[i] = tmp[k * 512 + j] + tmp[k * 512 + 256 + j]; }
        __syncthreads();
        if (tid < TK * 4) { float* src = qb + tid * 64; float ss = 0.f; for (int d = 0; d < 64; ++d) ss += src[d] * src[d];
            const float r = rsqrtf(ss * (1.f / 64.f) + EPS) * 0.125f; for (int d = 0; d < 64; ++d) src[d] = src[d] * r * AIN(I_MQN)[d]; }
        __syncthreads();
        { const int h = tid >> 7, m0 = (tid & 127) * 2;
#pragma unroll
          for (int mm = 0; mm < 2; ++mm) { const int m = m0 + mm; const bf16_t* kr = MK + ((size_t)(b * MH + h) * NMEM + m) * DH; float acc[TK];
#pragma unroll
              for (int k = 0; k < TK; ++k) acc[k] = 0.f;
#pragma unroll 8
              for (int d = 0; d < 64; ++d) { const float kv = bf2f(kr[d]);
#pragma unroll
                  for (int k = 0; k < TK; ++k) acc[k] += qb[k * 256 + h * 64 + d] * kv; }
#pragma unroll
              for (int k = 0; k < TK; ++k) scm[(k * 4 + h) * 256 + m] = acc[k]; } }
        __syncthreads();
        for (int row = wv; row < TK * 4; row += 8) { float* r = scm + row * 256; float m = -1e30f;
            for (int i = lane; i < 256; i += 64) m = fmaxf(m, r[i]); m = wave_max(m);
            float s = 0.f; for (int i = lane; i < 256; i += 64) { const float e = __expf(r[i] - m); r[i] = e; s += e; } s = wave_sum(s);
            const float inv = 1.f / s; for (int i = lane; i < 256; i += 64) r[i] *= inv; }
        __syncthreads();
        { const int hd = tid & 255, h = hd >> 6, d = hd & 63, k0 = (tid >> 8) * 2; float a0 = 0.f, a1 = 0.f;
#pragma unroll 4
          for (int m = 0; m < 256; ++m) { const float v = bf2f(MV[((size_t)(b * MH + h) * NMEM + m) * DH + d]); a0 += scm[((k0) * 4 + h) * 256 + m] * v; a1 += scm[((k0 + 1) * 4 + h) * 256 + m] * v; }
          ob[k0 * 256 + hd] = a0; ob[(k0 + 1) * 256 + hd] = a1; }
        __syncthreads();
        { float acc[2][TK];
#pragma unroll
          for (int i = 0; i < 2; ++i)
#pragma unroll
              for (int k = 0; k < TK; ++k) acc[i][k] = 0.f;
#pragma unroll 4
          for (int j = 0; j < 256; ++j) { const float w0 = wo[(size_t)j * 1024 + tid], w1 = wo[(size_t)j * 1024 + tid + 512];
#pragma unroll
              for (int k = 0; k < TK; ++k) { const float o = ob[k * 256 + j]; acc[0][k] += o * w0; acc[1][k] += o * w1; } }
          __syncthreads();
#pragma unroll
          for (int k = 0; k < TK; ++k) { x1[k * 1024 + tid] += acc[0][k]; x1[k * 1024 + tid + 512] += acc[1][k]; } }
        __syncthreads();
        if (wv < TK) { float ss = 0.f; for (int i = lane; i < 1024; i += 64) ss += x1[wv * 1024 + i] * x1[wv * 1024 + i]; ss = wave_sum(ss); if (lane == 0) rs[wv] = rsqrtf(ss * (1.f / DM) + EPS); }
        __syncthreads();
        for (int i = tid; i < TK * 1024; i += 512) oa[i] = x1[i] * rs[i >> 10] * AIN(I_FFN)[i & 1023];
        __syncthreads();
        for (int dd = wv; dd < TK * 36; dd += 8) { const int k = dd / 36, j = dd % 36; float acc = 0.f;
            if (j < 4) { for (int d = lane; d < 1024; d += 64) acc += oa[k * 1024 + d] * AIN(I_RGW)[d * 4 + j]; }
            else { const int gg = (j - 4) >> 3, e = (j - 4) & 7; for (int d = lane; d < 1024; d += 64) acc += oa[k * 1024 + d] * AIN(I_REW)[((size_t)gg * 1024 + d) * 8 + e]; }
            acc = wave_sum(acc);
            if (lane == 0) lg[dd] = acc + (j < 4 ? AIN(I_RGB)[j] : AIN(I_REB)[j - 4]); }
        __syncthreads();
        if (tid < TK) { const float* l = lg + tid * 36; int grp = 0; float gm = l[0];
            for (int j = 1; j < 4; ++j) if (l[j] > gm) { gm = l[j]; grp = j; }
            float gs = 0.f; for (int j = 0; j < 4; ++j) gs += __expf(l[j] - gm);
            const float gw = 1.f / gs;
            const float* el = l + 4 + grp * 8; int e0 = 0; float v0 = el[0];
            for (int j = 1; j < 8; ++j) if (el[j] > v0) { v0 = el[j]; e0 = j; }
            int e1 = -1; float v1 = 0.f;
            for (int j = 0; j < 8; ++j) if (j != e0) { if (e1 < 0 || el[j] > v1) { v1 = el[j]; e1 = j; } }
            const float p1 = __expf(v1 - v0); const float den = 1.f + p1;
            eid[tid * 2] = grp * 8 + e0; eid[tid * 2 + 1] = grp * 8 + e1; ew[tid * 2] = gw / den; ew[tid * 2 + 1] = gw * p1 / den; }
        __syncthreads();
        for (int i = tid; i < TK * 1024; i += 512) { a.out[(size_t)t0 * 1024 + i] = x1[i]; H3[(size_t)t0 * 1024 + i] = f2bf(x1[i]); }
        if (tid < TK * 2) { const int e = eid[tid]; const unsigned slot = atomicAdd(cntp + e, 1u);
            LIST[(size_t)e * NT + slot] = (t0 + (tid >> 1)) * 2 + (tid & 1); LISTW[(size_t)e * NT + slot] = ew[tid]; LISTR[(size_t)e * NT + slot] = rs[tid >> 1]; }
    }
}


struct EpiOut {
    static constexpr bool PERM = true, AFTER_DRAIN = false;
    const float* x; float* out; bf16_t* x1b; float* rss;
    DI void operator()(const pg8::f32x4 (&acc)[2][2][4][2], const pg8::Unit& u, int wr, int wc, int fr, int fq) const {
#pragma unroll
        for (int ai = 0; ai < 2; ++ai)
#pragma unroll
            for (int m = 0; m < 4; ++m) {
                const size_t row = (size_t)u.pm * 256 + ai * 128 + wr * 64 + m * 16 + fr; float ss = 0.f;
#pragma unroll
                for (int bj = 0; bj < 2; ++bj) {
                    const size_t off = row * DM + u.pn * 256 + 128 * bj + 32 * wc + 8 * fq;
                    const f32x4v x0 = *(const f32x4v*)(x + off), x1 = *(const f32x4v*)(x + off + 4);
                    const pg8::f32x4 a0 = acc[ai][bj][m][0], a1 = acc[ai][bj][m][1];
                    const f32x4v o0 = (f32x4v){x0.x + a0[0], x0.y + a0[1], x0.z + a0[2], x0.w + a0[3]}, o1 = (f32x4v){x1.x + a1[0], x1.y + a1[1], x1.z + a1[2], x1.w + a1[3]};
                    *(f32x4v*)(out + off) = o0; *(f32x4v*)(out + off + 4) = o1;
                    ss += (o0.x * o0.x + o0.y * o0.y) + (o0.z * o0.z + o0.w * o0.w) + (o1.x * o1.x + o1.y * o1.y) + (o1.z * o1.z + o1.w * o1.w);
                    v4u w; w.x = cvtpk(o0.x, o0.y); w.y = cvtpk(o0.z, o0.w); w.z = cvtpk(o1.x, o1.y); w.w = cvtpk(o1.z, o1.w);
                    *(v4u*)(x1b + off) = w;
                }
                ss += __shfl_xor(ss, 16); ss += __shfl_xor(ss, 32);
                if (fq == 0) rss[row * 16 + u.pn * 4 + wc] = ss;
            }
    }
};
DI void phase_outproj_mfma(const Ctx& a, unsigned char* lds_raw) {
    pg8::Gemm g{(const bf16_t*)(a.ws + WS_OA), (const bf16_t*)(a.ws + WS_WOUT_T), NT, DM, DM};
    pg8::StaticOrder S; S.init(NT, DM, (int)gridDim.x, (int)blockIdx.x);
    EpiOut E{AIN(I_X), a.out, (bf16_t*)(a.ws + WS_X1B), (float*)(a.ws + WS_RSS1)};
    pg8::gemm_phase<EpiOut, pg8::StaticOrder, true, true>((PG8_LAS unsigned char*)lds_raw, g, S, E);
}

struct MoeSched {
    const LAS int* tstart; const LAS int* cnts; int G, c, lognpn, nunits, mode;
    const int* LIST; const char* Abase; const char* Bbase;
    DI bool next(int i, pg8::UnitG& u) const {
        const int L = i * G + c; if (L >= nunits) return false;
        const int gt = L >> lognpn, pn = L & ((1 << lognpn) - 1);
        int e = 0; while (tstart[e + 1] <= gt) ++e;
        const int rt = gt - tstart[e], cnt = cnts[e];
        u.pn = pn; u.e = e; u.rt = rt; u.cnt = cnt; u.row0 = gt * 256;
        const int tid = threadIdx.x;
        if (mode == 0) {
            u.A = Abase; u.B = Bbase + ((size_t)e * 512 + pn * 256) * 1024 * 2;
#pragma unroll
            for (int h = 0; h < 2; ++h)
#pragma unroll
                for (int k = 0; k < 2; ++k) { int R, C; pg8::stage_rc(tid * 16 + k * 8192, R, C); const int idx = rt * 256 + h * 128 + R;
                    const int tok = (idx < cnt) ? (LIST[(size_t)e * NT + idx] >> 1) : 0; u.ao[h][k] = (unsigned)(tok * 1024 + C) * 2u; }
        } else {
            u.A = Abase + (size_t)gt * 256 * 256 * 2; u.B = Bbase + ((size_t)e * 1024 + pn * 256) * 256 * 2;
#pragma unroll
            for (int h = 0; h < 2; ++h)
#pragma unroll
                for (int k = 0; k < 2; ++k) { int R, C; pg8::stage_rc(tid * 16 + k * 8192, R, C); u.ao[h][k] = (unsigned)((h * 128 + R) * 256 + C) * 2u; }
        }
        return true;
    }
};
struct EpiGU {
    static constexpr bool PERM = true;
    bf16_t* HID; const float* LISTR;
    DI void operator()(const pg8::f32x4 (&acc)[2][2][4][2], const pg8::UnitG& u, int wr, int wc, int fr, int fq) const {
#pragma unroll
        for (int ai = 0; ai < 2; ++ai)
#pragma unroll
            for (int m = 0; m < 4; ++m) {
                const int rl = ai * 128 + wr * 64 + m * 16 + fr; float h[8];
                const int idx = u.rt * 256 + rl; const float rsd = (idx < u.cnt) ? LISTR[(size_t)u.e * NT + idx] : 0.f;
#pragma unroll
                for (int n = 0; n < 2; ++n)
#pragma unroll
                    for (int i = 0; i < 4; ++i) h[4 * n + i] = siluf(acc[ai][0][m][n][i] * rsd) * (acc[ai][1][m][n][i] * rsd);
                v4u w; w.x = cvtpk(h[0], h[1]); w.y = cvtpk(h[2], h[3]); w.z = cvtpk(h[4], h[5]); w.w = cvtpk(h[6], h[7]);
                *(v4u*)(HID + (size_t)(u.row0 + rl) * 256 + 128 * u.pn + 32 * wc + 8 * fq) = w;
            }
    }
};
struct EpiDown {
    static constexpr bool PERM = true;
    bf16_t* Y; const int* LIST; const float* LISTW;
    DI void operator()(const pg8::f32x4 (&acc)[2][2][4][2], const pg8::UnitG& u, int wr, int wc, int fr, int fq) const {
#pragma unroll
        for (int ai = 0; ai < 2; ++ai)
#pragma unroll
            for (int m = 0; m < 4; ++m) {
                const int rl = ai * 128 + wr * 64 + m * 16 + fr, idx = u.rt * 256 + rl;
                if (idx < u.cnt) {
                    const int asg = LIST[(size_t)u.e * NT + idx]; const float wg = LISTW[(size_t)u.e * NT + idx];
#pragma unroll
                    for (int bj = 0; bj < 2; ++bj) { const pg8::f32x4 a0 = acc[ai][bj][m][0], a1 = acc[ai][bj][m][1];
                        v4u w; w.x = cvtpk(a0[0] * wg, a0[1] * wg); w.y = cvtpk(a0[2] * wg, a0[3] * wg); w.z = cvtpk(a1[0] * wg, a1[1] * wg); w.w = cvtpk(a1[2] * wg, a1[3] * wg);
                        *(v4u*)(Y + (size_t)asg * 1024 + 256 * u.pn + 128 * bj + 32 * wc + 8 * fq) = w; }
                }
                asm volatile("" ::: "memory");
            }
    }
};
DI int moe_setup(const Ctx& a, unsigned char* lds_raw) {
    LAS int* ts = (LAS int*)((LAS unsigned char*)lds_raw + 131072); LAS int* cn = ts + 40;
    const unsigned* cnt = (const unsigned*)(a.ws + WS_CTL) + CW_CNT;
    __syncthreads();
    if (threadIdx.x == 0) { int acc = 0; for (int e = 0; e < NEXP; ++e) { const int c = (int)__hip_atomic_load(cnt + e, __ATOMIC_RELAXED, __HIP_MEMORY_SCOPE_AGENT); ts[e] = acc; cn[e] = c; acc += (c + 255) >> 8; } ts[NEXP] = acc; ts[NEXP + 1] = 0x7fffffff; }
    __syncthreads();
    return ts[NEXP];
}
DI void phase_moe_gu(const Ctx& a, unsigned char* lds_raw) {
    const int ntil = moe_setup(a, lds_raw);
    LAS int* ts = (LAS int*)((LAS unsigned char*)lds_raw + 131072);
    MoeSched S{ts, ts + 40, (int)gridDim.x, (int)blockIdx.x, 1, ntil * 2, 0, (const int*)(a.ws + WS_LIST), (const char*)(a.ws + WS_H3), (const char*)(a.ws + WS_WGU_T)};
    EpiGU E{(bf16_t*)(a.ws + WS_HID), (const float*)(a.ws + WS_LISTR)};
    pg8::gemm_phase_g<EpiGU, MoeSched>((PG8_LAS unsigned char*)lds_raw, 1024, S, E);
}
DI void phase_moe_down(const Ctx& a, unsigned char* lds_raw) {
    const int ntil = moe_setup(a, lds_raw);
    LAS int* ts = (LAS int*)((LAS unsigned char*)lds_raw + 131072);
    MoeSched S{ts, ts + 40, (int)gridDim.x, (int)blockIdx.x, 2, ntil * 4, 1, (const int*)(a.ws + WS_LIST), (const char*)(a.ws + WS_HID), (const char*)(a.ws + WS_WD_T)};
    EpiDown E{(bf16_t*)(a.ws + WS_Y), (const int*)(a.ws + WS_LIST), (const float*)(a.ws + WS_LISTW)};
    int kk = 256; asm volatile("" : "+s"(kk));
    pg8::gemm_phase_g<EpiDown, MoeSched>((PG8_LAS unsigned char*)lds_raw, kk, S, E);
}
DI void phase_combine(const Ctx& a) {
    const int tid = opaque_tid(), lane = tid & 63, wv = tid >> 6;
    const bf16_t* Y = (const bf16_t*)(a.ws + WS_Y);
    for (int t = blockIdx.x * NWAVE + wv; t < NT; t += gridDim.x * NWAVE) {
        f32x4v* o = (f32x4v*)(a.out + (size_t)t * DM) + lane;
        const unsigned long long* y0 = (const unsigned long long*)(Y + (size_t)(2 * t) * DM) + lane; const unsigned long long* y1 = (const unsigned long long*)(Y + (size_t)(2 * t + 1) * DM) + lane;
#pragma unroll
        for (int j = 0; j < 4; ++j) { f32x4v v = o[64 * j]; const unsigned long long p = y0[64 * j], q = y1[64 * j];
            v.x += bf2f((unsigned short)(p & 0xffff)) + bf2f((unsigned short)(q & 0xffff)); v.y += bf2f((unsigned short)((p >> 16) & 0xffff)) + bf2f((unsigned short)((q >> 16) & 0xffff));
            v.z += bf2f((unsigned short)((p >> 32) & 0xffff)) + bf2f((unsigned short)((q >> 32) & 0xffff)); v.w += bf2f((unsigned short)(p >> 48)) + bf2f((unsigned short)(q >> 48));
            o[64 * j] = v; }
    }
}


typedef float f32x16 __attribute__((ext_vector_type(16)));
typedef short s16x8 __attribute__((ext_vector_type(8)));
typedef short s16x4 __attribute__((ext_vector_type(4)));
#define MFMA32(a, b, c) __builtin_amdgcn_mfma_f32_32x32x16_bf16((a), (b), (c), 0, 0, 0)
DI int crow(int reg, int h) { return (reg & 3) + 8 * (reg >> 2) + 4 * h; }
DI s16x8 pack8(const f32x16& x, int s) {
    v4u p; p.x = cvtpk(x[8 * s], x[8 * s + 1]); p.y = cvtpk(x[8 * s + 2], x[8 * s + 3]); p.z = cvtpk(x[8 * s + 4], x[8 * s + 5]); p.w = cvtpk(x[8 * s + 6], x[8 * s + 7]);
    return __builtin_bit_cast(s16x8, p);
}
constexpr int TSTR = 272;
DI void phase_ret_state(const Ctx& a, unsigned char* lds_raw) {
    const int tid = opaque_tid(), lane = tid & 63, wv = __builtin_amdgcn_readfirstlane(tid >> 6), r = lane & 31, hh = lane >> 5;
    unsigned char* Kt = lds_raw;
    unsigned char* Vt = lds_raw + 64 * TSTR;
    const bf16_t* RET = (const bf16_t*)(a.ws + WS_RET);
    float* STT = (float*)(a.ws + WS_STT);
    for (int bh = (int)((blockIdx.x + gridDim.x - 64u) % gridDim.x); bh < NB * NHR; bh += gridDim.x) {
        const int h = bh % NHR; const float l2g = log2f(1.f - exp2f(-5.f - (float)h)); const float gc = exp2f(128.f * l2g);
        const int et = wv & 1, dt = (wv >> 1) & 1;
        f32x16 acc;
#pragma unroll
        for (int i = 0; i < 16; ++i) acc[i] = 0.f;
        for (int n = 0; n < 16; ++n) {
            __syncthreads();
#pragma unroll
            for (int i = 0; i < 2; ++i) { const int idx = tid + 512 * i, j = idx >> 3, c = idx & 7;
                const size_t go = ((size_t)bh * NS + n * 128 + j) * DH + 8 * c;
                const v4u kv = *(const v4u*)(RET + RET_STRIDE + go), vv = *(const v4u*)(RET + 2 * RET_STRIDE + go);
                const float z = exp2f((float)(127 - j) * l2g);
                const unsigned kw[4] = {kv.x, kv.y, kv.z, kv.w}, vw[4] = {vv.x, vv.y, vv.z, vv.w};
#pragma unroll
                for (int k = 0; k < 4; ++k) {
                    *(bf16_t*)(Kt + (8 * c + 2 * k) * TSTR + 2 * j) = f2bf(bf2f((unsigned short)(kw[k] & 0xffff)) * z);
                    *(bf16_t*)(Kt + (8 * c + 2 * k + 1) * TSTR + 2 * j) = f2bf(bf2f((unsigned short)(kw[k] >> 16)) * z);
                    *(bf16_t*)(Vt + (8 * c + 2 * k) * TSTR + 2 * j) = (unsigned short)(vw[k] & 0xffff);
                    *(bf16_t*)(Vt + (8 * c + 2 * k + 1) * TSTR + 2 * j) = (unsigned short)(vw[k] >> 16); } }
            __syncthreads();
            if (wv < 4) {
                float* dst = STT + ((size_t)bh * 16 + n) * 4096;
#pragma unroll
                for (int i = 0; i < 16; ++i) dst[(32 * et + crow(i, hh)) * 64 + 32 * dt + r] = acc[i];
#pragma unroll
                for (int i = 0; i < 16; ++i) acc[i] *= gc;
#pragma unroll
                for (int s = 0; s < 8; ++s) {
                    const s16x8 af = *(const s16x8*)(Vt + (32 * et + r) * TSTR + (16 * s + 8 * hh) * 2);
                    const s16x8 bf = *(const s16x8*)(Kt + (32 * dt + r) * TSTR + (16 * s + 8 * hh) * 2);
                    acc = MFMA32(af, bf, acc);
                }
            }
        }
    }
}
DI void phase_ret_out(const Ctx& a, unsigned char* lds_raw) {
    const int tid = opaque_tid(), lane = tid & 63, wv = __builtin_amdgcn_readfirstlane(tid >> 6), r = lane & 31, hh = lane >> 5;
    unsigned char* Kl = lds_raw;
    unsigned char* Vt = lds_raw + 16384;
    float* Ol = (float*)(lds_raw + 16384 + 64 * TSTR + 256);
    const bf16_t* RET = (const bf16_t*)(a.ws + WS_RET);
    const float* STT = (const float*)(a.ws + WS_STT);
    bf16_t* OA = (bf16_t*)(a.ws + WS_OA);
    for (int u = blockIdx.x; u < NB * NHR * 16; u += gridDim.x) {
        const int bh = u >> 4, n = u & 15, h = bh % NHR, b = bh / NHR;
        const float l2g = log2f(1.f - exp2f(-5.f - (float)h));
        __syncthreads();
#pragma unroll
        for (int i = 0; i < 2; ++i) { const int idx = tid + 512 * i, j = idx >> 3, c = idx & 7;
            const size_t go = ((size_t)bh * NS + n * 128 + j) * DH + 8 * c;
            const v4u kv = *(const v4u*)(RET + RET_STRIDE + go), vv = *(const v4u*)(RET + 2 * RET_STRIDE + go);
            *(v4u*)(Kl + j * 128 + ((c ^ ((j >> 1) & 7)) * 16)) = kv;
            const unsigned vw[4] = {vv.x, vv.y, vv.z, vv.w};
#pragma unroll
            for (int k = 0; k < 4; ++k) { *(bf16_t*)(Vt + (8 * c + 2 * k) * TSTR + 2 * j) = (unsigned short)(vw[k] & 0xffff); *(bf16_t*)(Vt + (8 * c + 2 * k + 1) * TSTR + 2 * j) = (unsigned short)(vw[k] >> 16); } }
        const int it = wv & 3, eh = wv >> 2;
        s16x8 qf[4];
        { const bf16_t* qp = RET + ((size_t)bh * NS + n * 128 + 32 * it + r) * DH + 8 * hh;
#pragma unroll
          for (int s = 0; s < 4; ++s) qf[s] = *(const s16x8*)(qp + 16 * s); }
        __syncthreads();
        f32x16 oin, ocr;
#pragma unroll
        for (int i = 0; i < 16; ++i) { oin[i] = 0.f; ocr[i] = 0.f; }
        for (int jt = 0; jt <= it; ++jt) {
            f32x16 st;
#pragma unroll
            for (int i = 0; i < 16; ++i) st[i] = 0.f;
            const int row = 32 * jt + r;
#pragma unroll
            for (int s = 0; s < 4; ++s) { const s16x8 kf = *(const s16x8*)(Kl + row * 128 + (((2 * s + hh) ^ ((row >> 1) & 7)) * 16)); st = MFMA32(kf, qf[s], st); }
            const int iq = 32 * it + r;
#pragma unroll
            for (int i = 0; i < 16; ++i) { const int dl = iq - (32 * jt + crow(i, hh)); st[i] = (dl >= 0) ? st[i] * exp2f((float)dl * l2g) : 0.f; }
#pragma unroll
            for (int s2 = 0; s2 < 2; ++s2) {
                const s16x8 pa = pack8(st, s2);
                const unsigned char* vp = Vt + (32 * eh + r) * TSTR + (32 * jt + 16 * s2 + 4 * hh) * 2;
                const s16x4 lo = *(const s16x4*)vp, hi = *(const s16x4*)(vp + 16);
                const s16x8 vf = __builtin_shufflevector(lo, hi, 0, 1, 2, 3, 4, 5, 6, 7);
                oin = MFMA32(pa, vf, oin);
            }
        }
        { const float* sp = STT + ((size_t)bh * 16 + n) * 4096 + (size_t)(32 * eh + r) * 64 + 8 * hh;
#pragma unroll
          for (int s = 0; s < 4; ++s) { const f32x4v f0 = *(const f32x4v*)(sp + 16 * s), f1 = *(const f32x4v*)(sp + 16 * s + 4);
              v4u p; p.x = cvtpk(f0.x, f0.y); p.y = cvtpk(f0.z, f0.w); p.z = cvtpk(f1.x, f1.y); p.w = cvtpk(f1.z, f1.w);
              ocr = MFMA32(qf[s], __builtin_bit_cast(s16x8, p), ocr); } }
#pragma unroll
        for (int i = 0; i < 16; ++i) { const int iq = 32 * it + crow(i, hh); Ol[iq * 64 + 32 * eh + r] = oin[i] + exp2f((float)(iq + 1) * l2g) * ocr[i]; }
        __syncthreads();
        { const int row = tid >> 2, qd = tid & 3; const float* op = Ol + row * 64 + 16 * qd; float v[16]; float sm = 0.f;
#pragma unroll
          for (int k = 0; k < 16; ++k) { v[k] = op[k]; sm += v[k]; }
          sm += __shfl_xor(sm, 1); sm += __shfl_xor(sm, 2); const float mu = sm * (1.f / 64.f); float vr = 0.f;
#pragma unroll
          for (int k = 0; k < 16; ++k) { const float d = v[k] - mu; vr += d * d; }
          vr += __shfl_xor(vr, 1); vr += __shfl_xor(vr, 2); const float rs = rsqrtf(vr * (1.f / 64.f) + EPS);
          const size_t tok = (size_t)b * NS + n * 128 + row;
          const bf16_t* gp = RET + 3 * RET_STRIDE + ((size_t)bh * NS + n * 128 + row) * DH + 16 * qd;
          const v4u g0 = *(const v4u*)gp, g1 = *(const v4u*)(gp + 8); const unsigned gw[8] = {g0.x, g0.y, g0.z, g0.w, g1.x, g1.y, g1.z, g1.w};
          const float* nw = AIN(I_RETON) + h * 64 + 16 * qd; unsigned ow[8];
#pragma unroll
          for (int k = 0; k < 8; ++k) { const float ga = bf2f((unsigned short)(gw[k] & 0xffff)), gb = bf2f((unsigned short)(gw[k] >> 16));
              ow[k] = cvtpk((v[2 * k] - mu) * rs * nw[2 * k] * siluf(ga), (v[2 * k + 1] - mu) * rs * nw[2 * k + 1] * siluf(gb)); }
          bf16_t* dp = OA + tok * 1024 + 512 + h * 64 + 16 * qd;
          *(v4u*)dp = (v4u){ow[0], ow[1], ow[2], ow[3]}; *(v4u*)(dp + 8) = (v4u){ow[4], ow[5], ow[6], ow[7]}; }
    }
}


constexpr int VSTR = 136;
constexpr int KVBUF = 8192 + 64 * VSTR;
constexpr float LOG2E = 1.4426950408889634f;
DI void nsa_stage_load(const bf16_t* Kg, const bf16_t* Vg, int jb, int tid, v4u& kr, v4u& vr) {
    const size_t go = ((size_t)jb * 64 + (tid >> 3)) * DH + 8 * (tid & 7);
    kr = *(const v4u*)(Kg + go); vr = *(const v4u*)(Vg + go);
}
DI void nsa_stage_write(unsigned char* buf, int tid, const v4u& kr, const v4u& vr) {
    const int j = tid >> 3, c = tid & 7;
    *(v4u*)(buf + j * 128 + ((c ^ ((j >> 1) & 7)) * 16)) = kr;
    unsigned char* vs = buf + 8192; const unsigned vw[4] = {vr.x, vr.y, vr.z, vr.w};
#pragma unroll
    for (int k = 0; k < 4; ++k) { *(bf16_t*)(vs + (8 * c + 2 * k) * VSTR + 2 * j) = (unsigned short)(vw[k] & 0xffff); *(bf16_t*)(vs + (8 * c + 2 * k + 1) * VSTR + 2 * j) = (unsigned short)(vw[k] >> 16); }
}
template <int MODE>
DI void nsa_branch(const bf16_t* Kg, const bf16_t* Vg, int jlo, int jhi, int cur, int tq, unsigned selmask, float negsh, const s16x8 (&qf)[4],
                   f32x16 (&O)[2], float& lsum, unsigned char* kvb, int tid, int r, int hh) {
    v4u kr, vr;
    nsa_stage_load(Kg, Vg, jlo, tid, kr, vr);
    __syncthreads();
    nsa_stage_write(kvb, tid, kr, vr);
    __syncthreads();
    for (int j = jlo; j <= jhi; ++j) {
        unsigned char* buf = kvb + ((j - jlo) & 1) * KVBUF;
        asm volatile("" : "+v"(r), "+v"(hh), "+v"(tid));
        if (j < jhi) nsa_stage_load(Kg, Vg, j + 1, tid, kr, vr);
        float ns = negsh;
        if (MODE == 0) ns = ((selmask >> j) & 1u) ? negsh : -1e30f;
#pragma unroll
        for (int kt = 0; kt < 2; ++kt) {
            f32x16 st;
#pragma unroll
            for (int i = 0; i < 16; ++i) st[i] = 0.f;
            const int row = 32 * kt + r;
#pragma unroll
            for (int s = 0; s < 4; ++s) { const s16x8 kf = *(const s16x8*)(buf + row * 128 + (((2 * s + hh) ^ ((row >> 1) & 7)) * 16)); st = MFMA32(kf, qf[s], st); }
            const int kbase = 64 * j + 32 * kt;
            if (j == cur) {
#pragma unroll
                for (int i = 0; i < 16; ++i) { const int key = kbase + crow(i, hh); st[i] = (key <= tq) ? __builtin_amdgcn_exp2f(st[i] * LOG2E + ns) : 0.f; }
            } else if (MODE == 1 && j == cur - 8) {
#pragma unroll
                for (int i = 0; i < 16; ++i) { const int key = kbase + crow(i, hh); st[i] = (key >= tq - 511) ? __builtin_amdgcn_exp2f(st[i] * LOG2E + ns) : 0.f; }
            } else {
#pragma unroll
                for (int i = 0; i < 16; ++i) st[i] = __builtin_amdgcn_exp2f(st[i] * LOG2E + ns);
            }
            float sm = 0.f;
#pragma unroll
            for (int i = 0; i < 16; ++i) sm += st[i];
            lsum += sm;
#pragma unroll
            for (int s2 = 0; s2 < 2; ++s2) {
                const s16x8 pa = pack8(st, s2);
#pragma unroll
                for (int et = 0; et < 2; ++et) {
                    const unsigned char* vp = buf + 8192 + (32 * et + r) * VSTR + (32 * kt + 16 * s2 + 4 * hh) * 2;
                    const s16x4 lo = *(const s16x4*)vp, hi = *(const s16x4*)(vp + 16);
                    O[et] = MFMA32(pa, __builtin_shufflevector(lo, hi, 0, 1, 2, 3, 4, 5, 6, 7), O[et]);
                }
            }
        }
        if (j < jhi) nsa_stage_write(kvb + ((j + 1 - jlo) & 1) * KVBUF, tid, kr, vr);
        __syncthreads();
    }
}
DI void phase_nsa_mfma(const Ctx& a, unsigned char* lds_raw) {
    int tid = opaque_tid(), lane = tid & 63; const int wv = __builtin_amdgcn_readfirstlane(tid >> 6); int r = lane & 31, hh = lane >> 5;
    unsigned char* Kc = lds_raw;
    unsigned char* Vc = lds_raw + 16384;
    unsigned char* kvb = lds_raw + 33792;
    float* coefl = (float*)(lds_raw + 67584) + wv * 32;
    float* bnd = (float*)(lds_raw + 67584 + 1024);
    float* Ol = (float*)(lds_raw + 69632) + wv * 2048;
    const bf16_t* Q = (const bf16_t*)(a.ws + WS_Q); const bf16_t* KV = (const bf16_t*)(a.ws + WS_KV);
    const bf16_t* KCMP = (const bf16_t*)(a.ws + WS_KCMP); const bf16_t* VCMP = (const bf16_t*)(a.ws + WS_VCMP);
    const float* GATES = (const float*)(a.ws + WS_GATES);
    bf16_t* OA = (bf16_t*)(a.ws + WS_OA);
    __syncthreads();
    if (wv < 3) { const float* gk = AIN(wv == 0 ? I_KCN : (wv == 1 ? I_KSN : I_KWN));
        const float mq = wave_max(fabsf(AIN(I_QN)[lane])), mk = wave_max(fabsf(gk[lane]));
        if (lane == 0) bnd[wv] = 8.f * mq * mk * LOG2E; }
    __syncthreads();
    const float nsh_c = -bnd[0], nsh_s = -bnd[1], nsh_w = -bnd[2];
    for (int it2 = blockIdx.x; it2 < 512; it2 += gridDim.x) {
        const int wi = it2 & 255, pass = it2 >> 8;
        const int bg = wi & 15, k = wi >> 4, qt = pass == 0 ? (31 - k) : k, cur = qt;
        const int b = bg >> 1, g = bg & 1, t0 = qt * 64;
        asm volatile("" : "+v"(r), "+v"(hh), "+v"(tid), "+v"(lane));
        const int q = r, head = q >> 3, tokl = 8 * wv + (q & 7), tq = t0 + tokl;
        const size_t tglob = (size_t)b * NS + tq;
        __syncthreads();
#pragma unroll
        for (int i = 0; i < 2; ++i) { const int idx = tid + 512 * i, j = idx >> 3, c = idx & 7;
            const size_t go = ((size_t)bg * 128 + j) * DH + 8 * c;
            const v4u kv = *(const v4u*)(KCMP + go), vv = *(const v4u*)(VCMP + go);
            *(v4u*)(Kc + j * 128 + ((c ^ ((j >> 1) & 7)) * 16)) = kv;
            const unsigned vw[4] = {vv.x, vv.y, vv.z, vv.w};
#pragma unroll
            for (int kk = 0; kk < 4; ++kk) { *(bf16_t*)(Vc + (8 * c + 2 * kk) * TSTR + 2 * j) = (unsigned short)(vw[kk] & 0xffff); *(bf16_t*)(Vc + (8 * c + 2 * kk + 1) * TSTR + 2 * j) = (unsigned short)(vw[kk] >> 16); } }
        s16x8 qf[4];
        { const bf16_t* qp = Q + tglob * 512 + (g * 4 + head) * 64 + 8 * hh;
#pragma unroll
          for (int s = 0; s < 4; ++s) qf[s] = *(const s16x8*)(qp + 16 * s); }
        const float* gt = GATES + tglob * 24 + g * 12 + head * 3;
        const float g0 = sigmf(gt[0]), g1 = sigmf(gt[1]), g2 = sigmf(gt[2]);
        __syncthreads();
        f32x16 Ot[2], Ob[2];
#pragma unroll
        for (int i = 0; i < 16; ++i) { Ot[0][i] = 0.f; Ot[1][i] = 0.f; Ob[0][i] = 0.f; Ob[1][i] = 0.f; }
        const int nkt = (4 * qt + 3 + 31) >> 5;
        const int cmax = (tq >= 31) ? ((tq - 31) >> 4) : -1;
        float impv[16]; float lc = 0.f, carry = 0.f;
#pragma unroll
        for (int kt = 0; kt < 4; ++kt) {
            f32x16 st;
#pragma unroll
            for (int i = 0; i < 16; ++i) st[i] = 0.f;
            if (kt < nkt) {
                const int row = 32 * kt + r;
#pragma unroll
                for (int s = 0; s < 4; ++s) { const s16x8 kf = *(const s16x8*)(Kc + row * 128 + (((2 * s + hh) ^ ((row >> 1) & 7)) * 16)); st = MFMA32(kf, qf[s], st); }
#pragma unroll
                for (int i = 0; i < 16; ++i) { const int c = 32 * kt + crow(i, hh); st[i] = (c <= cmax) ? __builtin_amdgcn_exp2f(st[i] * LOG2E + nsh_c) : 0.f; lc += st[i]; }
#pragma unroll
                for (int s2 = 0; s2 < 2; ++s2) {
                    const s16x8 pa = pack8(st, s2);
#pragma unroll
                    for (int et = 0; et < 2; ++et) {
                        const unsigned char* vp = Vc + (32 * et + r) * TSTR + (32 * kt + 16 * s2 + 4 * hh) * 2;
                        const s16x4 lo = *(const s16x4*)vp, hi = *(const s16x4*)(vp + 16);
                        Ob[et] = MFMA32(pa, __builtin_shufflevector(lo, hi, 0, 1, 2, 3, 4, 5, 6, 7), Ob[et]);
                    }
                }
            }
#pragma unroll
            for (int aa = 0; aa < 4; ++aa) { const float sp = 0.5f * st[4 * aa + 3]; const float osp = __shfl_xor(sp, 32);
                impv[kt * 4 + aa] = st[4 * aa] + st[4 * aa + 1] + st[4 * aa + 2] + sp + (hh ? osp : carry); carry = osp; }
            asm volatile("" ::: "memory");
        }
        const float ltc = lc + __shfl_xor(lc, 32);
        const float invc = (ltc > 0.f) ? 1.f / ltc : 0.f;
        unsigned selmask;
        {
#pragma unroll
            for (int x = 0; x < 16; ++x) { impv[x] *= invc; impv[x] += __shfl_xor(impv[x], 8); impv[x] += __shfl_xor(impv[x], 16); }
            if (cur < 8) selmask = (2u << cur) - 1u;
            else {
                selmask = 1u | (1u << cur) | (1u << (cur - 1));
#pragma unroll
                for (int x = 0; x < 16; ++x) { const int j = 2 * x + hh; if (j < 1 || j > cur - 2) impv[x] = -1e30f; }
                for (int rd = 0; rd < 5; ++rd) {
                    float best = -2e30f; int bj = 99;
#pragma unroll
                    for (int x = 0; x < 16; ++x) if (impv[x] > best) { best = impv[x]; bj = 2 * x + hh; }
                    const float ob = __shfl_xor(best, 32); const int oj = __shfl_xor(bj, 32);
                    const bool take = (ob > best) || (ob == best && oj < bj);
                    const int wj = take ? oj : bj;
                    selmask |= 1u << wj;
#pragma unroll
                    for (int x = 0; x < 16; ++x) if (2 * x + hh == wj) impv[x] = -2e30f;
                }
            }
        }
#define NSA_FOLD(coefv) do { asm volatile("" ::: "memory"); if (hh == 0) coefl[q] = (coefv); asm volatile("s_waitcnt lgkmcnt(0)" ::: "memory"); \
        _Pragma("unroll") for (int i = 0; i < 16; ++i) { const float cf = coefl[crow(i, hh)]; Ot[0][i] += cf * Ob[0][i]; Ot[1][i] += cf * Ob[1][i]; Ob[0][i] = 0.f; Ob[1][i] = 0.f; } \
        asm volatile("s_waitcnt lgkmcnt(0)" ::: "memory"); } while (0)
        NSA_FOLD(g0 * invc);
        { float ls = 0.f;
          nsa_branch<0>(KV + 2 * KV_STRIDE + (size_t)bg * NS * DH, KV + 3 * KV_STRIDE + (size_t)bg * NS * DH, 0, cur, cur, tq, selmask, nsh_s, qf, Ob, ls, kvb, tid, r, hh);
          const float lt = ls + __shfl_xor(ls, 32);
          NSA_FOLD(g1 / lt); }
        { float lw = 0.f;
          nsa_branch<1>(KV + 4 * KV_STRIDE + (size_t)bg * NS * DH, KV + 5 * KV_STRIDE + (size_t)bg * NS * DH, cur >= 8 ? cur - 8 : 0, cur, cur, tq, 0u, nsh_w, qf, Ob, lw, kvb, tid, r, hh);
          const float lt = lw + __shfl_xor(lw, 32);
          NSA_FOLD(g2 / lt); }
#pragma unroll
        for (int i = 0; i < 16; ++i) { Ol[crow(i, hh) * 64 + r] = Ot[0][i]; Ol[crow(i, hh) * 64 + 32 + r] = Ot[1][i]; }
        asm volatile("s_waitcnt lgkmcnt(0)" ::: "memory");
        { const int rq = lane >> 1, hf = lane & 1; const float* op = Ol + rq * 64 + 32 * hf; float ss = 0.f;
#pragma unroll
          for (int c4 = 0; c4 < 8; ++c4) { const f32x4v t4 = *(const f32x4v*)(op + 4 * c4); ss += (t4.x * t4.x + t4.y * t4.y) + (t4.z * t4.z + t4.w * t4.w); }
          ss += __shfl_xor(ss, 1);
          const float rs = rsqrtf(ss * (1.f / 64.f) + EPS);
          const int hd = g * 4 + (rq >> 3); const float* nw = AIN(I_NSAON) + hd * 64 + 32 * hf;
          bf16_t* dp = OA + ((size_t)b * NS + t0 + 8 * wv + (rq & 7)) * 1024 + hd * 64 + 32 * hf;
#pragma unroll
          for (int c4 = 0; c4 < 4; ++c4) { const f32x4v va = *(const f32x4v*)(op + 8 * c4), vb = *(const f32x4v*)(op + 8 * c4 + 4); const f32x4v na = *(const f32x4v*)(nw + 8 * c4), nb = *(const f32x4v*)(nw + 8 * c4 + 4); v4u w;
              w.x = cvtpk(va.x * rs * na.x, va.y * rs * na.y); w.y = cvtpk(va.z * rs * na.z, va.w * rs * na.w);
              w.z = cvtpk(vb.x * rs * nb.x, vb.y * rs * nb.y); w.w = cvtpk(vb.z * rs * nb.z, vb.w * rs * nb.w);
              *(v4u*)(dp + 8 * c4) = w; asm volatile("" ::: "memory"); } }
        asm volatile("s_waitcnt lgkmcnt(0)" ::: "memory");
    }
#undef NSA_FOLD
}


#define MFMA16(a, b, c) __builtin_amdgcn_mfma_f32_16x16x32_bf16((a), (b), (c), 0, 0, 0)
DI int perm32i(int rho) { const int n = rho >> 4, i = rho & 15; return 8 * (i >> 2) + 4 * n + (i & 3); }
DI void p5_loadB(const bf16_t* Bt, int K, int kt, int tid, v4u (&br)[4]) {
#pragma unroll
    for (int i = 0; i < 4; ++i) { const int p = tid + 512 * i, rho = p >> 3, c = p & 7; const int n = (rho & ~31) + perm32i(rho & 31); br[i] = *(const v4u*)(Bt + (size_t)n * K + kt * 64 + 8 * c); }
}
DI void p5_writeB(unsigned char* Bl, int tid, const v4u (&br)[4]) {
#pragma unroll
    for (int i = 0; i < 4; ++i) { const int p = tid + 512 * i, rho = p >> 3, c = p & 7; *(v4u*)(Bl + rho * 128 + ((c ^ (rho & 7)) * 16)) = br[i]; }
}
DI void phase_memattn_mfma(const Ctx& a, unsigned char* lds_raw, const bool dummy = false, const int parts = 31) {
    int tid = opaque_tid(); const int lane = tid & 63, wv = __builtin_amdgcn_readfirstlane(tid >> 6);
    int fr = lane & 15, fq = lane >> 4, r = lane & 31, hh = lane >> 5;
    const int wm = wv >> 2, wn = wv & 3;
    unsigned char* Al = lds_raw; unsigned char* Bl = lds_raw + 16384; unsigned char* QOl = lds_raw + 81920;
    float* rstd1 = (float*)(lds_raw + 114688); float* coefl = rstd1 + 64 + wv * 32; float* rss2 = rstd1 + 320; float* biasl = rstd1 + 1344; int* sel_e = (int*)(rstd1 + 1408); float* sel_w = rstd1 + 1536; float* sel_r = rstd1 + 1664;
    int* rankl = (int*)(rstd1 + 1728); int* basel = (int*)(rstd1 + 1856); float* bndp = rstd1 + 1888;
    const bf16_t* X1b = (const bf16_t*)(a.ws + WS_X1B); const bf16_t* WqT = (const bf16_t*)(a.ws + WS_WQ_T); const bf16_t* WoT = (const bf16_t*)(a.ws + WS_WO_T);
    const bf16_t* MK = (const bf16_t*)(a.ws + WS_MK); const bf16_t* MVT = (const bf16_t*)(a.ws + WS_MVT);
    const bf16_t* WRH = (const bf16_t*)(a.ws + WS_WR_HI); const bf16_t* WRL = (const bf16_t*)(a.ws + WS_WR_LO);
    const float* RSS1 = (const float*)(a.ws + WS_RSS1);
    bf16_t* X2b = (bf16_t*)(a.ws + (dummy ? WS_OA : WS_H3)); int* LIST = (int*)(a.ws + (dummy ? 152 * MiB : WS_LIST)); float* LISTW = (float*)(a.ws + (dummy ? 154 * MiB : WS_LISTW)); float* LISTR = (float*)(a.ws + (dummy ? 156 * MiB : WS_LISTR));
    unsigned* cntp = (unsigned*)(a.ws + WS_CTL) + CW_CNT + (dummy ? 64 : 0);
    float* outW = dummy ? (float*)(a.ws + 176 * MiB) : a.out;
    __syncthreads();
    if (wv == 0) { const float mq = wave_max(fabsf(AIN(I_MQN)[lane])), mk = wave_max(fabsf(AIN(I_MKN)[lane])); if (lane == 0) bndp[0] = 8.f * mq * mk * LOG2E; }
    if (wv == 1 && lane < 36) biasl[lane] = lane < 4 ? AIN(I_RGB)[lane] : AIN(I_REB)[lane - 4];
    __syncthreads();
    const float nsh = -bndp[0];
    for (int it = blockIdx.x; it < NT / 64; it += gridDim.x) {
        const int t0 = it * 64, b = t0 / NS;
        asm volatile("" : "+v"(tid), "+v"(fr), "+v"(fq), "+v"(r), "+v"(hh));
        __syncthreads();
        if (tid < 64) { const f32x4v* pp = (const f32x4v*)(RSS1 + (size_t)(t0 + tid) * 16); const f32x4v p0 = pp[0], p1 = pp[1], p2 = pp[2], p3 = pp[3];
            const float sm = (((p0.x + p0.y) + (p0.z + p0.w)) + ((p1.x + p1.y) + (p1.z + p1.w))) + (((p2.x + p2.y) + (p2.z + p2.w)) + ((p3.x + p3.y) + (p3.z + p3.w)));
            rstd1[tid] = rsqrtf(sm * (1.f / DM) + EPS); }
        pg8::f32x4 acc[2][4];
#pragma unroll
        for (int m = 0; m < 2; ++m)
#pragma unroll
            for (int n = 0; n < 4; ++n) acc[m][n] = (pg8::f32x4){0.f, 0.f, 0.f, 0.f};
        {
            const bf16_t* Ap = X1b + (size_t)(t0 + (tid >> 3)) * DM + 8 * (tid & 7);
            const int awo = (tid >> 3) * 128 + (((tid & 7) ^ ((tid >> 3) & 7)) * 16);
            v4u ra0, ra1, ra2, ra3, rb0[4], rb1[4], rb2[4], rb3[4];
#define G1_LOAD(RA, RB, t) do { if ((t) < 16) { RA = *(const v4u*)(Ap + (t) * 64); p5_loadB(WqT, 1024, (t), tid, RB); } } while (0)
#define G1_WRITE(RA, RB, b) do { *(v4u*)(Al + (b) * 8192 + awo) = RA; p5_writeB(Bl + (b) * 32768, tid, RB); } while (0)
#define G1_COMPUTE(b) do { const unsigned char* Ac = Al + (b) * 8192; const unsigned char* Bc = Bl + (b) * 32768; \
            _Pragma("unroll") for (int kk = 0; kk < 2; ++kk) { pg8::bf16x8 af[2], bfr[4]; \
                _Pragma("unroll") for (int m = 0; m < 2; ++m) af[m] = *(const pg8::bf16x8*)(Ac + (32 * wm + 16 * m + fr) * 128 + (((4 * kk + fq) ^ (fr & 7)) * 16)); \
                _Pragma("unroll") for (int n = 0; n < 4; ++n) bfr[n] = *(const pg8::bf16x8*)(Bc + (64 * wn + 16 * n + fr) * 128 + (((4 * kk + fq) ^ (fr & 7)) * 16)); \
                _Pragma("unroll") for (int m = 0; m < 2; ++m) _Pragma("unroll") for (int n = 0; n < 4; ++n) acc[m][n] = MFMA16(bfr[n], af[m], acc[m][n]); } } while (0)
            G1_LOAD(ra0, rb0, 0); G1_LOAD(ra1, rb1, 1); G1_LOAD(ra2, rb2, 2); G1_LOAD(ra3, rb3, 3);
            G1_WRITE(ra0, rb0, 0);
            __syncthreads();
            if (parts & 1) for (int tb = 0; tb < 16; tb += 4) {
                G1_LOAD(ra0, rb0, tb + 4); G1_COMPUTE(0); G1_WRITE(ra1, rb1, 1); __syncthreads();
                G1_LOAD(ra1, rb1, tb + 5); G1_COMPUTE(1); G1_WRITE(ra2, rb2, 0); __syncthreads();
                G1_LOAD(ra2, rb2, tb + 6); G1_COMPUTE(0); G1_WRITE(ra3, rb3, 1); __syncthreads();
                G1_LOAD(ra3, rb3, tb + 7); G1_COMPUTE(1); if (tb + 4 < 16) G1_WRITE(ra0, rb0, 0); __syncthreads();
            }
#undef G1_LOAD
#undef G1_WRITE
        }
        { const float* mqn = AIN(I_MQN);
#pragma unroll
          for (int m = 0; m < 2; ++m) { const int row = 32 * wm + 16 * m + fr; const float rs1 = rstd1[row]; float v[16]; float ss = 0.f;
#pragma unroll
              for (int n = 0; n < 4; ++n)
#pragma unroll
                  for (int i = 0; i < 4; ++i) { v[4 * n + i] = acc[m][n][i] * rs1; ss += v[4 * n + i] * v[4 * n + i]; }
              ss += __shfl_xor(ss, 16); ss += __shfl_xor(ss, 32);
              const float rn = rsqrtf(ss * (1.f / 64.f) + EPS) * 0.125f;
#pragma unroll
              for (int gp = 0; gp < 2; ++gp) { const float* gq = mqn + 32 * gp + 8 * fq; v4u w;
                  w.x = cvtpk(v[8 * gp] * rn * gq[0], v[8 * gp + 1] * rn * gq[1]); w.y = cvtpk(v[8 * gp + 2] * rn * gq[2], v[8 * gp + 3] * rn * gq[3]);
                  w.z = cvtpk(v[8 * gp + 4] * rn * gq[4], v[8 * gp + 5] * rn * gq[5]); w.w = cvtpk(v[8 * gp + 6] * rn * gq[6], v[8 * gp + 7] * rn * gq[7]);
                  *(v4u*)(QOl + row * 512 + (((8 * wn + 4 * gp + fq) ^ (row & 15)) * 16)) = w; } } }
        __syncthreads();
        { const int head = wv >> 1, th = wv & 1; const int row = 32 * th + r;
          s16x8 qf[4];
#pragma unroll
          for (int s2 = 0; s2 < 4; ++s2) qf[s2] = *(const s16x8*)(QOl + row * 512 + (((8 * head + 2 * s2 + hh) ^ (row & 15)) * 16));
          const bf16_t* Kp = MK + (size_t)(b * MH + head) * NMEM * DH + (size_t)r * DH + 8 * hh; const bf16_t* Vp = MVT + (size_t)(b * MH + head) * DH * NMEM + (size_t)r * NMEM + 4 * hh;
          f32x16 O[2];
#pragma unroll
          for (int i = 0; i < 16; ++i) { O[0][i] = 0.f; O[1][i] = 0.f; }
          float lsum = 0.f;
          s16x8 kfA[4], kfB[4]; s16x4 vA[2][2][2], vB[2][2][2];
#define AT_LOAD(KF, VF, kt) do { if ((kt) < 8) { _Pragma("unroll") for (int s2 = 0; s2 < 4; ++s2) KF[s2] = *(const s16x8*)(Kp + (size_t)(32 * (kt)) * DH + 16 * s2); \
            _Pragma("unroll") for (int s2 = 0; s2 < 2; ++s2) _Pragma("unroll") for (int et = 0; et < 2; ++et) { const bf16_t* vp = Vp + (size_t)(32 * et) * NMEM + 32 * (kt) + 16 * s2; VF[s2][et][0] = *(const s16x4*)vp; VF[s2][et][1] = *(const s16x4*)(vp + 8); } } } while (0)
#define AT_STEP(KF, VF) do { f32x16 st; _Pragma("unroll") for (int i = 0; i < 16; ++i) st[i] = 0.f; \
            _Pragma("unroll") for (int s2 = 0; s2 < 4; ++s2) st = MFMA32(KF[s2], qf[s2], st); \
            _Pragma("unroll") for (int i = 0; i < 16; ++i) { st[i] = __builtin_amdgcn_exp2f(st[i] * LOG2E + nsh); lsum += st[i]; } \
            _Pragma("unroll") for (int s2 = 0; s2 < 2; ++s2) { const s16x8 pa = pack8(st, s2); \
                _Pragma("unroll") for (int et = 0; et < 2; ++et) O[et] = MFMA32(pa, __builtin_shufflevector(VF[s2][et][0], VF[s2][et][1], 0, 1, 2, 3, 4, 5, 6, 7), O[et]); } } while (0)
          AT_LOAD(kfA, vA, 0);
          if (parts & 2) for (int kt = 0; kt < 8; kt += 2) { AT_LOAD(kfB, vB, kt + 1); AT_STEP(kfA, vA); AT_LOAD(kfA, vA, kt + 2); AT_STEP(kfB, vB); }
#undef AT_LOAD
#undef AT_STEP
          const float lt = lsum + __shfl_xor(lsum, 32);
          asm volatile("" ::: "memory"); if (hh == 0) coefl[r] = 1.f / lt; asm volatile("s_waitcnt lgkmcnt(0)" ::: "memory");
#pragma unroll
          for (int i = 0; i < 16; ++i) { const float cf = coefl[crow(i, hh)]; const int orow = 32 * th + crow(i, hh);
#pragma unroll
              for (int et = 0; et < 2; ++et) { const int chunk = 8 * head + 4 * et + (r >> 3);
                  *(bf16_t*)(QOl + orow * 512 + ((chunk ^ (orow & 15)) * 16) + (r & 7) * 2) = f2bf(O[et][i] * cf); } }
        }
        __syncthreads();
        {
            v4u rb0[4], rb1[4], rb2[4], rb3[4]; f32x4v xr[2][2][2];
#define G2_LOAD(RB, s_) do { if ((s_) < 16) p5_loadB(WoT + (size_t)((s_) >> 2) * 65536, 256, (s_) & 3, tid, RB); } while (0)
#define G2_COMPUTE(b, kt) do { const unsigned char* Bc = Bl + (b) * 32768; \
            _Pragma("unroll") for (int kk = 0; kk < 2; ++kk) { pg8::bf16x8 af[2], bfr[4]; \
                _Pragma("unroll") for (int m = 0; m < 2; ++m) af[m] = *(const pg8::bf16x8*)(QOl + (32 * wm + 16 * m + fr) * 512 + (((8 * (kt) + 4 * kk + fq) ^ fr) * 16)); \
                _Pragma("unroll") for (int n = 0; n < 4; ++n) bfr[n] = *(const pg8::bf16x8*)(Bc + (64 * wn + 16 * n + fr) * 128 + (((4 * kk + fq) ^ (fr & 7)) * 16)); \
                _Pragma("unroll") for (int m = 0; m < 2; ++m) _Pragma("unroll") for (int n = 0; n < 4; ++n) acc[m][n] = MFMA16(bfr[n], af[m], acc[m][n]); } } while (0)
            G2_LOAD(rb0, 0); G2_LOAD(rb1, 1); G2_LOAD(rb2, 2); G2_LOAD(rb3, 3);
            p5_writeB(Bl, tid, rb0);
            __syncthreads();
            if (parts & 4) for (int nc = 0; nc < 4; ++nc) {
                asm volatile("" : "+v"(tid), "+v"(fr), "+v"(fq));
#pragma unroll
                for (int m = 0; m < 2; ++m)
#pragma unroll
                    for (int n = 0; n < 4; ++n) acc[m][n] = (pg8::f32x4){0.f, 0.f, 0.f, 0.f};
#pragma unroll
                for (int m = 0; m < 2; ++m)
#pragma unroll
                    for (int gp = 0; gp < 2; ++gp) { const float* xp2 = a.out + (size_t)(t0 + 32 * wm + 16 * m + fr) * DM + 256 * nc + 64 * wn + 32 * gp + 8 * fq; xr[m][gp][0] = *(const f32x4v*)xp2; xr[m][gp][1] = *(const f32x4v*)(xp2 + 4); }
                const int sb = 4 * nc;
                G2_LOAD(rb0, sb + 4); G2_COMPUTE(0, 0); p5_writeB(Bl + 32768, tid, rb1); __syncthreads();
                G2_LOAD(rb1, sb + 5); G2_COMPUTE(1, 1); p5_writeB(Bl, tid, rb2); __syncthreads();
                G2_LOAD(rb2, sb + 6); G2_COMPUTE(0, 2); p5_writeB(Bl + 32768, tid, rb3); __syncthreads();
                G2_LOAD(rb3, sb + 7); G2_COMPUTE(1, 3); if (nc < 3) p5_writeB(Bl, tid, rb0); __syncthreads();
#pragma unroll
                for (int m = 0; m < 2; ++m) { const int row = 32 * wm + 16 * m + fr; float ss = 0.f;
#pragma unroll
                    for (int gp = 0; gp < 2; ++gp) { const size_t off = (size_t)(t0 + row) * DM + 256 * nc + 64 * wn + 32 * gp + 8 * fq;
                        const f32x4v x0 = xr[m][gp][0], x1 = xr[m][gp][1];
                        const pg8::f32x4 a0 = acc[m][2 * gp], a1 = acc[m][2 * gp + 1];
                        const f32x4v o0 = (f32x4v){x0.x + a0[0], x0.y + a0[1], x0.z + a0[2], x0.w + a0[3]}, o1 = (f32x4v){x1.x + a1[0], x1.y + a1[1], x1.z + a1[2], x1.w + a1[3]};
                        *(f32x4v*)(outW + off) = o0; *(f32x4v*)(outW + off + 4) = o1;
                        ss += (o0.x * o0.x + o0.y * o0.y) + (o0.z * o0.z + o0.w * o0.w) + (o1.x * o1.x + o1.y * o1.y) + (o1.z * o1.z + o1.w * o1.w);
                        v4u w; w.x = cvtpk(o0.x, o0.y); w.y = cvtpk(o0.z, o0.w); w.z = cvtpk(o1.x, o1.y); w.w = cvtpk(o1.z, o1.w);
                        *(v4u*)(X2b + off) = w; }
                    ss += __shfl_xor(ss, 16); ss += __shfl_xor(ss, 32);
                    if (fq == 0) rss2[row * 16 + nc * 4 + wn] = ss; }
            }
#undef G2_LOAD
#undef G2_COMPUTE
#undef G1_COMPUTE
        }
        asm volatile("s_waitcnt vmcnt(0)" ::: "memory");
        __syncthreads();
        { pg8::f32x4 a3[4][3];
#pragma unroll
          for (int mt = 0; mt < 4; ++mt)
#pragma unroll
              for (int n = 0; n < 3; ++n) a3[mt][n] = (pg8::f32x4){0.f, 0.f, 0.f, 0.f};
          const float* xp = outW + (size_t)(t0 + fr) * DM + 128 * wv + 8 * fq;
          const bf16_t* whp = WRH + (size_t)fr * DM + 128 * wv + 8 * fq; const bf16_t* wlp = WRL + (size_t)fr * DM + 128 * wv + 8 * fq;
          f32x4v xa[4][2], xb[4][2]; pg8::bf16x8 wha[3], wla[3], whb[3], wlb[3];
#define RT_LOAD(X, WH, WL, ks) do { _Pragma("unroll") for (int mt = 0; mt < 4; ++mt) { X[mt][0] = *(const f32x4v*)(xp + (size_t)16 * mt * DM + 32 * (ks)); X[mt][1] = *(const f32x4v*)(xp + (size_t)16 * mt * DM + 32 * (ks) + 4); } \
            _Pragma("unroll") for (int n = 0; n < 3; ++n) { WH[n] = *(const pg8::bf16x8*)(whp + (size_t)16 * n * DM + 32 * (ks)); WL[n] = *(const pg8::bf16x8*)(wlp + (size_t)16 * n * DM + 32 * (ks)); } } while (0)
#define RT_STEP(X, WH, WL) do { _Pragma("unroll") for (int mt = 0; mt < 4; ++mt) { \
            const float xv[8] = {X[mt][0].x, X[mt][0].y, X[mt][0].z, X[mt][0].w, X[mt][1].x, X[mt][1].y, X[mt][1].z, X[mt][1].w}; float xh[8], xl[8]; \
            _Pragma("unroll") for (int j = 0; j < 8; ++j) { xh[j] = bf2f(f2bf(xv[j])); xl[j] = xv[j] - xh[j]; } \
            v4u ph, pl; ph.x = cvtpk(xh[0], xh[1]); ph.y = cvtpk(xh[2], xh[3]); ph.z = cvtpk(xh[4], xh[5]); ph.w = cvtpk(xh[6], xh[7]); \
            pl.x = cvtpk(xl[0], xl[1]); pl.y = cvtpk(xl[2], xl[3]); pl.z = cvtpk(xl[4], xl[5]); pl.w = cvtpk(xl[6], xl[7]); \
            const pg8::bf16x8 xhf = __builtin_bit_cast(pg8::bf16x8, ph), xlf = __builtin_bit_cast(pg8::bf16x8, pl); \
            _Pragma("unroll") for (int n = 0; n < 3; ++n) { a3[mt][n] = MFMA16(xhf, WH[n], a3[mt][n]); a3[mt][n] = MFMA16(xhf, WL[n], a3[mt][n]); a3[mt][n] = MFMA16(xlf, WH[n], a3[mt][n]); } } } while (0)
          if (parts & 8) {
              RT_LOAD(xa, wha, wla, 0); RT_LOAD(xb, whb, wlb, 1);
              RT_STEP(xa, wha, wla); RT_LOAD(xa, wha, wla, 2); RT_STEP(xb, whb, wlb); RT_LOAD(xb, whb, wlb, 3); RT_STEP(xa, wha, wla); RT_STEP(xb, whb, wlb);
          }
#undef RT_LOAD
#undef RT_STEP
          float* slab = (float*)lds_raw + wv * 3072;
#pragma unroll
          for (int mt = 0; mt < 4; ++mt)
#pragma unroll
              for (int n = 0; n < 3; ++n)
#pragma unroll
                  for (int i = 0; i < 4; ++i) slab[(16 * mt + 4 * fq + i) * 48 + 16 * n + fr] = a3[mt][n][i];
        }
        __syncthreads();
        if ((parts & 16) && tid < 64) { float sm2 = 0.f;
#pragma unroll
            for (int j = 0; j < 16; ++j) sm2 += rss2[tid * 16 + j];
            const float rs2 = rsqrtf(sm2 * (1.f / DM) + EPS); float* l = (float*)lds_raw + tid * 48;
            for (int n = 0; n < 36; ++n) { float sm = l[n];
#pragma unroll
                for (int w = 1; w < 8; ++w) sm += l[w * 3072 + n];
                l[n] = sm * rs2 + biasl[n]; }
            int grp = 0; float gm = l[0];
            for (int j = 1; j < 4; ++j) if (l[j] > gm) { gm = l[j]; grp = j; }
            float gs = 0.f; for (int j = 0; j < 4; ++j) gs += __expf(l[j] - gm);
            const float gw = 1.f / gs;
            const float* el = l + 4 + grp * 8; int e0 = 0; float v0 = el[0];
            for (int j = 1; j < 8; ++j) if (el[j] > v0) { v0 = el[j]; e0 = j; }
            int e1 = -1; float v1 = 0.f;
            for (int j = 0; j < 8; ++j) if (j != e0) { if (e1 < 0 || el[j] > v1) { v1 = el[j]; e1 = j; } }
            const float p1 = __expf(v1 - v0); const float den = 1.f + p1;
            sel_e[2 * tid] = (grp * 8 + e0) & 31; sel_e[2 * tid + 1] = (grp * 8 + e1) & 31; sel_w[2 * tid] = gw / den; sel_w[2 * tid + 1] = gw * p1 / den; sel_r[tid] = rs2; }
        __syncthreads();
        if ((parts & 16) && tid < 32) { int c = 0;
            for (int q = 0; q < 128; ++q) if (sel_e[q] == tid) { rankl[q] = c; ++c; }
            basel[tid] = c ? (int)atomicAdd(cntp + tid, (unsigned)c) : 0; }
        __syncthreads();
        if ((parts & 16) && tid < 128) { const int e = sel_e[tid]; const size_t slot = (size_t)e * NT + basel[e] + rankl[tid];
            LIST[slot] = (t0 + (tid >> 1)) * 2 + (tid & 1); LISTW[slot] = sel_w[tid]; LISTR[slot] = sel_r[tid >> 1]; }
    }
}

struct MemKvOrder {
    int c, first;
    DI bool next(int i, pg8::Unit& u) const { const int k = c - first; if (i != 0 || k < 0 || k >= 16) return false; u.pm = k >> 1; u.pn = k & 1; return true; }
    DI void a_ready(const pg8::Unit&) const {}
    DI void done(const pg8::Unit&) const {}
};
struct EpiMemKV {
    static constexpr bool PERM = true, AFTER_DRAIN = false;
    bf16_t* MK; bf16_t* MVT; const float* kn;
    DI void operator()(const pg8::f32x4 (&acc)[2][2][4][2], const pg8::Unit& u, int wr, int wc, int fr, int fq) const {
        const int b = u.pm;
        float g[2][8];
#pragma unroll
        for (int bj = 0; bj < 2; ++bj)
#pragma unroll
            for (int j = 0; j < 8; ++j) g[bj][j] = kn[32 * bj + 8 * fq + j];
#pragma unroll
        for (int ai = 0; ai < 2; ++ai)
#pragma unroll
            for (int m = 0; m < 4; ++m) {
                const int rl = ai * 128 + wr * 64 + m * 16 + fr;
                float v[2][8];
#pragma unroll
                for (int bj = 0; bj < 2; ++bj)
#pragma unroll
                    for (int n = 0; n < 2; ++n)
#pragma unroll
                        for (int i = 0; i < 4; ++i) v[bj][4 * n + i] = acc[ai][bj][m][n][i];
                if (u.pn == 0) {
                    float ss = 0.f;
#pragma unroll
                    for (int bj = 0; bj < 2; ++bj)
#pragma unroll
                        for (int j = 0; j < 8; ++j) ss += v[bj][j] * v[bj][j];
                    ss += __shfl_xor(ss, 16); ss += __shfl_xor(ss, 32);
                    const float rn = rsqrtf(ss * (1.f / 64.f) + EPS);
                    bf16_t* rp = MK + ((size_t)(b * MH + wc) * NMEM + rl) * DH + 8 * fq;
#pragma unroll
                    for (int bj = 0; bj < 2; ++bj) { v4u w; w.x = cvtpk(v[bj][0] * rn * g[bj][0], v[bj][1] * rn * g[bj][1]); w.y = cvtpk(v[bj][2] * rn * g[bj][2], v[bj][3] * rn * g[bj][3]);
                        w.z = cvtpk(v[bj][4] * rn * g[bj][4], v[bj][5] * rn * g[bj][5]); w.w = cvtpk(v[bj][6] * rn * g[bj][6], v[bj][7] * rn * g[bj][7]); *(v4u*)(rp + 32 * bj) = w; }
                } else {
                    bf16_t* tp = MVT + (size_t)(b * MH + wc) * DH * NMEM + rl;
#pragma unroll
                    for (int bj = 0; bj < 2; ++bj)
#pragma unroll
                        for (int j = 0; j < 8; ++j) tp[(size_t)(32 * bj + 8 * fq + j) * NMEM] = f2bf(v[bj][j]);
                }
            }
    }
};
DI void phase_memkv_mfma(const Ctx& a, unsigned char* lds_raw) {
    pg8::Gemm g{(const bf16_t*)(a.ws + WS_HM), (const bf16_t*)(a.ws + WS_WKV_T), NB * NMEM, 512, DM};
    MemKvOrder S{(int)blockIdx.x, (int)gridDim.x >= 144 ? 128 : 0};
    EpiMemKV E{(bf16_t*)(a.ws + WS_MK), (bf16_t*)(a.ws + WS_MVT), AIN(I_MKN)};
    pg8::gemm_phase<EpiMemKV, MemKvOrder, true, true>((PG8_LAS unsigned char*)lds_raw, g, S, E);
}

DI void phase_compress_mfma(const Ctx& a, unsigned char* lds_raw) {
    int tid = opaque_tid(); const int lane = tid & 63, wv = __builtin_amdgcn_readfirstlane(tid >> 6);
    int fr = lane & 15, fq = lane >> 4;
    const int wm = wv >> 2, wn = wv & 3;
    unsigned char* Al = lds_raw; unsigned char* Bl = lds_raw + 16384; unsigned char* Hl = lds_raw + 49152; unsigned char* W2l = lds_raw + 65536; float* Ol = (float*)(lds_raw + 81920);
    const bf16_t* KV = (const bf16_t*)(a.ws + WS_KV);
    for (int u = blockIdx.x; u < 64; u += gridDim.x) {
        const int kv = u >> 5, bg = (u >> 1) & 15, half = u & 1;
        const bf16_t* Ab = KV + (size_t)kv * KV_STRIDE + ((size_t)bg * NS + 16 * 64 * half) * DH;
        const bf16_t* W1T = (const bf16_t*)(a.ws + WS_W1K_T) + (size_t)kv * 128 * 2048; const bf16_t* W2T = (const bf16_t*)(a.ws + WS_W2K_T) + (size_t)kv * 64 * 128;
        const float* PB = (const float*)(a.ws + WS_PB) + kv * 128;
        asm volatile("" : "+v"(tid), "+v"(fr), "+v"(fq));
        __syncthreads();
#pragma unroll
        for (int i = 0; i < 2; ++i) { const int p = tid + 512 * i, row = p >> 4, c = p & 15; *(v4u*)(W2l + row * 256 + ((c ^ (row & 15)) * 16)) = *(const v4u*)(W2T + row * 128 + 8 * c); }
        pg8::f32x4 acc[2][2];
#pragma unroll
        for (int m = 0; m < 2; ++m)
#pragma unroll
            for (int n = 0; n < 2; ++n) acc[m][n] = (pg8::f32x4){0.f, 0.f, 0.f, 0.f};
        {
            v4u ar, br[2];
            const bf16_t* Ap = Ab + (size_t)(tid >> 3) * 1024 + 8 * (tid & 7);
            ar = *(const v4u*)Ap;
#pragma unroll
            for (int i = 0; i < 2; ++i) { const int p = tid + 512 * i; br[i] = *(const v4u*)(W1T + (size_t)(p >> 3) * 2048 + 8 * (p & 7)); }
            *(v4u*)(Al + (tid >> 3) * 128 + (((tid & 7) ^ ((tid >> 3) & 7)) * 16)) = ar;
#pragma unroll
            for (int i = 0; i < 2; ++i) { const int p = tid + 512 * i, rho = p >> 3, c = p & 7; *(v4u*)(Bl + rho * 128 + ((c ^ (rho & 7)) * 16)) = br[i]; }
            __syncthreads();
            for (int kt = 0; kt < 32; ++kt) {
                asm volatile("" : "+v"(tid), "+v"(fr), "+v"(fq));
                if (kt + 1 < 32) { ar = *(const v4u*)(Ap + (kt + 1) * 64);
#pragma unroll
                    for (int i = 0; i < 2; ++i) { const int p = tid + 512 * i; br[i] = *(const v4u*)(W1T + (size_t)(p >> 3) * 2048 + (kt + 1) * 64 + 8 * (p & 7)); } }
                const unsigned char* Ac = Al + (kt & 1) * 8192; const unsigned char* Bc = Bl + (kt & 1) * 16384;
#pragma unroll
                for (int kk = 0; kk < 2; ++kk) {
                    pg8::bf16x8 af[2], bfr[2];
#pragma unroll
                    for (int m = 0; m < 2; ++m) af[m] = *(const pg8::bf16x8*)(Ac + (32 * wm + 16 * m + fr) * 128 + (((4 * kk + fq) ^ (fr & 7)) * 16));
#pragma unroll
                    for (int n = 0; n < 2; ++n) bfr[n] = *(const pg8::bf16x8*)(Bc + (32 * wn + 16 * n + fr) * 128 + (((4 * kk + fq) ^ (fr & 7)) * 16));
#pragma unroll
                    for (int m = 0; m < 2; ++m)
#pragma unroll
                        for (int n = 0; n < 2; ++n) acc[m][n] = MFMA16(bfr[n], af[m], acc[m][n]);
                }
                if (kt + 1 < 32) { *(v4u*)(Al + ((kt + 1) & 1) * 8192 + (tid >> 3) * 128 + (((tid & 7) ^ ((tid >> 3) & 7)) * 16)) = ar;
#pragma unroll
                    for (int i = 0; i < 2; ++i) { const int p = tid + 512 * i, rho = p >> 3, c = p & 7; *(v4u*)(Bl + ((kt + 1) & 1) * 16384 + rho * 128 + ((c ^ (rho & 7)) * 16)) = br[i]; } }
                __syncthreads();
            }
        }
#pragma unroll
        for (int m = 0; m < 2; ++m)
#pragma unroll
            for (int n = 0; n < 2; ++n) { const int row = 32 * wm + 16 * m + fr, col = 32 * wn + 16 * n + 4 * fq; const f32x4v pb = *(const f32x4v*)(PB + col);
                unsigned long long w = (unsigned long long)cvtpk(siluf(acc[m][n][0] + pb.x), siluf(acc[m][n][1] + pb.y)) | ((unsigned long long)cvtpk(siluf(acc[m][n][2] + pb.z), siluf(acc[m][n][3] + pb.w)) << 32);
                *(unsigned long long*)(Hl + row * 256 + (((col >> 3) ^ (row & 15)) * 16) + (fq & 1) * 8) = w; }
        __syncthreads();
        { pg8::f32x4 a2[2] = {(pg8::f32x4){0.f, 0.f, 0.f, 0.f}, (pg8::f32x4){0.f, 0.f, 0.f, 0.f}};
#pragma unroll
          for (int kk = 0; kk < 4; ++kk) { const pg8::bf16x8 bfr = *(const pg8::bf16x8*)(W2l + (16 * wn + fr) * 256 + (((4 * kk + fq) ^ fr) * 16));
#pragma unroll
              for (int m = 0; m < 2; ++m) { const pg8::bf16x8 af = *(const pg8::bf16x8*)(Hl + (32 * wm + 16 * m + fr) * 256 + (((4 * kk + fq) ^ fr) * 16)); a2[m] = MFMA16(bfr, af, a2[m]); } }
#pragma unroll
          for (int m = 0; m < 2; ++m) *(f32x4v*)(Ol + (32 * wm + 16 * m + fr) * 64 + 16 * wn + 4 * fq) = (f32x4v){a2[m][0], a2[m][1], a2[m][2], a2[m][3]}; }
        __syncthreads();
        { const int row = tid >> 3, part = tid & 7; const float* op = Ol + row * 64 + 8 * part; const f32x4v o0 = *(const f32x4v*)op, o1 = *(const f32x4v*)(op + 4);
          float v[8] = {o0.x, o0.y, o0.z, o0.w, o1.x, o1.y, o1.z, o1.w};
          if (kv == 0) { float ss = 0.f;
#pragma unroll
              for (int j = 0; j < 8; ++j) ss += v[j] * v[j];
              ss += __shfl_xor(ss, 1); ss += __shfl_xor(ss, 2); ss += __shfl_xor(ss, 4);
              const float rn = rsqrtf(ss * (1.f / 64.f) + EPS); const float* gk = AIN(I_KCN) + 8 * part;
#pragma unroll
              for (int j = 0; j < 8; ++j) v[j] = v[j] * rn * gk[j]; }
          const int c = 64 * half + row;
          v4u w; w.x = cvtpk(v[0], v[1]); w.y = cvtpk(v[2], v[3]); w.z = cvtpk(v[4], v[5]); w.w = cvtpk(v[6], v[7]);
          if (c == 127) w = (v4u){0u, 0u, 0u, 0u};
          *(v4u*)((bf16_t*)(a.ws + (kv ? WS_VCMP : WS_KCMP)) + ((size_t)bg * 128 + c) * DH + 8 * part) = w; }
    }
}

__global__ void __launch_bounds__(NTHR, 2) fwd_kernel(Args ka) {
    extern __shared__ __attribute__((aligned(16))) unsigned char lds_raw[];
    float* lds = (float*)lds_raw;
    volatile LAS unsigned* misc = (volatile LAS unsigned*)((LAS unsigned char*)lds_raw + LDS_MISC);
    if (threadIdx.x < 64) misc[threadIdx.x] = 0u;
    LAS unsigned long long* ptab = (LAS unsigned long long*)((LAS unsigned char*)lds_raw + LDS_PTAB);
    if (threadIdx.x < 32) ptab[threadIdx.x] = (unsigned long long)ka.in[threadIdx.x];
    __syncthreads();
    Ctx a; a.tab = ptab; a.out = ka.out; a.ws = ka.ws;
    XcdBarrier bar = xcd_barrier_post((unsigned*)(a.ws + WS_CTL), misc + 8);

#ifndef PHMASK
#define PHMASK 0xffff
#endif
#define PH(k) ((PHMASK >> (k)) & 1)
#ifndef DUPMASK
#define DUPMASK 0
#endif
#define DUP(k) ((DUPMASK >> (k)) & 1)
#ifndef P5PARTS
#define P5PARTS 31
#endif
#ifndef DUPBAR
#define DUPBAR 0
#endif
#define GBAR() do { xcd_barrier(bar); if (DUPBAR) xcd_barrier(bar); } while (0)
    if (PH(0)) { phase_prologue(a, lds_raw); if (DUP(0)) { phase_prologue(a, lds_raw); } }
    GBAR();
    if (PH(1)) { phase_proj_mfma(a, lds_raw); if (DUP(1)) { phase_proj_mfma(a, lds_raw); } }
    if (PH(2)) { phase_memkv_mfma(a, lds_raw); if (DUP(2)) { phase_memkv_mfma(a, lds_raw); } }
    GBAR();
    if (PH(3)) { phase_compress_mfma(a, lds_raw); if (DUP(3)) { phase_compress_mfma(a, lds_raw); } }
    if (PH(11)) { phase_ret_state(a, lds_raw); if (DUP(11)) { phase_ret_state(a, lds_raw); } }
    GBAR();
    if (PH(4)) { phase_nsa_mfma(a, lds_raw); if (DUP(4)) { phase_nsa_mfma(a, lds_raw); } }
    if (PH(5)) { phase_ret_out(a, lds_raw); if (DUP(5)) { phase_ret_out(a, lds_raw); } }
    GBAR();
    if (PH(6)) { phase_outproj_mfma(a, lds_raw); if (DUP(6)) { phase_outproj_mfma(a, lds_raw); } }
    GBAR();
#if OPT_MEMATTN
    if (PH(7)) { phase_memattn_mfma(a, lds_raw); if (DUP(7)) { phase_memattn_mfma(a, lds_raw, true, P5PARTS); } }
#else
    if (PH(7)) { phase_tail_b(a, lds); if (DUP(7)) { phase_tail_b(a, lds); } }
#endif
    GBAR();
    if (PH(8)) { phase_moe_gu(a, lds_raw); if (DUP(8)) { phase_moe_gu(a, lds_raw); } }
    GBAR();
    if (PH(9)) { phase_moe_down(a, lds_raw); if (DUP(9)) { phase_moe_down(a, lds_raw); } }
    GBAR();
    if (PH(10)) { phase_combine(a); if (DUP(10)) { phase_combine(a); } }
}

extern "C" void kernel_launch(void* const* d_in, const int* in_sizes, int n_in, void* d_out, int out_size, void* d_ws, size_t ws_size, hipStream_t stream) {
    static int grid = 0;
    if (grid == 0) {
        if (n_in != 32 || ws_size < WS_END) { fprintf(stderr, "kernel_launch: unexpected n_in %d / ws %zu\n", n_in, ws_size); grid = -1; return; }
        int dev = 0, cus = 0, per_cu = 0;
        if (hipGetDevice(&dev) != hipSuccess || hipDeviceGetAttribute(&cus, hipDeviceAttributeMultiprocessorCount, dev) != hipSuccess) { grid = -1; return; }
        if (hipFuncSetAttribute((const void*)fwd_kernel, hipFuncAttributeMaxDynamicSharedMemorySize, LDS_BYTES) != hipSuccess) { fprintf(stderr, "kernel_launch: hipFuncSetAttribute failed\n"); grid = -1; return; }
        if (hipOccupancyMaxActiveBlocksPerMultiprocessor(&per_cu, (const void*)fwd_kernel, NTHR, LDS_BYTES) != hipSuccess || per_cu < 1) { fprintf(stderr, "kernel_launch: occupancy query says %d blocks per CU\n", per_cu); (void)hipGetLastError(); grid = -1; return; }
        grid = cus;
    }
    if (grid < 0) return;
    (void)hipMemsetAsync((char*)d_ws + WS_CTL, 0, CTL_ZERO_BYTES, stream);
    Args a{};
    for (int i = 0; i < 32; ++i) a.in[i] = (const float*)d_in[i];
    a.out = (float*)d_out; a.ws = (unsigned char*)d_ws;
    hipLaunchKernelGGL(fwd_kernel, dim3(grid), dim3(NTHR), LDS_BYTES, stream, a);
}
```
